# Optimizing an MI355X kernel written in HIP

```python
import math
import jax
import jax.numpy as jnp
from jax import lax
import numpy as np

D_MODEL = 1024
BATCH = 8
SEQ = 4096
DEPTH = 1

HEAD_DIM = 64
ROPE_THETA = 10000.0
NORM_EPS = 1e-6
NEG_INF = -1e30
FORCE_SCORE = 1e9

DIFF_HEADS = 4
DIFF_VDIM = 2 * HEAD_DIM
DIFF_Q_BLOCK = 128

NSA_HEADS = 8
NSA_KV_GROUPS = 2
NSA_HPG = NSA_HEADS // NSA_KV_GROUPS
CMP_LEN = 32
CMP_STRIDE = 16
CMP_HIDDEN = 4 * HEAD_DIM
SEL_LEN = 64
SEL_TOPK = 16
WINDOW = 512
NSA_Q_BLOCK = 64

D_FF = int(math.ceil(8 * D_MODEL / 3 / 256)) * 256

DIFF_QK = DIFF_HEADS * 2 * HEAD_DIM
DIFF_V = DIFF_HEADS * DIFF_VDIM
NSA_Q = NSA_HEADS * HEAD_DIM
NSA_KV = NSA_KV_GROUPS * HEAD_DIM
NSA_GATES = 3 * NSA_HEADS
MERGE_GATES = 2 * D_MODEL
IN_SPLITS = (DIFF_QK, DIFF_QK, DIFF_V, NSA_Q, NSA_KV, NSA_KV, NSA_KV, NSA_KV, NSA_KV, NSA_KV, NSA_GATES, MERGE_GATES)
IN_DIM = sum(IN_SPLITS)
A_WIDTH = DIFF_V
B_WIDTH = NSA_HEADS * HEAD_DIM

kernel_name = "hybrid_diffattn_nsa_block"


def lambda_init(layer):
    return 0.8 - 0.6 * math.exp(-0.3 * layer)


def rms_norm(x, g):
    xf = x.astype(jnp.float32)
    y = xf * lax.rsqrt(jnp.mean(xf * xf, axis=-1, keepdims=True) + NORM_EPS)
    return (y * g.astype(jnp.float32)).astype(x.dtype)


def rope_tables(positions, dim):
    inv_freq = 1.0 / (ROPE_THETA ** (jnp.arange(0, dim, 2, dtype=jnp.float32) / dim))
    ang = positions.astype(jnp.float32)[..., None] * inv_freq
    return jnp.cos(ang), jnp.sin(ang)


def apply_rope(x, cos, sin):
    half = x.shape[-1] // 2
    xf = x.astype(jnp.float32)
    x1, x2 = xf[..., :half], xf[..., half:]
    return jnp.concatenate([x1 * cos - x2 * sin, x2 * cos + x1 * sin], axis=-1).astype(x.dtype)


def differential_attention(q, k, v, lam):
    B, S, H, _, dh = q.shape
    nblk = S // DIFF_Q_BLOCK
    scale = dh ** -0.5
    kpos = jnp.arange(S)

    def one_block(i):
        s0 = i * DIFF_Q_BLOCK
        qb = lax.dynamic_slice_in_dim(q, s0, DIFF_Q_BLOCK, axis=1)
        s = jnp.einsum('bqhcd,bkhcd->bhcqk', qb, k).astype(jnp.float32) * scale
        qpos = s0 + jnp.arange(DIFF_Q_BLOCK)
        causal = kpos[None, :] <= qpos[:, None]
        p = jax.nn.softmax(jnp.where(causal, s, NEG_INF), axis=-1)
        a = p[:, :, 0] - lam * p[:, :, 1]
        return jnp.einsum('bhqk,bkhe->bqhe', a.astype(v.dtype), v)

    o = lax.map(one_block, jnp.arange(nblk))
    return o.transpose(1, 0, 2, 3, 4).reshape(B, S, H, v.shape[-1])


def compress(x, pe, w1, w2):
    B, S, G, dh = x.shape
    nc = (S - CMP_LEN) // CMP_STRIDE + 1
    idx = np.arange(nc)[:, None] * CMP_STRIDE + np.arange(CMP_LEN)[None, :]
    blk = x[:, idx] + pe[None, None, :, None, :]
    blk = blk.transpose(0, 1, 3, 2, 4).reshape(B, nc, G, CMP_LEN * dh)
    return jax.nn.silu(blk @ w1) @ w2


def nsa_attention(q, kc, vc, ks, vs, kw, vw):
    B, S, G, hpg, dh = q.shape
    nc = kc.shape[1]
    nsb = S // SEL_LEN
    topk = min(SEL_TOPK, nsb)
    nblk = S // NSA_Q_BLOCK
    scale = dh ** -0.5
    cmp_end = np.arange(nc) * CMP_STRIDE + CMP_LEN - 1
    ci = np.arange(nc)[:, None] * CMP_STRIDE
    sj = np.arange(nsb)[None, :] * SEL_LEN
    overlap = jnp.asarray(((ci < sj + SEL_LEN) & (ci + CMP_LEN > sj)).astype(np.float32))
    kb = ks.reshape(B, nsb, SEL_LEN, G, dh).transpose(0, 3, 1, 2, 4)
    vb = vs.reshape(B, nsb, SEL_LEN, G, dh).transpose(0, 3, 1, 2, 4)
    kw_pad = jnp.pad(kw, ((0, 0), (WINDOW, 0), (0, 0), (0, 0)))
    vw_pad = jnp.pad(vw, ((0, 0), (WINDOW, 0), (0, 0), (0, 0)))
    b_idx = jnp.arange(B)[:, None, None, None]
    g_idx = jnp.arange(G)[None, None, :, None]
    blk_ids = jnp.arange(nsb)
    sel_off = jnp.arange(SEL_LEN)

    def one_block(i):
        s0 = i * NSA_Q_BLOCK
        qpos = s0 + jnp.arange(NSA_Q_BLOCK)
        qb = lax.dynamic_slice_in_dim(q, s0, NSA_Q_BLOCK, axis=1)
        sc = jnp.einsum('bqghd,bcgd->bqghc', qb, kc).astype(jnp.float32) * scale
        cm = (cmp_end[None, :] <= qpos[:, None])[None, :, None, None, :]
        pc = jax.nn.softmax(jnp.where(cm, sc, NEG_INF), axis=-1) * cm
        o_c = jnp.einsum('bqghc,bcgd->bqghd', pc.astype(vc.dtype), vc)
        imp = jnp.einsum('bqgc,cn->bqgn', pc.sum(axis=3), overlap)
        qblk = qpos // SEL_LEN
        forced = (blk_ids[None, :] == 0) | (blk_ids[None, :] == qblk[:, None]) | (blk_ids[None, :] == qblk[:, None] - 1)
        causal_blk = blk_ids[None, :] <= qblk[:, None]
        imp = jnp.where(forced[None, :, None, :], FORCE_SCORE, imp)
        imp = jnp.where(causal_blk[None, :, None, :], imp, NEG_INF)
        _, idx = lax.top_k(imp, topk)
        ksel = kb[b_idx, g_idx, idx]
        vsel = vb[b_idx, g_idx, idx]
        ss = jnp.einsum('bqghd,bqgnld->bqghnl', qb, ksel).astype(jnp.float32) * scale
        kp = idx[..., None] * SEL_LEN + sel_off
        smask = (kp <= qpos[None, :, None, None, None])[:, :, :, None]
        ss = jnp.where(smask, ss, NEG_INF).reshape(B, NSA_Q_BLOCK, G, hpg, topk * SEL_LEN)
        ps = jax.nn.softmax(ss, axis=-1).reshape(B, NSA_Q_BLOCK, G, hpg, topk, SEL_LEN)
        o_s = jnp.einsum('bqghnl,bqgnld->bqghd', ps.astype(vsel.dtype), vsel)
        kwb = lax.dynamic_slice_in_dim(kw_pad, s0, NSA_Q_BLOCK + WINDOW, axis=1)
        vwb = lax.dynamic_slice_in_dim(vw_pad, s0, NSA_Q_BLOCK + WINDOW, axis=1)
        kpos = s0 - WINDOW + jnp.arange(NSA_Q_BLOCK + WINDOW)
        dist = qpos[:, None] - kpos[None, :]
        wmask = ((dist >= 0) & (dist < WINDOW) & (kpos[None, :] >= 0))[None, :, None, None, :]
        sw = jnp.einsum('bqghd,bkgd->bqghk', qb, kwb).astype(jnp.float32) * scale
        pw = jax.nn.softmax(jnp.where(wmask, sw, NEG_INF), axis=-1)
        o_w = jnp.einsum('bqghk,bkgd->bqghd', pw.astype(vwb.dtype), vwb)
        return o_c, o_s, o_w

    o_c, o_s, o_w = lax.map(one_block, jnp.arange(nblk))

    def to_seq(o):
        return o.transpose(1, 0, 2, 3, 4, 5).reshape(B, S, G * hpg, dh)

    return to_seq(o_c), to_seq(o_s), to_seq(o_w)


def hybrid_mixer(u, cos, sin, layer, w_in, diff_lambda, diff_subln_g, cmp_pe_k, cmp_pe_v,
                 cmp_k_w1, cmp_k_w2, cmp_v_w1, cmp_v_w2, w_branch_a, w_branch_b, w_out):
    B, S, _ = u.shape
    G, dh = NSA_KV_GROUPS, HEAD_DIM
    split_at = np.cumsum(IN_SPLITS)[:-1].tolist()
    (dq, dk, dv, nq, kc_, vc_, ks_, vs_, kw_, vw_, ngate, mgate) = jnp.split(u @ w_in, split_at, axis=-1)
    c4, s4 = cos[:, :, None, None, :], sin[:, :, None, None, :]
    c3, s3 = cos[:, :, None, :], sin[:, :, None, :]
    dq = apply_rope(dq.reshape(B, S, DIFF_HEADS, 2, dh), c4, s4)
    dk = apply_rope(dk.reshape(B, S, DIFF_HEADS, 2, dh), c4, s4)
    dv = dv.reshape(B, S, DIFF_HEADS, DIFF_VDIM)
    lam_init = lambda_init(layer)
    lf = diff_lambda.astype(jnp.float32)
    lam = jnp.exp(jnp.sum(lf[0] * lf[1])) - jnp.exp(jnp.sum(lf[2] * lf[3])) + lam_init
    y_a = differential_attention(dq, dk, dv, lam)
    y_a = rms_norm(y_a, diff_subln_g) * (1.0 - lam_init)
    y_a = y_a.reshape(B, S, A_WIDTH) @ w_branch_a
    nq = apply_rope(nq.reshape(B, S, NSA_HEADS, dh), c3, s3).reshape(B, S, G, NSA_HPG, dh)

    def kv(t):
        return t.reshape(B, S, G, dh)

    k_cmp = compress(apply_rope(kv(kc_), c3, s3), cmp_pe_k, cmp_k_w1, cmp_k_w2)
    v_cmp = compress(kv(vc_), cmp_pe_v, cmp_v_w1, cmp_v_w2)
    k_sel = apply_rope(kv(ks_), c3, s3)
    k_win = apply_rope(kv(kw_), c3, s3)
    o_c, o_s, o_w = nsa_attention(nq, k_cmp, v_cmp, k_sel, kv(vs_), k_win, kv(vw_))
    g = jax.nn.sigmoid(ngate.astype(jnp.float32)).reshape(B, S, 3, NSA_HEADS, 1).astype(u.dtype)
    y_b = g[:, :, 0] * o_c + g[:, :, 1] * o_s + g[:, :, 2] * o_w
    y_b = y_b.reshape(B, S, B_WIDTH) @ w_branch_b
    mg = jax.nn.sigmoid(mgate.astype(jnp.float32)).reshape(B, S, 2, D_MODEL).astype(u.dtype)
    return (mg[:, :, 0] * y_a + mg[:, :, 1] * y_b) @ w_out


def swiglu(u, w_gate, w_up, w_down):
    return (jax.nn.silu(u @ w_gate) * (u @ w_up)) @ w_down


def setup_inputs(seed: int = 0) -> dict:
    key = jax.random.key(seed)
    ks = jax.random.split(key, 22)

    def nrm(k, shape, scale):
        return jax.random.normal(k, shape, jnp.float32) * scale

    return {
        "x": nrm(ks[0], (BATCH, SEQ, D_MODEL), 1.0),
        "positions": jnp.tile(jnp.arange(SEQ, dtype=jnp.int32)[None, :], (BATCH, 1)),
        "attn_norm_g": 1.0 + nrm(ks[1], (DEPTH, D_MODEL), 0.02),
        "w_in": nrm(ks[2], (DEPTH, D_MODEL, IN_DIM), D_MODEL ** -0.5),
        "diff_lambda": nrm(ks[3], (DEPTH, 4, HEAD_DIM), 0.1),
        "diff_subln_g": 1.0 + nrm(ks[4], (DEPTH, DIFF_VDIM), 0.02),
        "cmp_pe_k": nrm(ks[5], (DEPTH, CMP_LEN, HEAD_DIM), 0.1),
        "cmp_pe_v": nrm(ks[6], (DEPTH, CMP_LEN, HEAD_DIM), 0.1),
        "cmp_k_w1": nrm(ks[7], (DEPTH, CMP_LEN * HEAD_DIM, CMP_HIDDEN), (CMP_LEN * HEAD_DIM) ** -0.5),
        "cmp_k_w2": nrm(ks[8], (DEPTH, CMP_HIDDEN, HEAD_DIM), CMP_HIDDEN ** -0.5),
        "cmp_v_w1": nrm(ks[9], (DEPTH, CMP_LEN * HEAD_DIM, CMP_HIDDEN), (CMP_LEN * HEAD_DIM) ** -0.5),
        "cmp_v_w2": nrm(ks[10], (DEPTH, CMP_HIDDEN, HEAD_DIM), CMP_HIDDEN ** -0.5),
        "w_branch_a": nrm(ks[11], (DEPTH, A_WIDTH, D_MODEL), A_WIDTH ** -0.5),
        "w_branch_b": nrm(ks[12], (DEPTH, B_WIDTH, D_MODEL), B_WIDTH ** -0.5),
        "w_out": nrm(ks[13], (DEPTH, D_MODEL, D_MODEL), D_MODEL ** -0.5),
        "ffn_norm_g": 1.0 + nrm(ks[14], (DEPTH, D_MODEL), 0.02),
        "w_gate": nrm(ks[15], (DEPTH, D_MODEL, D_FF), D_MODEL ** -0.5),
        "w_up": nrm(ks[16], (DEPTH, D_MODEL, D_FF), D_MODEL ** -0.5),
        "w_down": nrm(ks[17], (DEPTH, D_FF, D_MODEL), D_FF ** -0.5),
        "final_norm_g": 1.0 + nrm(ks[18], (D_MODEL,), 0.02),
    }


def reference(x, positions, attn_norm_g, w_in, diff_lambda, diff_subln_g, cmp_pe_k, cmp_pe_v,
              cmp_k_w1, cmp_k_w2, cmp_v_w1, cmp_v_w2, w_branch_a, w_branch_b, w_out,
              ffn_norm_g, w_gate, w_up, w_down, final_norm_g):
    cos, sin = rope_tables(positions, HEAD_DIM)
    h = x
    for layer in range(DEPTH):
        u = rms_norm(h, attn_norm_g[layer])
        h = h + hybrid_mixer(u, cos, sin, layer, w_in[layer], diff_lambda[layer], diff_subln_g[layer],
                             cmp_pe_k[layer], cmp_pe_v[layer], cmp_k_w1[layer], cmp_k_w2[layer],
                             cmp_v_w1[layer], cmp_v_w2[layer], w_branch_a[layer], w_branch_b[layer],
                             w_out[layer])
        u = rms_norm(h, ffn_norm_g[layer])
        h = h + swiglu(u, w_gate[layer], w_up[layer], w_down[layer])
    return rms_norm(h, final_norm_g)
```

```cpp
#include <hip/hip_runtime.h>
#include <hip/hip_cooperative_groups.h>
#include <cstdint>
#include <cstdio>
namespace cg = cooperative_groups;

#define LAS __attribute__((address_space(3)))
typedef unsigned short bf16_t;
typedef short bf16x8 __attribute__((ext_vector_type(8)));
typedef short s16x4 __attribute__((ext_vector_type(4)));
typedef float f32x4 __attribute__((ext_vector_type(4)));
typedef float f32x2 __attribute__((ext_vector_type(2)));
typedef float f32x16 __attribute__((ext_vector_type(16)));
typedef unsigned u32x4 __attribute__((ext_vector_type(4)));
typedef unsigned u32x2 __attribute__((ext_vector_type(2)));
typedef __bf16 bf16x2_t __attribute__((ext_vector_type(2)));

constexpr int NB = 8, S = 4096, T = NB * S, D = 1024, FF = 2816, FF2 = 2 * FF, INP = 5120;
constexpr float EPS = 1e-6f;
constexpr float C2 = 0.125f * 1.4426950408889634f;
constexpr float LAM_INIT = 0.2f;

constexpr size_t MiB = 1u << 20;
constexpr size_t WS_CTL = 0;
constexpr size_t WS_WIN = 1 * MiB, WS_WGU = 11 * MiB, WS_WD = 22 * MiB, WS_WO = 28 * MiB, WS_WA = 30 * MiB, WS_WB = 31 * MiB, WS_W1K = 32 * MiB, WS_W1V = 33 * MiB;
constexpr size_t WS_COS = 34 * MiB, WS_SIN = 38 * MiB;
constexpr size_t WS_RS1 = 42 * MiB, WS_SSQ2 = 43 * MiB, WS_SSQ3 = 45 * MiB, WS_NG = 47 * MiB, WS_BIASP = 50 * MiB;
constexpr size_t WS_GK = 52 * MiB, WS_GV = 60 * MiB, WS_KCMP = 68 * MiB, WS_VCMP = 69 * MiB;
constexpr size_t WS_XB = 70 * MiB;
constexpr size_t WS_DQ = 134 * MiB, WS_DK = 166 * MiB, WS_DV = 198 * MiB, WS_NQ = 230 * MiB;
constexpr size_t WS_KC = 262 * MiB, WS_VC = 270 * MiB, WS_KS = 278 * MiB, WS_VS = 286 * MiB, WS_KW = 294 * MiB, WS_VW = 302 * MiB;
constexpr size_t WS_ACT = 134 * MiB;
constexpr size_t WS_MG = 310 * MiB;
constexpr size_t WS_YA = 438 * MiB, WS_YB = 470 * MiB;
constexpr size_t WS_END = 502 * MiB;
constexpr int LDS_BYTES = 155648;

__device__ __forceinline__ unsigned cvtpk(float lo, float hi) { f32x2 v = {lo, hi}; bf16x2_t b = __builtin_convertvector(v, bf16x2_t); return __builtin_bit_cast(unsigned, b); }
__device__ __forceinline__ float bf2f(unsigned short h) { return __uint_as_float(((unsigned)h) << 16); }
__device__ __forceinline__ float bflo(unsigned w) { return __uint_as_float(w << 16); }
__device__ __forceinline__ float bfhi(unsigned w) { return __uint_as_float(w & 0xffff0000u); }
__device__ __forceinline__ float sigmoidf_(float x) { return 1.f / (1.f + __expf(-x)); }
__device__ __forceinline__ float wave_sum(float v) {
#pragma unroll
    for (int o = 1; o < 64; o <<= 1) v += __shfl_xor(v, o);
    return v;
}

namespace pg8 {
constexpr int BM = 256, BK = 64, HALF = 128, HTB = HALF * BK * 2, STAGE_BYTES = 8 * HTB, NXCD = 8, WGM = 8;
__host__ __device__ __forceinline__ int lds_byte(int r, int c) { const int st = (r >> 4) * 2 + (c >> 5), rr = r & 15, cc = c & 31, ob = rr * 64 + cc * 2; return st * 1024 + (ob ^ (((ob >> 9) & 1) << 5)); }
__host__ __device__ __forceinline__ void stage_rc(int b, int& R, int& C) { const int st = b / 1024, sb = b % 1024, swz = sb ^ (((sb >> 9) & 1) << 5); R = (st >> 1) * 16 + swz / 64; C = (st & 1) * 32 + (swz % 64) / 2; }
__host__ __device__ __forceinline__ int perm32(int rho) { const int n = rho >> 4, i = rho & 15; return 8 * (i >> 2) + 4 * n + (i & 3); }
struct Unit { int pm, pn; };
struct Gemm { const bf16_t* A; const bf16_t* Bt; int M, N, K; };
struct StaticOrder {
    int nM, nN, nwg, G, c;
    __host__ __device__ void init(int M, int N, int G_, int c_) { nM = M / BM; nN = N / BM; nwg = nM * nN; G = G_; c = c_; }
    __host__ __device__ bool next(int i, Unit& u) const {
        const long L = (long)i * G + c; if (L >= nwg) return false;
        int wgid = (int)L; { const int q = nwg / NXCD, r = nwg % NXCD, xcd = wgid % NXCD, off = wgid / NXCD; wgid = (xcd < r ? xcd * (q + 1) : r * (q + 1) + (xcd - r) * q) + off; }
        const int nig = WGM * nN, gid = wgid / nig, fm = gid * WGM, gsz = (nM - fm) < WGM ? (nM - fm) : WGM;
        u.pm = fm + ((wgid % nig) % gsz); u.pn = (wgid % nig) / gsz; return true;
    }
};
template <class Epi, bool ALIGN_EPI>
__device__ __forceinline__ void gemm_phase(LAS unsigned char* lds, const Gemm g, const StaticOrder& S, const Epi& E) {
    int tid_ = threadIdx.x; asm volatile("" : "+v"(tid_));
    const int tid = tid_, wid = __builtin_amdgcn_readfirstlane(tid >> 6), lane = tid & 63, wr = wid >> 2, wc = wid & 3, fr = lane & 15, fq = lane >> 4;
    const int K = g.K, nt = K / BK;
    unsigned voffA[2], voffB[2];
#pragma unroll
    for (int i = 0; i < 2; ++i) { int R, C; stage_rc(tid * 16 + i * 8192, R, C); const int Rb = (R & ~31) + perm32(R & 31);
        voffA[i] = (unsigned)(R * K + C) * 2u; voffB[i] = (unsigned)(Rb * K + C) * 2u; }
    const size_t kstep = (size_t)(BK * 2);
    const size_t hstep = (size_t)HALF * K * 2;
    const size_t tstep = 2 * hstep;
    const unsigned ldsw = (unsigned)wid * 1024u;
    const int aoff = lds_byte(wr * 64 + fr, fq * 8), boff = lds_byte(wc * 32 + fr, fq * 8);
#define PG8_SA(b, h) (((b) * 2 + (h)) * HTB)
#define PG8_SB(b, h) ((4 + (b) * 2 + (h)) * HTB)
#define PG8_STAGE(bufoff, gbase, voff) do { _Pragma("unroll") for (int _i = 0; _i < 2; ++_i) \
        __builtin_amdgcn_global_load_lds((const unsigned*)((const char*)(gbase) + (voff)[_i]), (LAS unsigned*)(lds + (bufoff) + ldsw + _i * 8192), 16, 0, 0); } while (0)
#define PG8_LDA(dst, b, h) do { _Pragma("unroll") for (int m = 0; m < 4; ++m) _Pragma("unroll") for (int k = 0; k < 2; ++k) dst[m][k] = *(const LAS bf16x8*)(lds + PG8_SA(b, h) + aoff + m * 2048 + k * 1024); } while (0)
#define PG8_LDB(dst, b, h) do { _Pragma("unroll") for (int n = 0; n < 2; ++n) _Pragma("unroll") for (int k = 0; k < 2; ++k) dst[n][k] = *(const LAS bf16x8*)(lds + PG8_SB(b, h) + boff + n * 2048 + k * 1024); } while (0)
#define PG8_MMA(ai, bj, At, Bt) do { __builtin_amdgcn_s_setprio(1); _Pragma("unroll") for (int m = 0; m < 4; ++m) _Pragma("unroll") for (int n = 0; n < 2; ++n) _Pragma("unroll") for (int k = 0; k < 2; ++k) \
        acc[ai][bj][m][n] = __builtin_amdgcn_mfma_f32_16x16x32_bf16(Bt[n][k], At[m][k], acc[ai][bj][m][n], 0, 0, 0); __builtin_amdgcn_s_setprio(0); } while (0)
#define PG8_WAIT_V(n) asm volatile("s_waitcnt vmcnt(" #n ")" ::: "memory")
#define PG8_WAIT_L(n) asm volatile("s_waitcnt lgkmcnt(" #n ")" ::: "memory")
#define PG8_BAR __builtin_amdgcn_s_barrier()
#define PG8_SCHED __builtin_amdgcn_sched_barrier(0)
    Unit cur, nxt; int ui = 0;
    if (!S.next(0, cur)) return;
    f32x4 acc[2][2][4][2];
#pragma unroll
    for (int a = 0; a < 2; ++a)
#pragma unroll
        for (int b = 0; b < 2; ++b)
#pragma unroll
            for (int m = 0; m < 4; ++m)
#pragma unroll
                for (int n = 0; n < 2; ++n) acc[a][b][m][n] = (f32x4){0.f, 0.f, 0.f, 0.f};
    bf16x8 At[4][2], B0[2][2], B1[2][2];
    const char* cA = (const char*)g.A + (size_t)cur.pm * tstep; const char* cB = (const char*)g.Bt + (size_t)cur.pn * tstep;
    PG8_STAGE(PG8_SB(0, 0), cB, voffB); PG8_STAGE(PG8_SB(0, 1), cB + hstep, voffB); PG8_STAGE(PG8_SA(0, 0), cA, voffA); PG8_STAGE(PG8_SA(0, 1), cA + hstep, voffA);
    if (wr == 1) PG8_BAR;
    PG8_WAIT_V(2); PG8_BAR;
    PG8_STAGE(PG8_SB(1, 0), cB + kstep, voffB); PG8_STAGE(PG8_SA(1, 0), cA + kstep, voffA); PG8_STAGE(PG8_SB(1, 1), cB + hstep + kstep, voffB);
    PG8_WAIT_V(6); PG8_BAR;
    for (;;) {
        const bool has_next = S.next(ui + 1, nxt);
        const char* nA = has_next ? (const char*)g.A + (size_t)nxt.pm * tstep : cA; const char* nB = has_next ? (const char*)g.Bt + (size_t)nxt.pn * tstep : cB;
        for (int t = 0; t < nt; t += 2) {
            const bool last = (t == nt - 2);
            const char* a1 = cA + (size_t)(t + 1) * kstep;
            const char* a2 = last ? nA : cA + (size_t)(t + 2) * kstep; const char* b2 = last ? nB : cB + (size_t)(t + 2) * kstep;
            const char* a3 = a2 + kstep; const char* b3 = b2 + kstep;
            PG8_LDB(B0, 0, 0); PG8_LDB(B1, 0, 1); PG8_SCHED; PG8_LDA(At, 0, 0); PG8_STAGE(PG8_SA(1, 1), a1 + hstep, voffA);
            PG8_WAIT_V(8); PG8_WAIT_L(0); PG8_BAR; PG8_MMA(0, 0, At, B0); PG8_MMA(0, 1, At, B1); PG8_BAR; PG8_SCHED;
            PG8_LDA(At, 0, 1); PG8_STAGE(PG8_SB(0, 0), b2, voffB); PG8_STAGE(PG8_SB(0, 1), b2 + hstep, voffB); PG8_STAGE(PG8_SA(0, 0), a2, voffA);
            PG8_WAIT_V(8); PG8_WAIT_L(0); PG8_BAR; PG8_MMA(1, 0, At, B0); PG8_MMA(1, 1, At, B1); PG8_BAR; PG8_SCHED;
            PG8_LDB(B0, 1, 0); PG8_LDB(B1, 1, 1); PG8_SCHED; PG8_LDA(At, 1, 0); PG8_STAGE(PG8_SA(0, 1), a2 + hstep, voffA);
            PG8_WAIT_V(8); PG8_WAIT_L(0); PG8_BAR; PG8_MMA(0, 0, At, B0); PG8_MMA(0, 1, At, B1); PG8_BAR; PG8_SCHED;
            PG8_LDA(At, 1, 1); PG8_STAGE(PG8_SB(1, 0), b3, voffB); PG8_STAGE(PG8_SB(1, 1), b3 + hstep, voffB); PG8_STAGE(PG8_SA(1, 0), a3, voffA);
            PG8_WAIT_V(8); PG8_WAIT_L(0); PG8_BAR; PG8_MMA(1, 0, At, B0); PG8_MMA(1, 1, At, B1); PG8_BAR; PG8_SCHED;
        }
        if constexpr (ALIGN_EPI) { if (wr == 0) PG8_BAR; }
        E(acc, cur, wr, wc, fr, fq);
        if (!has_next) break;
#pragma unroll
        for (int a = 0; a < 2; ++a)
#pragma unroll
            for (int b = 0; b < 2; ++b)
#pragma unroll
                for (int m = 0; m < 4; ++m)
#pragma unroll
                    for (int n = 0; n < 2; ++n) acc[a][b][m][n] = (f32x4){0.f, 0.f, 0.f, 0.f};
        cur = nxt; cA = nA; cB = nB; ++ui;
        if constexpr (ALIGN_EPI) { if (wr == 1) PG8_BAR; }
    }
    PG8_WAIT_V(0);
    if constexpr (!ALIGN_EPI) { if (wr == 0) PG8_BAR; }
    PG8_BAR;
#undef PG8_SA
#undef PG8_SB
#undef PG8_STAGE
#undef PG8_LDA
#undef PG8_LDB
#undef PG8_MMA
#undef PG8_WAIT_V
#undef PG8_WAIT_L
#undef PG8_BAR
#undef PG8_SCHED
}
}

typedef f32x4 AccT[2][2][4][2];

struct EpiProj {
    const float* rs1; const float* cosT; const float* sinT;
    unsigned char* ws;
    __device__ __forceinline__ void operator()(const AccT& acc, const pg8::Unit& u, int wr, int wc, int fr, int fq) const {
        const int row0 = u.pm * 256 + wr * 64 + fr;
#pragma unroll
        for (int bj = 0; bj < 2; ++bj) {
            const int sec = u.pn * 2 + bj;
            if (sec >= 39) continue;
            if (sec == 38) {
                if (wc == 0 && fq < 3) {
                    float* NG = (float*)(ws + WS_NG);
#pragma unroll
                    for (int ai = 0; ai < 2; ++ai)
#pragma unroll
                        for (int m = 0; m < 4; ++m) { const int r = row0 + ai * 128 + m * 16; const float rs = rs1[r];
                            f32x4 v0 = acc[ai][bj][m][0] * rs, v1 = acc[ai][bj][m][1] * rs;
                            f32x4 o0, o1;
#pragma unroll
                            for (int i = 0; i < 4; ++i) { o0[i] = sigmoidf_(v0[i]); o1[i] = sigmoidf_(v1[i]); }
                            *(f32x4*)(NG + (size_t)r * 24 + fq * 8) = o0; *(f32x4*)(NG + (size_t)r * 24 + fq * 8 + 4) = o1; }
                }
                continue;
            }
            if (sec >= 22) {
                bf16_t* MG = (bf16_t*)(ws + WS_MG);
                const int col = (sec - 22) * 128 + wc * 32 + fq * 8;
#pragma unroll
                for (int ai = 0; ai < 2; ++ai)
#pragma unroll
                    for (int m = 0; m < 4; ++m) { const int r = row0 + ai * 128 + m * 16; const float rs = rs1[r];
                        f32x4 v0 = acc[ai][bj][m][0] * rs, v1 = acc[ai][bj][m][1] * rs;
                        u32x4 w; w.x = cvtpk(sigmoidf_(v0[0]), sigmoidf_(v0[1])); w.y = cvtpk(sigmoidf_(v0[2]), sigmoidf_(v0[3]));
                        w.z = cvtpk(sigmoidf_(v1[0]), sigmoidf_(v1[1])); w.w = cvtpk(sigmoidf_(v1[2]), sigmoidf_(v1[3]));
                        *(u32x4*)(MG + (size_t)r * 2048 + col) = w; }
                continue;
            }
            bf16_t* base; int H, head, HD, coff; bool rope; float scale = 1.f;
            if (sec < 4)       { base = (bf16_t*)(ws + WS_DQ); H = 4; head = sec;      HD = 128; coff = (wc >> 1) * 64; rope = true; scale = C2; }
            else if (sec < 8)  { base = (bf16_t*)(ws + WS_DK); H = 4; head = sec - 4;  HD = 128; coff = (wc >> 1) * 64; rope = true; }
            else if (sec < 12) { base = (bf16_t*)(ws + WS_DV); H = 4; head = sec - 8;  HD = 128; coff = (wc >> 1) * 64; rope = false; }
            else if (sec < 16) { base = (bf16_t*)(ws + WS_NQ); H = 8; head = (sec - 12) * 2 + (wc >> 1); HD = 64; coff = 0; rope = true; scale = C2; }
            else { const int k6 = sec - 16; base = (bf16_t*)(ws + WS_KC + (size_t)k6 * 8 * MiB); H = 2; head = wc >> 1; HD = 64; coff = 0; rope = (k6 & 1) == 0; }
            const int j = 4 * (wc & 1) + fq;
#pragma unroll
            for (int ai = 0; ai < 2; ++ai)
#pragma unroll
                for (int m = 0; m < 4; ++m) { const int r = row0 + ai * 128 + m * 16; const float rs = rs1[r] * scale;
                    const int b = r >> 12, s = r & 4095;
                    bf16_t* p = base + ((size_t)(b * H + head) * S + s) * HD + coff;
                    f32x4 v0 = acc[ai][bj][m][0] * rs, v1 = acc[ai][bj][m][1] * rs;
                    if (rope) {
                        const f32x4 c = *(const f32x4*)(cosT + (size_t)r * 32 + 4 * j), sn = *(const f32x4*)(sinT + (size_t)r * 32 + 4 * j);
                        const f32x4 o1 = v0 * c - v1 * sn, o2 = v1 * c + v0 * sn;
                        u32x2 w1, w2; w1.x = cvtpk(o1[0], o1[1]); w1.y = cvtpk(o1[2], o1[3]); w2.x = cvtpk(o2[0], o2[1]); w2.y = cvtpk(o2[2], o2[3]);
                        *(u32x2*)(p + 4 * j) = w1; *(u32x2*)(p + 32 + 4 * j) = w2;
                    } else {
                        u32x4 w; w.x = cvtpk(v0[0], v0[1]); w.y = cvtpk(v0[2], v0[3]); w.z = cvtpk(v1[0], v1[1]); w.w = cvtpk(v1[2], v1[3]);
                        *(u32x4*)(p + 8 * j) = w;
                    }
                }
        }
    }
};
struct EpiF32 {
    float* O; int ldc;
    __device__ __forceinline__ void operator()(const AccT& acc, const pg8::Unit& u, int wr, int wc, int fr, int fq) const {
        const int row0 = u.pm * 256 + wr * 64 + fr, col0 = u.pn * 256 + wc * 32 + fq * 8;
#pragma unroll
        for (int ai = 0; ai < 2; ++ai)
#pragma unroll
            for (int m = 0; m < 4; ++m)
#pragma unroll
                for (int bj = 0; bj < 2; ++bj) { float* p = O + (size_t)(row0 + ai * 128 + m * 16) * ldc + col0 + bj * 128;
                    *(f32x4*)p = acc[ai][bj][m][0]; *(f32x4*)(p + 4) = acc[ai][bj][m][1]; }
    }
};
template <bool SECOND> struct EpiBranch {
    bf16_t* MERGED; const bf16_t* MG;
    __device__ __forceinline__ void operator()(const AccT& acc, const pg8::Unit& u, int wr, int wc, int fr, int fq) const {
        const int row0 = u.pm * 256 + wr * 64 + fr, col0 = u.pn * 256 + wc * 32 + fq * 8;
#pragma unroll
        for (int ai = 0; ai < 2; ++ai)
#pragma unroll
            for (int m = 0; m < 4; ++m)
#pragma unroll
                for (int bj = 0; bj < 2; ++bj) { const int r = row0 + ai * 128 + m * 16, c = col0 + bj * 128;
                    const u32x4 g = *(const u32x4*)(MG + (size_t)r * 2048 + (SECOND ? 1024 : 0) + c);
                    const f32x4 a0 = acc[ai][bj][m][0], a1 = acc[ai][bj][m][1];
                    float o[8] = {bflo(g.x) * a0[0], bfhi(g.x) * a0[1], bflo(g.y) * a0[2], bfhi(g.y) * a0[3], bflo(g.z) * a1[0], bfhi(g.z) * a1[1], bflo(g.w) * a1[2], bfhi(g.w) * a1[3]};
                    bf16_t* p = MERGED + (size_t)r * 1024 + c;
                    if (SECOND) { const u32x4 pv = *(const u32x4*)p;
                        o[0] += bflo(pv.x); o[1] += bfhi(pv.x); o[2] += bflo(pv.y); o[3] += bfhi(pv.y); o[4] += bflo(pv.z); o[5] += bfhi(pv.z); o[6] += bflo(pv.w); o[7] += bfhi(pv.w); }
                    u32x4 w; w.x = cvtpk(o[0], o[1]); w.y = cvtpk(o[2], o[3]); w.z = cvtpk(o[4], o[5]); w.w = cvtpk(o[6], o[7]);
                    *(u32x4*)p = w; }
    }
};
template <bool WRITE_BF> struct EpiResid {
    const float* base; float* out; bf16_t* HB; float* SSQ;
    __device__ __forceinline__ void operator()(const AccT& acc, const pg8::Unit& u, int wr, int wc, int fr, int fq) const {
        const int row0 = u.pm * 256 + wr * 64 + fr, col0 = u.pn * 256 + wc * 32 + fq * 8;
#pragma unroll
        for (int ai = 0; ai < 2; ++ai)
#pragma unroll
            for (int m = 0; m < 4; ++m) { const int r = row0 + ai * 128 + m * 16; float ss = 0.f;
#pragma unroll
                for (int bj = 0; bj < 2; ++bj) { const size_t off = (size_t)r * 1024 + col0 + bj * 128;
                    const f32x4 h0 = *(const f32x4*)(base + off) + acc[ai][bj][m][0], h1 = *(const f32x4*)(base + off + 4) + acc[ai][bj][m][1];
                    *(f32x4*)(out + off) = h0; *(f32x4*)(out + off + 4) = h1;
                    ss += (h0[0] * h0[0] + h0[1] * h0[1]) + (h0[2] * h0[2] + h0[3] * h0[3]) + (h1[0] * h1[0] + h1[1] * h1[1]) + (h1[2] * h1[2] + h1[3] * h1[3]);
                    if (WRITE_BF) { u32x4 w; w.x = cvtpk(h0[0], h0[1]); w.y = cvtpk(h0[2], h0[3]); w.z = cvtpk(h1[0], h1[1]); w.w = cvtpk(h1[2], h1[3]); *(u32x4*)(HB + off) = w; } }
                ss += __shfl_xor(ss, 16); ss += __shfl_xor(ss, 32);
                if (fq == 0) SSQ[(size_t)r * 16 + u.pn * 4 + wc] = ss; }
    }
};
struct EpiGU {
    const float* SSQ2; bf16_t* ACT;
    __device__ __forceinline__ void operator()(const AccT& acc, const pg8::Unit& u, int wr, int wc, int fr, int fq) const {
        const int row0 = u.pm * 256 + wr * 64 + fr, col0 = u.pn * 128 + wc * 16 + fq * 4;
#pragma unroll
        for (int ai = 0; ai < 2; ++ai)
#pragma unroll
            for (int m = 0; m < 4; ++m) { const int r = row0 + ai * 128 + m * 16;
                const f32x4* sp = (const f32x4*)(SSQ2 + (size_t)r * 16); const f32x4 s0 = sp[0], s1 = sp[1], s2 = sp[2], s3 = sp[3];
                const float tot = ((s0[0] + s0[1]) + (s0[2] + s0[3])) + ((s1[0] + s1[1]) + (s1[2] + s1[3])) + ((s2[0] + s2[1]) + (s2[2] + s2[3])) + ((s3[0] + s3[1]) + (s3[2] + s3[3]));
                const float rs = rsqrtf(tot * (1.f / 1024.f) + EPS);
#pragma unroll
                for (int bj = 0; bj < 2; ++bj) { const f32x4 gv = acc[ai][bj][m][0] * rs, uv = acc[ai][bj][m][1] * rs; float o[4];
#pragma unroll
                    for (int i = 0; i < 4; ++i) o[i] = gv[i] * sigmoidf_(gv[i]) * uv[i];
                    u32x2 w; w.x = cvtpk(o[0], o[1]); w.y = cvtpk(o[2], o[3]);
                    *(u32x2*)(ACT + (size_t)r * FF + col0 + bj * 64) = w; } }
    }
};

__device__ __forceinline__ int crow(int r, int hi) { return (r & 3) + 8 * (r >> 2) + 4 * hi; }
__device__ __forceinline__ void qkt(f32x16& p0, f32x16& p1, const LAS unsigned char* Kslot, const bf16x8* qr, int r32, int hi) {
    const LAS unsigned char* kb = Kslot + hi * 1024 + r32 * 16;
    const f32x16 zz = f32x16{};
#pragma unroll
    for (int d0 = 0; d0 < 4; ++d0) {
        const bf16x8 b0 = *(const LAS bf16x8*)(kb + d0 * 2048);
        const bf16x8 b1 = *(const LAS bf16x8*)(kb + d0 * 2048 + 512);
        if (d0 == 0) { p0 = __builtin_amdgcn_mfma_f32_32x32x16_bf16(b0, qr[0], zz, 0, 0, 0); p1 = __builtin_amdgcn_mfma_f32_32x32x16_bf16(b1, qr[0], zz, 0, 0, 0); }
        else { p0 = __builtin_amdgcn_mfma_f32_32x32x16_bf16(b0, qr[d0], p0, 0, 0, 0); p1 = __builtin_amdgcn_mfma_f32_32x32x16_bf16(b1, qr[d0], p1, 0, 0, 0); }
    }
}
__device__ __forceinline__ s16x4 vtr(const LAS unsigned char* p) { return __builtin_bit_cast(s16x4, __builtin_amdgcn_ds_read_tr16_b64_v4i16((LAS s16x4*)p)); }
template <int NDB> struct Flash {
    f32x16 o[NDB]; float mhat, l; bool first;
    __device__ __forceinline__ void reset() {
#pragma unroll
        for (int d = 0; d < NDB; ++d) o[d] = f32x16{};
        mhat = 0.f; l = 0.f; first = true; }
    __device__ __forceinline__ void softmax(f32x16& p0, f32x16& p1, LAS float* wsf, int r32, int hi) {
        float a = fmaxf(p0[0], p1[0]);
#pragma unroll
        for (int r = 1; r < 16; ++r) a = fmaxf(a, fmaxf(p0[r], p1[r]));
        const float rm = fmaxf(a, __shfl_xor(a, 32)) - mhat;
        bool need; float dl;
        if (first) { need = true; dl = (rm > -1e30f) ? rm : 0.f; }
        else { need = __any(rm > 8.0f); dl = fmaxf(rm, 0.f); }
        if (need) {
            mhat += dl;
            if (!first) {
                const float f = __builtin_amdgcn_exp2f(-dl); l *= f;
                if (hi == 0) wsf[r32] = f;
                asm volatile("s_waitcnt lgkmcnt(0)" ::: "memory");
#pragma unroll
                for (int k = 0; k < 4; ++k) { const f32x4 t = *(const LAS f32x4*)(wsf + 8 * k + 4 * hi);
#pragma unroll
                    for (int d = 0; d < NDB; ++d) { o[d][4 * k] *= t[0]; o[d][4 * k + 1] *= t[1]; o[d][4 * k + 2] *= t[2]; o[d][4 * k + 3] *= t[3]; } }
                asm volatile("s_waitcnt lgkmcnt(0)" ::: "memory");
            }
        }
        first = false;
        float s = 0.f;
#pragma unroll
        for (int r = 0; r < 16; ++r) { p0[r] = __builtin_amdgcn_exp2f(p0[r] - mhat); p1[r] = __builtin_amdgcn_exp2f(p1[r] - mhat); s += p0[r] + p1[r]; }
        l += s;
    }
    __device__ __forceinline__ void pv(const f32x16& p0, const f32x16& p1, const LAS unsigned char* Vslot, int lane, int hi) {
        u32x4 pw[4];
        pw[0] = (u32x4){cvtpk(p0[0], p0[1]), cvtpk(p0[2], p0[3]), cvtpk(p0[4], p0[5]), cvtpk(p0[6], p0[7])};
        pw[1] = (u32x4){cvtpk(p0[8], p0[9]), cvtpk(p0[10], p0[11]), cvtpk(p0[12], p0[13]), cvtpk(p0[14], p0[15])};
        pw[2] = (u32x4){cvtpk(p1[0], p1[1]), cvtpk(p1[2], p1[3]), cvtpk(p1[4], p1[5]), cvtpk(p1[6], p1[7])};
        pw[3] = (u32x4){cvtpk(p1[8], p1[9]), cvtpk(p1[10], p1[11]), cvtpk(p1[12], p1[13]), cvtpk(p1[14], p1[15])};
        const LAS unsigned char* vp = Vslot + ((lane >> 4) & 1) * 32 + (lane & 3) * 8 + (4 * hi + ((lane & 15) >> 2)) * 64;
#pragma unroll
        for (int d = 0; d < NDB; ++d)
#pragma unroll
            for (int ks = 0; ks < 4; ++ks) {
                const s16x4 lo = vtr(vp + (d * 4 + ks) * 1024), hh = vtr(vp + (d * 4 + ks) * 1024 + 512);
                const bf16x8 vf = (bf16x8){lo[0], lo[1], lo[2], lo[3], hh[0], hh[1], hh[2], hh[3]};
                o[d] = __builtin_amdgcn_mfma_f32_32x32x16_bf16(__builtin_bit_cast(bf16x8, pw[ks]), vf, o[d], 0, 0, 0);
            }
    }
    __device__ __forceinline__ float ltot() const { return l + __shfl_xor(l, 32); }
};
__device__ __forceinline__ void row_bcast(float v, float (&fr_)[16], LAS float* wsf, int r32, int hi) {
    asm volatile("s_waitcnt lgkmcnt(0)" ::: "memory");
    if (hi == 0) wsf[r32] = v;
    asm volatile("s_waitcnt lgkmcnt(0)" ::: "memory");
#pragma unroll
    for (int k = 0; k < 4; ++k) { const f32x4 t = *(const LAS f32x4*)(wsf + 8 * k + 4 * hi); fr_[4 * k] = t[0]; fr_[4 * k + 1] = t[1]; fr_[4 * k + 2] = t[2]; fr_[4 * k + 3] = t[3]; }
    asm volatile("s_waitcnt lgkmcnt(0)" ::: "memory");
}

constexpr int DF_BUF = 32768;
constexpr int DF_STAGE = 65536;
constexpr int DF_WSF = DF_STAGE + 4 * 32 * 132 * 4;
__device__ __forceinline__ void diff_unit(LAS unsigned char* L, int b, int h, int qb, const unsigned char* ws, float lam, const float* subg) {
    int tid_ = threadIdx.x; asm volatile("" : "+v"(tid_));
    const int tid = tid_, lane = tid & 63, r32 = lane & 31, hi = lane >> 5, wid = __builtin_amdgcn_readfirstlane(tid >> 6);
    const int comp = wid >> 2, rgi = wid & 3;
    const size_t bh = (size_t)(b * 4 + h) * S;
    const bf16_t* Qp = (const bf16_t*)(ws + WS_DQ) + (bh + qb * 128 + rgi * 32 + r32) * 128 + comp * 64;
    bf16x8 qr[4];
#pragma unroll
    for (int d0 = 0; d0 < 4; ++d0) qr[d0] = *(const bf16x8*)(Qp + d0 * 16 + hi * 8);
    const bf16_t* Kg = (const bf16_t*)(ws + WS_DK) + bh * 128 + (size_t)lane * 128 + wid * 8;
    const bf16_t* Vg = (const bf16_t*)(ws + WS_DV) + bh * 128 + (size_t)(16 * (wid & 3) + (lane >> 2)) * 128 + (wid >> 2) * 32 + (lane & 3) * 8;
    LAS float* wsf = (LAS float*)(L + DF_WSF) + wid * 32;
    const int NT = 2 * qb + 2;
    Flash<4> F; F.reset();
    u32x4 sk0, sk1, sv0, sv1;
    { const size_t o = 0; sk0 = *(const u32x4*)(Kg + o); sk1 = *(const u32x4*)(Kg + o + 64); sv0 = *(const u32x4*)(Vg + o); sv1 = *(const u32x4*)(Vg + o + 64); }
    { LAS unsigned char* B = L; *(LAS u32x4*)(B + wid * 1024 + lane * 16) = sk0; *(LAS u32x4*)(B + 8192 + wid * 1024 + lane * 16) = sk1;
      *(LAS u32x4*)(B + 16384 + wid * 1024 + lane * 16) = sv0; *(LAS u32x4*)(B + 16384 + (wid + 8) * 1024 + lane * 16) = sv1; }
    __syncthreads();
    for (int t = 0; t < NT; ++t) {
        LAS unsigned char* B = L + (t & 1) * DF_BUF;
        const bool more = (t + 1 < NT);
        if (more) { const size_t o = (size_t)(t + 1) * 64 * 128; sk0 = *(const u32x4*)(Kg + o); sk1 = *(const u32x4*)(Kg + o + 64); sv0 = *(const u32x4*)(Vg + o); sv1 = *(const u32x4*)(Vg + o + 64); }
        const bool active = !(t == NT - 1 && rgi < 2);
        if (active) {
            f32x16 p0, p1;
            qkt(p0, p1, B + comp * 8192, qr, r32, hi);
            if (t >= NT - 2) {
                const int ql = 32 * rgi + r32 - 64 * (t - (NT - 2));
#pragma unroll
                for (int r = 0; r < 16; ++r) { const int kv = crow(r, hi); if (kv > ql) p0[r] = -INFINITY; if (kv + 32 > ql) p1[r] = -INFINITY; }
            }
            F.softmax(p0, p1, wsf, r32, hi);
            F.pv(p0, p1, B + 16384, lane, hi);
        }
        if (more) { LAS unsigned char* Bn = L + ((t + 1) & 1) * DF_BUF;
            *(LAS u32x4*)(Bn + wid * 1024 + lane * 16) = sk0; *(LAS u32x4*)(Bn + 8192 + wid * 1024 + lane * 16) = sk1;
            *(LAS u32x4*)(Bn + 16384 + wid * 1024 + lane * 16) = sv0; *(LAS u32x4*)(Bn + 16384 + (wid + 8) * 1024 + lane * 16) = sv1; }
        __syncthreads();
    }
    const float lt = F.ltot();
    float fr_[16];
    row_bcast((comp ? lam : 1.f) / lt, fr_, wsf, r32, hi);
    LAS float* stg = (LAS float*)(L + DF_STAGE) + rgi * 32 * 132;
    if (comp == 1) {
#pragma unroll
        for (int d = 0; d < 4; ++d)
#pragma unroll
            for (int r = 0; r < 16; ++r) stg[crow(r, hi) * 132 + d * 32 + r32] = F.o[d][r] * fr_[r];
    }
    __syncthreads();
    if (comp == 0) {
#pragma unroll
        for (int d = 0; d < 4; ++d)
#pragma unroll
            for (int r = 0; r < 16; ++r) { const int ix = crow(r, hi) * 132 + d * 32 + r32; stg[ix] = F.o[d][r] * fr_[r] - stg[ix]; }
        asm volatile("s_waitcnt lgkmcnt(0)" ::: "memory");
        const LAS float* rowp = stg + r32 * 132 + 64 * hi;
        float ss = 0.f;
#pragma unroll
        for (int k = 0; k < 16; ++k) { const f32x4 v = *(const LAS f32x4*)(rowp + 4 * k); ss += (v[0] * v[0] + v[1] * v[1]) + (v[2] * v[2] + v[3] * v[3]); }
        ss += __shfl_xor(ss, 32);
        const float rstd = rsqrtf(ss * (1.f / 128.f) + EPS) * (1.f - LAM_INIT);
        bf16_t* Yp = (bf16_t*)(ws + WS_YA) + ((size_t)b * S + qb * 128 + rgi * 32 + r32) * 512 + h * 128 + 64 * hi;
#pragma unroll
        for (int k = 0; k < 8; ++k) { const f32x4 v0 = *(const LAS f32x4*)(rowp + 8 * k), v1 = *(const LAS f32x4*)(rowp + 8 * k + 4);
            const f32x4 g0 = *(const f32x4*)(subg + 64 * hi + 8 * k), g1 = *(const f32x4*)(subg + 64 * hi + 8 * k + 4);
            u32x4 w; w.x = cvtpk(v0[0] * rstd * g0[0], v0[1] * rstd * g0[1]); w.y = cvtpk(v0[2] * rstd * g0[2], v0[3] * rstd * g0[3]);
            w.z = cvtpk(v1[0] * rstd * g1[0], v1[1] * rstd * g1[1]); w.w = cvtpk(v1[2] * rstd * g1[2], v1[3] * rstd * g1[3]);
            *(u32x4*)(Yp + 8 * k) = w; }
    }
    __syncthreads();
}

constexpr int NS_BUF = 16384;
constexpr int NS_CMP = 32768;
constexpr int NS_GL = 98304;
constexpr int NS_WSF = 131072;
template <class MaskF>
__device__ __forceinline__ void nsa_kv_pass(LAS unsigned char* L, Flash<2>& F, const bf16x8* qr, const bf16_t* Kg0, const bf16_t* Vg0, int jlo, int jhi, unsigned long long wave_tiles,
                                            LAS float* wsf, int wid, int lane, int r32, int hi, const MaskF& mask) {
    u32x4 sk, sv;
    sk = *(const u32x4*)(Kg0 + (size_t)jlo * 4096); sv = *(const u32x4*)(Vg0 + (size_t)jlo * 4096);
    *(LAS u32x4*)(L + wid * 1024 + lane * 16) = sk; *(LAS u32x4*)(L + 8192 + wid * 1024 + lane * 16) = sv;
    __syncthreads();
    for (int j = jlo; j <= jhi; ++j) {
        LAS unsigned char* B = L + ((j - jlo) & 1) * NS_BUF;
        const bool more = j < jhi;
        if (more) { sk = *(const u32x4*)(Kg0 + (size_t)(j + 1) * 4096); sv = *(const u32x4*)(Vg0 + (size_t)(j + 1) * 4096); }
        if ((wave_tiles >> j) & 1ull) {
            f32x16 p0, p1;
            qkt(p0, p1, B, qr, r32, hi);
            mask(p0, p1, j);
            F.softmax(p0, p1, wsf, r32, hi);
            F.pv(p0, p1, B + 8192, lane, hi);
        }
        if (more) { LAS unsigned char* Bn = L + ((j + 1 - jlo) & 1) * NS_BUF; *(LAS u32x4*)(Bn + wid * 1024 + lane * 16) = sk; *(LAS u32x4*)(Bn + 8192 + wid * 1024 + lane * 16) = sv; }
        __syncthreads();
    }
}
__device__ __forceinline__ void nsa_unit(LAS unsigned char* L, int b, int g, int qblk, const unsigned char* ws) {
    int tid_ = threadIdx.x; asm volatile("" : "+v"(tid_));
    const int tid = tid_, lane = tid & 63, r32 = lane & 31, hi = lane >> 5, wid = __builtin_amdgcn_readfirstlane(tid >> 6);
    const int ql = 8 * wid + (r32 & 7), hh = r32 >> 3, head = g * 4 + hh;
    const int qpos = 64 * qblk + ql;
    const size_t tok = (size_t)b * S + qpos;
    const bf16_t* Qp = (const bf16_t*)(ws + WS_NQ) + ((size_t)(b * 8 + head) * S + qpos) * 64;
    bf16x8 qr[4];
#pragma unroll
    for (int d0 = 0; d0 < 4; ++d0) qr[d0] = *(const bf16x8*)(Qp + d0 * 16 + hi * 8);
    const float* NGp = (const float*)(ws + WS_NG) + tok * 24 + head;
    const float g0 = NGp[0], g1 = NGp[8], g2 = NGp[16];
    LAS float* wsf = (LAS float*)(L + NS_WSF) + wid * 32;
    const size_t pg = (size_t)(b * 2 + g);
    LAS float* yst = (LAS float*)(L + NS_CMP) + wid * 2048;
    float fr_[16];
    unsigned long long mymask = 0ull, anymask = 0ull;
    {
        const int ntc = ((4 * qblk + 2) >> 6) + 1;
        const bf16_t* Kc = (const bf16_t*)(ws + WS_KCMP) + (pg * 256 + lane) * 64 + wid * 8;
        const bf16_t* Vc = (const bf16_t*)(ws + WS_VCMP) + (pg * 256 + 16 * (wid & 3) + (lane >> 2)) * 64 + (wid >> 2) * 32 + (lane & 3) * 8;
        for (int ct = 0; ct < ntc; ++ct) {
            const u32x4 k = *(const u32x4*)(Kc + (size_t)ct * 4096), v = *(const u32x4*)(Vc + (size_t)ct * 4096);
            *(LAS u32x4*)(L + NS_CMP + ct * 8192 + wid * 1024 + lane * 16) = k; *(LAS u32x4*)(L + NS_CMP + 32768 + ct * 8192 + wid * 1024 + lane * 16) = v;
        }
        __syncthreads();
        const int cm = (qpos >= 31) ? ((qpos - 31) >> 4) : -1;
        Flash<2> F; F.reset();
        for (int ct = 0; ct < ntc; ++ct) {
            f32x16 p0, p1;
            qkt(p0, p1, L + NS_CMP + ct * 8192, qr, r32, hi);
#pragma unroll
            for (int r = 0; r < 16; ++r) { const int c = 64 * ct + crow(r, hi); if (c > cm) p0[r] = -INFINITY; if (c + 32 > cm) p1[r] = -INFINITY; }
            F.softmax(p0, p1, wsf, r32, hi);
            F.pv(p0, p1, L + NS_CMP + 32768 + ct * 8192, lane, hi);
        }
        const float lt = F.ltot();
        const float il = lt > 0.f ? 1.f / lt : 0.f;
        LAS float* Gs = (LAS float*)(L + NS_GL) + wid * 1024;
        LAS float* Ls = Gs + 512;
        for (int ct = 0; ct < ntc; ++ct) {
            f32x16 p0, p1;
            qkt(p0, p1, L + NS_CMP + ct * 8192, qr, r32, hi);
#pragma unroll
            for (int r = 0; r < 16; ++r) { const int c = 64 * ct + crow(r, hi);
                float a = (c > cm) ? 0.f : __builtin_amdgcn_exp2f(p0[r] - F.mhat) * il, bq = (c + 32 > cm) ? 0.f : __builtin_amdgcn_exp2f(p1[r] - F.mhat) * il;
                a += __shfl_xor(a, 8); a += __shfl_xor(a, 16); bq += __shfl_xor(bq, 8); bq += __shfl_xor(bq, 16);
                p0[r] = a; p1[r] = bq; }
            if (r32 < 8) {
#pragma unroll
                for (int k = 0; k < 4; ++k) { const int jj = 16 * ct + 2 * k + hi;
                    Gs[r32 * 64 + jj] = (p0[4 * k] + p0[4 * k + 1]) + (p0[4 * k + 2] + p0[4 * k + 3]); Ls[r32 * 64 + jj] = p0[4 * k + 3];
                    Gs[r32 * 64 + jj + 8] = (p1[4 * k] + p1[4 * k + 1]) + (p1[4 * k + 2] + p1[4 * k + 3]); Ls[r32 * 64 + jj + 8] = p1[4 * k + 3]; }
            }
        }
        asm volatile("s_waitcnt lgkmcnt(0)" ::: "memory");
        const int j = lane, jmax = 16 * ntc;
        for (int qi = 0; qi < 8; ++qi) {
            float v = (j < jmax) ? Gs[qi * 64 + j] : 0.f;
            if (j >= 1 && j - 1 < jmax) v += Ls[qi * 64 + j - 1];
            if (j == 0 || j == qblk || j == qblk - 1) v = 1e9f;
            if (j > qblk) v = -1e30f;
            int cnt = 0;
            for (int i = 0; i < 64; ++i) { const float vi = __uint_as_float(__builtin_amdgcn_readlane(__float_as_uint(v), i)); cnt += (vi > v || (vi == v && i < j)) ? 1 : 0; }
            const unsigned long long m = __ballot((cnt < 16) && (j <= qblk));
            anymask |= m;
            if ((r32 & 7) == qi) mymask = m;
        }
        asm volatile("s_waitcnt lgkmcnt(0)" ::: "memory");
        __syncthreads();
        row_bcast(g0 * il, fr_, wsf, r32, hi);
#pragma unroll
        for (int d = 0; d < 2; ++d)
#pragma unroll
            for (int r = 0; r < 16; ++r) yst[crow(r, hi) * 64 + d * 32 + r32] = F.o[d][r] * fr_[r];
    }
    const bf16_t* Kl = (const bf16_t*)0; (void)Kl;
    const size_t koff = (pg * S + lane) * 64 + wid * 8;
    const size_t voff = (pg * S + 16 * (wid & 3) + (lane >> 2)) * 64 + (wid >> 2) * 32 + (lane & 3) * 8;
    {
        Flash<2> F; F.reset();
        auto mask = [&](f32x16& p0, f32x16& p1, int j) {
            const bool sel = (mymask >> j) & 1ull;
            if (!sel) {
#pragma unroll
                for (int r = 0; r < 16; ++r) { p0[r] = -INFINITY; p1[r] = -INFINITY; }
            } else if (j == qblk) {
#pragma unroll
                for (int r = 0; r < 16; ++r) { const int kv = crow(r, hi); if (kv > ql) p0[r] = -INFINITY; if (kv + 32 > ql) p1[r] = -INFINITY; }
            }
        };
        nsa_kv_pass(L, F, qr, (const bf16_t*)(ws + WS_KS) + koff, (const bf16_t*)(ws + WS_VS) + voff, 0, qblk, anymask, wsf, wid, lane, r32, hi, mask);
        const float lt = F.ltot();
        row_bcast(g1 / lt, fr_, wsf, r32, hi);
#pragma unroll
        for (int d = 0; d < 2; ++d)
#pragma unroll
            for (int r = 0; r < 16; ++r) yst[crow(r, hi) * 64 + d * 32 + r32] += F.o[d][r] * fr_[r];
    }
    {
        Flash<2> F; F.reset();
        const int jlo = qblk >= 8 ? qblk - 8 : 0;
        auto mask = [&](f32x16& p0, f32x16& p1, int j) {
            if (j == qblk || j == qblk - 8) {
                const int base = 64 * (qblk - j) + ql;
#pragma unroll
                for (int r = 0; r < 16; ++r) { const int kv = crow(r, hi); if ((unsigned)(base - kv) >= 512u) p0[r] = -INFINITY; if ((unsigned)(base - kv - 32) >= 512u) p1[r] = -INFINITY; }
            }
        };
        nsa_kv_pass(L, F, qr, (const bf16_t*)(ws + WS_KW) + koff, (const bf16_t*)(ws + WS_VW) + voff, jlo, qblk, ~0ull, wsf, wid, lane, r32, hi, mask);
        const float lt = F.ltot();
        row_bcast(g2 / lt, fr_, wsf, r32, hi);
        LAS bf16_t* stg = (LAS bf16_t*)(L + NS_GL) + wid * 2048;
#pragma unroll
        for (int r = 0; r < 16; ++r) { const int orow = crow(r, hi);
#pragma unroll
            for (int d = 0; d < 2; ++d) { const float yv = yst[orow * 64 + d * 32 + r32] + F.o[d][r] * fr_[r]; stg[orow * 64 + d * 32 + r32] = (bf16_t)(cvtpk(yv, 0.f) & 0xffffu); } }
        asm volatile("s_waitcnt lgkmcnt(0)" ::: "memory");
        bf16_t* Yb = (bf16_t*)(ws + WS_YB);
#pragma unroll
        for (int i = 0; i < 4; ++i) { const int row = i * 8 + (lane >> 3), ch = lane & 7; const u32x4 v = *(const LAS u32x4*)(stg + row * 64 + ch * 8);
            *(u32x4*)(Yb + ((size_t)b * S + 64 * qblk + 8 * wid + (row & 7)) * 512 + (g * 4 + (row >> 3)) * 64 + ch * 8) = v; }
    }
    __syncthreads();
}

template <class MapF>
__device__ __forceinline__ void tr_item(const float* W, int K, int N, int ldw, bf16_t* WT, const float* kscale, LAS float* scr, int item, int lane, const MapF& map) {
    const int nblk = (N + 31) / 32, kb = item / nblk, nb = item % nblk, k0 = 64 * kb, n0 = 32 * nb;
    const int nn = n0 + (lane & 31);
#pragma unroll 8
    for (int i = 0; i < 32; ++i) { const int kk = 2 * i + (lane >> 5); float v = (nn < N) ? W[(size_t)(k0 + kk) * ldw + nn] : 0.f; if (kscale) v *= kscale[k0 + kk]; scr[kk * 33 + (lane & 31)] = v; }
    asm volatile("s_waitcnt lgkmcnt(0)" ::: "memory");
    const int c = lane & 7;
#pragma unroll
    for (int jx = 0; jx < 4; ++jx) { const int n = (lane >> 3) + 8 * jx; const LAS float* s = scr + (8 * c) * 33 + n;
        u32x4 o; o.x = cvtpk(s[0 * 33], s[1 * 33]); o.y = cvtpk(s[2 * 33], s[3 * 33]); o.z = cvtpk(s[4 * 33], s[5 * 33]); o.w = cvtpk(s[6 * 33], s[7 * 33]);
        if (n0 + n < N) *(u32x4*)(WT + (size_t)map(n0 + n) * K + k0 + 8 * c) = o; }
    asm volatile("s_waitcnt lgkmcnt(0)" ::: "memory");
}
__device__ __forceinline__ int rope_pos(int d) { return d < 32 ? 8 * (d >> 2) + (d & 3) : 8 * ((d - 32) >> 2) + 4 + (d & 3); }
struct MapIn {
    __device__ __forceinline__ int operator()(int n) const {
        if (n >= 2840) return 2816 + (n - 2840);
        if (n >= 2816) return 4864 + (n - 2816);
        bool rope;
        if (n < 1024) rope = true; else if (n < 1536) rope = false; else if (n < 2048) rope = true; else rope = (((n - 2048) >> 7) & 1) == 0;
        return rope ? (n & ~63) + rope_pos(n & 63) : n;
    }
};
struct MapId { int off; __device__ __forceinline__ int operator()(int n) const { return off + n; } };
struct MapGU { int up; __device__ __forceinline__ int operator()(int f) const { return 8 * (f >> 2) + 4 * up + (f & 3); } };

struct Args { const void* in[20]; float* out; unsigned char* ws; };

__global__ void __launch_bounds__(512, 2) hybrid_fwd(Args args) {
    extern __shared__ __attribute__((aligned(16))) unsigned char lds_raw[];
    LAS unsigned char* L = (LAS unsigned char*)lds_raw;
    cg::grid_group grid = cg::this_grid();
    const int tid = threadIdx.x, lane = tid & 63, wave = __builtin_amdgcn_readfirstlane(tid >> 6);
    const int G = gridDim.x, bx = blockIdx.x;
    unsigned char* ws = args.ws;
    const float* x = (const float*)args.in[0];
    const int* positions = (const int*)args.in[1];
    float* out = args.out;
    unsigned* ctl = (unsigned*)(ws + WS_CTL);
    LAS int* misc = (LAS int*)(L + LDS_BYTES - 64);

    {
        LAS float* scr = (LAS float*)(L + wave * 16384);
        const int gw = bx * 8 + wave, NGW = G * 8;
        const float* g1 = (const float*)args.in[2]; const float* g2 = (const float*)args.in[15];
        constexpr int I_IN = 16 * 153, I_G = 16 * 88, I_D = 44 * 32, I_O = 16 * 32, I_A = 8 * 32, I_C = 16 * 8;
        constexpr int NIT = I_IN + 2 * I_G + I_D + I_O + 2 * I_A + 4 * I_C;
        for (int it = gw; it < NIT; it += NGW) {
            int r = it;
            if (r < I_IN) { tr_item((const float*)args.in[3], 1024, 4888, 4888, (bf16_t*)(ws + WS_WIN), g1, scr, r, lane, MapIn{}); continue; } r -= I_IN;
            if (r < I_G) { tr_item((const float*)args.in[16], 1024, FF, FF, (bf16_t*)(ws + WS_WGU), g2, scr, r, lane, MapGU{0}); continue; } r -= I_G;
            if (r < I_G) { tr_item((const float*)args.in[17], 1024, FF, FF, (bf16_t*)(ws + WS_WGU), g2, scr, r, lane, MapGU{1}); continue; } r -= I_G;
            if (r < I_D) { tr_item((const float*)args.in[18], FF, 1024, 1024, (bf16_t*)(ws + WS_WD), nullptr, scr, r, lane, MapId{0}); continue; } r -= I_D;
            if (r < I_O) { tr_item((const float*)args.in[14], 1024, 1024, 1024, (bf16_t*)(ws + WS_WO), nullptr, scr, r, lane, MapId{0}); continue; } r -= I_O;
            if (r < I_A) { tr_item((const float*)args.in[12], 512, 1024, 1024, (bf16_t*)(ws + WS_WA), nullptr, scr, r, lane, MapId{0}); continue; } r -= I_A;
            if (r < I_A) { tr_item((const float*)args.in[13], 512, 1024, 1024, (bf16_t*)(ws + WS_WB), nullptr, scr, r, lane, MapId{0}); continue; } r -= I_A;
            if (r < I_C) { tr_item((const float*)args.in[8], 1024, 256, 256, (bf16_t*)(ws + WS_W1K), nullptr, scr, r, lane, MapId{0}); continue; } r -= I_C;
            if (r < I_C) { tr_item((const float*)args.in[8] + 1024 * 256, 1024, 256, 256, (bf16_t*)(ws + WS_W1K), nullptr, scr, r, lane, MapId{256}); continue; } r -= I_C;
            if (r < I_C) { tr_item((const float*)args.in[10], 1024, 256, 256, (bf16_t*)(ws + WS_W1V), nullptr, scr, r, lane, MapId{0}); continue; } r -= I_C;
            tr_item((const float*)args.in[10] + 1024 * 256, 1024, 256, 256, (bf16_t*)(ws + WS_W1V), nullptr, scr, r, lane, MapId{256});
        }
        bf16_t* XB = (bf16_t*)(ws + WS_XB); float* rs1 = (float*)(ws + WS_RS1);
        float* cosT = (float*)(ws + WS_COS); float* sinT = (float*)(ws + WS_SIN);
        const float invf = 1.0f / powf(10000.0f, (float)(2 * (lane & 31)) / 64.0f);
        for (int m = gw; m < T; m += NGW) {
            const f32x4* xr = (const f32x4*)(x + (size_t)m * D) + lane;
            f32x4 v[4]; float s = 0.f;
#pragma unroll
            for (int jx = 0; jx < 4; ++jx) { v[jx] = xr[64 * jx]; s += (v[jx][0] * v[jx][0] + v[jx][1] * v[jx][1]) + (v[jx][2] * v[jx][2] + v[jx][3] * v[jx][3]); }
            s = wave_sum(s);
            if (lane == 0) rs1[m] = rsqrtf(s * (1.f / D) + EPS);
            u32x2* o8 = (u32x2*)(XB + (size_t)m * D) + lane;
#pragma unroll
            for (int jx = 0; jx < 4; ++jx) { u32x2 w; w.x = cvtpk(v[jx][0], v[jx][1]); w.y = cvtpk(v[jx][2], v[jx][3]); o8[64 * jx] = w; }
            const float ang = (float)positions[m] * invf;
            if (lane < 32) cosT[(size_t)m * 32 + lane] = cosf(ang); else sinT[(size_t)m * 32 + (lane - 32)] = sinf(ang);
        }
        if (bx < 32) {
            const int kv = bx >> 4, slab = bx & 15;
            const float* pe = (const float*)args.in[kv ? 7 : 6]; const float* W1 = (const float*)args.in[kv ? 10 : 8];
            const int n = tid & 255, half = tid >> 8; float acc = 0.f;
            for (int k = slab * 128 + half * 64; k < slab * 128 + half * 64 + 64; ++k) acc += pe[k] * W1[(size_t)k * 256 + n];
            __syncthreads();
            LAS float* red = (LAS float*)L;
            if (half) red[n] = acc;
            __syncthreads();
            if (!half) ((float*)(ws + WS_BIASP))[(kv * 16 + slab) * 256 + n] = acc + red[n];
            __syncthreads();
        }
    }
    grid.sync();
    {
        pg8::Gemm g{(const bf16_t*)(ws + WS_XB), (const bf16_t*)(ws + WS_WIN), T, INP, D}; pg8::StaticOrder SO; SO.init(T, INP, G, bx);
        EpiProj E{(const float*)(ws + WS_RS1), (const float*)(ws + WS_COS), (const float*)(ws + WS_SIN), ws};
        pg8::gemm_phase<EpiProj, true>(L, g, SO, E);
    }
    grid.sync();
    {
        { pg8::Gemm g{(const bf16_t*)(ws + WS_KC), (const bf16_t*)(ws + WS_W1K), 4096, 512, 1024}; pg8::StaticOrder SO; SO.init(4096, 512, G, bx);
          EpiF32 E{(float*)(ws + WS_GK), 512}; pg8::gemm_phase<EpiF32, true>(L, g, SO, E); }
        { pg8::Gemm g{(const bf16_t*)(ws + WS_VC), (const bf16_t*)(ws + WS_W1V), 4096, 512, 1024}; pg8::StaticOrder SO; SO.init(4096, 512, G, (bx + G - 32) % G);
          EpiF32 E{(float*)(ws + WS_GV), 512}; pg8::gemm_phase<EpiF32, true>(L, g, SO, E); }
        __syncthreads();
        const float* lf = (const float*)args.in[4];
        const float sa = wave_sum(lf[lane] * lf[64 + lane]), sb = wave_sum(lf[128 + lane] * lf[192 + lane]);
        const float lam = expf(sa) - expf(sb) + LAM_INIT;
        for (;;) {
            if (tid == 0) misc[0] = (int)atomicAdd(ctl + 64, 1u);
            __syncthreads();
            const int idx = misc[0];
            __syncthreads();
            if (idx >= 1024) break;
            const int qb = 31 - (idx >> 5), bh = idx & 31;
            diff_unit(L, bh >> 2, bh & 3, qb, ws, lam, (const float*)args.in[5]);
        }
    }
    grid.sync();
    {
        LAS float* hid = (LAS float*)L;
        LAS float* bias = hid + 4096;
        for (int un = bx; un < 512; un += G) {
            const int kv = un >> 8, p = (un >> 4) & 15, rb = un & 15;
            const float* Gm = (const float*)(ws + (kv ? WS_GV : WS_GK));
            const float* w2 = (const float*)args.in[kv ? 11 : 9];
            if (tid < 256) { float a = 0.f; const float* bp = (const float*)(ws + WS_BIASP) + kv * 16 * 256 + tid;
#pragma unroll
                for (int s = 0; s < 16; ++s) a += bp[s * 256]; bias[tid] = a; }
            __syncthreads();
#pragma unroll
            for (int i = 0; i < 8; ++i) { const int e = tid + 512 * i, r = e >> 8, k = e & 255, c = 16 * rb + r; const size_t R = (size_t)p * 256 + c;
                float v = Gm[R * 512 + k] + bias[k]; if (c < 255) v += Gm[(R + 1) * 512 + 256 + k];
                hid[r * 256 + k] = v / (1.f + __expf(-v)); }
            __syncthreads();
            const int d = tid & 63, r0 = tid >> 6; float a0 = 0.f, a1 = 0.f;
#pragma unroll 8
            for (int k = 0; k < 256; ++k) { const float w = w2[k * 64 + d]; a0 += hid[r0 * 256 + k] * w; a1 += hid[(r0 + 8) * 256 + k] * w; }
            bf16_t* O = (bf16_t*)(ws + (kv ? WS_VCMP : WS_KCMP)) + ((size_t)p * 256 + 16 * rb) * 64;
            O[r0 * 64 + d] = (bf16_t)(cvtpk(a0, 0.f) & 0xffffu); O[(r0 + 8) * 64 + d] = (bf16_t)(cvtpk(a1, 0.f) & 0xffffu);
            __syncthreads();
        }
    }
    grid.sync();
    {
        for (;;) {
            if (tid == 0) misc[0] = (int)atomicAdd(ctl + 128, 1u);
            __syncthreads();
            const int idx = misc[0];
            __syncthreads();
            if (idx >= 1024) break;
            const int qblk = 63 - (idx >> 4), pgx = idx & 15;
            nsa_unit(L, pgx >> 1, pgx & 1, qblk, ws);
        }
    }
    grid.sync();
    {
        { pg8::Gemm g{(const bf16_t*)(ws + WS_YA), (const bf16_t*)(ws + WS_WA), T, D, 512}; pg8::StaticOrder SO; SO.init(T, D, G, bx);
          EpiBranch<false> E{(bf16_t*)(ws + WS_XB), (const bf16_t*)(ws + WS_MG)}; pg8::gemm_phase<EpiBranch<false>, true>(L, g, SO, E); }
        __syncthreads();
        { pg8::Gemm g{(const bf16_t*)(ws + WS_YB), (const bf16_t*)(ws + WS_WB), T, D, 512}; pg8::StaticOrder SO; SO.init(T, D, G, bx);
          EpiBranch<true> E{(bf16_t*)(ws + WS_XB), (const bf16_t*)(ws + WS_MG)}; pg8::gemm_phase<EpiBranch<true>, true>(L, g, SO, E); }
    }
    grid.sync();
    {
        pg8::Gemm g{(const bf16_t*)(ws + WS_XB), (const bf16_t*)(ws + WS_WO), T, D, D}; pg8::StaticOrder SO; SO.init(T, D, G, bx);
        EpiResid<true> E{x, out, (bf16_t*)(ws + WS_YA), (float*)(ws + WS_SSQ2)};
        pg8::gemm_phase<EpiResid<true>, true>(L, g, SO, E);
    }
    grid.sync();
    {
        pg8::Gemm g{(const bf16_t*)(ws + WS_YA), (const bf16_t*)(ws + WS_WGU), T, FF2, D}; pg8::StaticOrder SO; SO.init(T, FF2, G, bx);
        EpiGU E{(const float*)(ws + WS_SSQ2), (bf16_t*)(ws + WS_ACT)};
        pg8::gemm_phase<EpiGU, true>(L, g, SO, E);
    }
    grid.sync();
    {
        pg8::Gemm g{(const bf16_t*)(ws + WS_ACT), (const bf16_t*)(ws + WS_WD), T, D, FF}; pg8::StaticOrder SO; SO.init(T, D, G, bx);
        EpiResid<false> E{out, out, nullptr, (float*)(ws + WS_SSQ3)};
        pg8::gemm_phase<EpiResid<false>, true>(L, g, SO, E);
    }
    grid.sync();
    {
        const float* gf = (const float*)args.in[19]; const float* SSQ3 = (const float*)(ws + WS_SSQ3);
        const int gw = bx * 8 + wave, NGW = G * 8;
        f32x4 gv[4];
#pragma unroll
        for (int jx = 0; jx < 4; ++jx) gv[jx] = ((const f32x4*)gf)[lane + 64 * jx];
        for (int m = gw; m < T; m += NGW) {
            float s = (lane < 16) ? SSQ3[(size_t)m * 16 + lane] : 0.f;
            s = wave_sum(s);
            const float rs = rsqrtf(s * (1.f / D) + EPS);
            f32x4* xr = (f32x4*)(out + (size_t)m * D) + lane;
#pragma unroll
            for (int jx = 0; jx < 4; ++jx) { f32x4 v = xr[64 * jx]; v = v * rs * gv[jx]; xr[64 * jx] = v; }
        }
    }
}

extern "C" void kernel_launch(void* const* d_in, const int* in_sizes, int n_in, void* d_out, int out_size, void* d_ws, size_t ws_size, hipStream_t stream) {
    static int grid = 0;
    if (grid == 0) {
        if (n_in != 20 || out_size != T * D || ws_size < WS_END) { fprintf(stderr, "kernel_launch: unexpected shapes (n_in %d out %d ws %zu)\n", n_in, out_size, ws_size); grid = -1; return; }
        int dev = 0, cus = 0, per_cu = 0;
        hipGetDevice(&dev);
        hipDeviceGetAttribute(&cus, hipDeviceAttributeMultiprocessorCount, dev);
        hipFuncSetAttribute((const void*)hybrid_fwd, hipFuncAttributeMaxDynamicSharedMemorySize, LDS_BYTES);
        hipOccupancyMaxActiveBlocksPerMultiprocessor(&per_cu, (const void*)hybrid_fwd, 512, LDS_BYTES);
        if (per_cu < 1) { fprintf(stderr, "kernel_launch: occupancy query says %d blocks per CU\n", per_cu); per_cu = 1; }
        (void)hipGetLastError();
        grid = cus * per_cu;
    }
    if (grid < 0) return;
    hipMemsetAsync((char*)d_ws + WS_CTL, 0, 4096, stream);
    Args a{};
    for (int i = 0; i < 20; ++i) a.in[i] = d_in[i];
    a.out = (float*)d_out; a.ws = (unsigned char*)d_ws;
    void* params[] = {&a};
    hipError_t e = hipLaunchCooperativeKernel((const void*)hybrid_fwd, dim3(grid), dim3(512), params, LDS_BYTES, stream);
    if (e != hipSuccess) fprintf(stderr, "cooperative launch failed: %s (grid %d)\n", hipGetErrorString(e), grid);
}
```

```cpp
#include <hip/hip_runtime.h>
#include <hip/hip_cooperative_groups.h>
#include <cstdint>
#include <cstdio>
#include <type_traits>
namespace cg = cooperative_groups;

#define LAS __attribute__((address_space(3)))
typedef unsigned short bf16_t;
typedef short bf16x8 __attribute__((ext_vector_type(8)));
typedef short s16x4 __attribute__((ext_vector_type(4)));
typedef float f32x4 __attribute__((ext_vector_type(4)));
typedef float f32x2 __attribute__((ext_vector_type(2)));
typedef float f32x16 __attribute__((ext_vector_type(16)));
typedef unsigned u32x4 __attribute__((ext_vector_type(4)));
typedef unsigned u32x2 __attribute__((ext_vector_type(2)));
typedef __bf16 bf16x2_t __attribute__((ext_vector_type(2)));

constexpr int NB = 8, S = 4096, T = NB * S, D = 1024, FF = 2816, FF2 = 2 * FF, INP = 5120;
constexpr float EPS = 1e-6f;
constexpr float C2 = 0.125f * 1.4426950408889634f;
constexpr float LAM_INIT = 0.2f;

constexpr size_t MiB = 1u << 20;
constexpr size_t WS_CTL = 0;
constexpr size_t WS_WIN = 1 * MiB, WS_WGU = 11 * MiB, WS_WD = 22 * MiB, WS_WO = 28 * MiB, WS_WA = 30 * MiB, WS_WB = 31 * MiB, WS_W1K = 32 * MiB, WS_W1V = 33 * MiB;
constexpr size_t WS_COS = 34 * MiB, WS_SIN = 38 * MiB;
constexpr size_t WS_RS1 = 42 * MiB, WS_SSQ2 = 43 * MiB, WS_SSQ3 = 45 * MiB, WS_NG = 47 * MiB, WS_BIASP = 50 * MiB;
constexpr size_t WS_GK = 52 * MiB, WS_GV = 60 * MiB, WS_KCMP = 68 * MiB, WS_VCMP = 69 * MiB;
constexpr size_t WS_XB = 70 * MiB;
constexpr size_t WS_DQ = 134 * MiB, WS_DK = 166 * MiB, WS_DV = 198 * MiB, WS_NQ = 230 * MiB;
constexpr size_t WS_KC = 262 * MiB, WS_VC = 270 * MiB, WS_KS = 278 * MiB, WS_VS = 286 * MiB, WS_KW = 294 * MiB, WS_VW = 302 * MiB;
constexpr size_t WS_ACT = 134 * MiB;
constexpr size_t WS_MG = 310 * MiB;
constexpr size_t WS_YA = 438 * MiB, WS_YB = 470 * MiB;
constexpr size_t WS_END = 502 * MiB;
constexpr int LDS_BYTES = 155648;

__device__ __forceinline__ unsigned cvtpk(float lo, float hi) { f32x2 v = {lo, hi}; bf16x2_t b = __builtin_convertvector(v, bf16x2_t); return __builtin_bit_cast(unsigned, b); }
__device__ __forceinline__ float bf2f(unsigned short h) { return __uint_as_float(((unsigned)h) << 16); }
__device__ __forceinline__ float bflo(unsigned w) { return __uint_as_float(w << 16); }
__device__ __forceinline__ float bfhi(unsigned w) { return __uint_as_float(w & 0xffff0000u); }
__device__ __forceinline__ float sigmoidf_(float x) { return 1.f / (1.f + __expf(-x)); }
__device__ __forceinline__ float wave_sum(float v) {
#pragma unroll
    for (int o = 1; o < 64; o <<= 1) v += __shfl_xor(v, o);
    return v;
}

namespace pg8 {
constexpr int BM = 256, BK = 64, HALF = 128, HTB = HALF * BK * 2, STAGE_BYTES = 8 * HTB, NXCD = 8, WGM = 8;
__host__ __device__ __forceinline__ int lds_byte(int r, int c) { const int st = (r >> 4) * 2 + (c >> 5), rr = r & 15, cc = c & 31, ob = rr * 64 + cc * 2; return st * 1024 + (ob ^ (((ob >> 9) & 1) << 5)); }
__host__ __device__ __forceinline__ void stage_rc(int b, int& R, int& C) { const int st = b / 1024, sb = b % 1024, swz = sb ^ (((sb >> 9) & 1) << 5); R = (st >> 1) * 16 + swz / 64; C = (st & 1) * 32 + (swz % 64) / 2; }
__host__ __device__ __forceinline__ int perm32(int rho) { const int n = rho >> 4, i = rho & 15; return 8 * (i >> 2) + 4 * n + (i & 3); }
struct Unit { int pm, pn; };
struct Gemm { const bf16_t* A; const bf16_t* Bt; int M, N, K; };
struct StaticOrder {
    int nM, nN, nwg, G, c;
    __host__ __device__ void init(int M, int N, int G_, int c_) { nM = M / BM; nN = N / BM; nwg = nM * nN; G = G_; c = c_; }
    __host__ __device__ bool next(int i, Unit& u) const {
        const long L = (long)i * G + c; if (L >= nwg) return false;
        int wgid = (int)L; { const int q = nwg / NXCD, r = nwg % NXCD, xcd = wgid % NXCD, off = wgid / NXCD; wgid = (xcd < r ? xcd * (q + 1) : r * (q + 1) + (xcd - r) * q) + off; }
        const int nig = WGM * nN, gid = wgid / nig, fm = gid * WGM, gsz = (nM - fm) < WGM ? (nM - fm) : WGM;
        u.pm = fm + ((wgid % nig) % gsz); u.pn = (wgid % nig) / gsz; return true;
    }
};
template <class Epi, bool ALIGN_EPI>
__device__ __forceinline__ void gemm_phase(LAS unsigned char* lds, const Gemm g, const StaticOrder& S, const Epi& E) {
    int tid_ = threadIdx.x; asm volatile("" : "+v"(tid_));
    const int tid = tid_, wid = __builtin_amdgcn_readfirstlane(tid >> 6), lane = tid & 63, wr = wid >> 2, wc = wid & 3, fr = lane & 15, fq = lane >> 4;
    const int K = g.K, nt = K / BK;
    unsigned voffA[2], voffB[2];
#pragma unroll
    for (int i = 0; i < 2; ++i) { int R, C; stage_rc(tid * 16 + i * 8192, R, C); const int Rb = (R & ~31) + perm32(R & 31);
        voffA[i] = (unsigned)(R * K + C) * 2u; voffB[i] = (unsigned)(Rb * K + C) * 2u; }
    const size_t kstep = (size_t)(BK * 2);
    const size_t hstep = (size_t)HALF * K * 2;
    const size_t tstep = 2 * hstep;
    const unsigned ldsw = (unsigned)wid * 1024u;
    const int aoff = lds_byte(wr * 64 + fr, fq * 8), boff = lds_byte(wc * 32 + fr, fq * 8);
#define PG8_SA(b, h) (((b) * 2 + (h)) * HTB)
#define PG8_SB(b, h) ((4 + (b) * 2 + (h)) * HTB)
#define PG8_STAGE(bufoff, gbase, voff) do { _Pragma("unroll") for (int _i = 0; _i < 2; ++_i) \
        __builtin_amdgcn_global_load_lds((const unsigned*)((const char*)(gbase) + (voff)[_i]), (LAS unsigned*)(lds + (bufoff) + ldsw + _i * 8192), 16, 0, 0); } while (0)
#define PG8_LDA(dst, b, h) do { _Pragma("unroll") for (int m = 0; m < 4; ++m) _Pragma("unroll") for (int k = 0; k < 2; ++k) dst[m][k] = *(const LAS bf16x8*)(lds + PG8_SA(b, h) + aoff + m * 2048 + k * 1024); } while (0)
#define PG8_LDB(dst, b, h) do { _Pragma("unroll") for (int n = 0; n < 2; ++n) _Pragma("unroll") for (int k = 0; k < 2; ++k) dst[n][k] = *(const LAS bf16x8*)(lds + PG8_SB(b, h) + boff + n * 2048 + k * 1024); } while (0)
#define PG8_MMA(ai, bj, At, Bt) do { __builtin_amdgcn_s_setprio(1); _Pragma("unroll") for (int m = 0; m < 4; ++m) _Pragma("unroll") for (int n = 0; n < 2; ++n) _Pragma("unroll") for (int k = 0; k < 2; ++k) \
        acc[ai][bj][m][n] = __builtin_amdgcn_mfma_f32_16x16x32_bf16(Bt[n][k], At[m][k], acc[ai][bj][m][n], 0, 0, 0); __builtin_amdgcn_s_setprio(0); } while (0)
#define PG8_WAIT_V(n) asm volatile("s_waitcnt vmcnt(" #n ")" ::: "memory")
#define PG8_WAIT_L(n) asm volatile("s_waitcnt lgkmcnt(" #n ")" ::: "memory")
#define PG8_BAR __builtin_amdgcn_s_barrier()
#define PG8_SCHED __builtin_amdgcn_sched_barrier(0)
    Unit cur, nxt; int ui = 0;
    if (!S.next(0, cur)) return;
    f32x4 acc[2][2][4][2];
#pragma unroll
    for (int a = 0; a < 2; ++a)
#pragma unroll
        for (int b = 0; b < 2; ++b)
#pragma unroll
            for (int m = 0; m < 4; ++m)
#pragma unroll
                for (int n = 0; n < 2; ++n) acc[a][b][m][n] = (f32x4){0.f, 0.f, 0.f, 0.f};
    bf16x8 At[4][2], B0[2][2], B1[2][2];
    const char* cA = (const char*)g.A + (size_t)cur.pm * tstep; const char* cB = (const char*)g.Bt + (size_t)cur.pn * tstep;
    PG8_STAGE(PG8_SB(0, 0), cB, voffB); PG8_STAGE(PG8_SB(0, 1), cB + hstep, voffB); PG8_STAGE(PG8_SA(0, 0), cA, voffA); PG8_STAGE(PG8_SA(0, 1), cA + hstep, voffA);
    if (wr == 1) PG8_BAR;
    PG8_WAIT_V(2); PG8_BAR;
    PG8_STAGE(PG8_SB(1, 0), cB + kstep, voffB); PG8_STAGE(PG8_SA(1, 0), cA + kstep, voffA); PG8_STAGE(PG8_SB(1, 1), cB + hstep + kstep, voffB);
    PG8_WAIT_V(6); PG8_BAR;
    for (;;) {
        const bool has_next = S.next(ui + 1, nxt);
        const char* nA = has_next ? (const char*)g.A + (size_t)nxt.pm * tstep : cA; const char* nB = has_next ? (const char*)g.Bt + (size_t)nxt.pn * tstep : cB;
        for (int t = 0; t < nt; t += 2) {
            const bool last = (t == nt - 2);
            const char* a1 = cA + (size_t)(t + 1) * kstep;
            const char* a2 = last ? nA : cA + (size_t)(t + 2) * kstep; const char* b2 = last ? nB : cB + (size_t)(t + 2) * kstep;
            const char* a3 = a2 + kstep; const char* b3 = b2 + kstep;
            PG8_LDB(B0, 0, 0); PG8_LDB(B1, 0, 1); PG8_SCHED; PG8_LDA(At, 0, 0); PG8_STAGE(PG8_SA(1, 1), a1 + hstep, voffA);
            PG8_WAIT_V(8); PG8_WAIT_L(0); PG8_BAR; PG8_MMA(0, 0, At, B0); PG8_MMA(0, 1, At, B1); PG8_BAR; PG8_SCHED;
            PG8_LDA(At, 0, 1); PG8_STAGE(PG8_SB(0, 0), b2, voffB); PG8_STAGE(PG8_SB(0, 1), b2 + hstep, voffB); PG8_STAGE(PG8_SA(0, 0), a2, voffA);
            PG8_WAIT_V(8); PG8_WAIT_L(0); PG8_BAR; PG8_MMA(1, 0, At, B0); PG8_MMA(1, 1, At, B1); PG8_BAR; PG8_SCHED;
            PG8_LDB(B0, 1, 0); PG8_LDB(B1, 1, 1); PG8_SCHED; PG8_LDA(At, 1, 0); PG8_STAGE(PG8_SA(0, 1), a2 + hstep, voffA);
            PG8_WAIT_V(8); PG8_WAIT_L(0); PG8_BAR; PG8_MMA(0, 0, At, B0); PG8_MMA(0, 1, At, B1); PG8_BAR; PG8_SCHED;
            PG8_LDA(At, 1, 1); PG8_STAGE(PG8_SB(1, 0), b3, voffB); PG8_STAGE(PG8_SB(1, 1), b3 + hstep, voffB); PG8_STAGE(PG8_SA(1, 0), a3, voffA);
            PG8_WAIT_V(8); PG8_WAIT_L(0); PG8_BAR; PG8_MMA(1, 0, At, B0); PG8_MMA(1, 1, At, B1); PG8_BAR; PG8_SCHED;
        }
        if constexpr (ALIGN_EPI) { if (wr == 0) PG8_BAR; }
        E(acc, cur, wr, wc, fr, fq);
        if (!has_next) break;
#pragma unroll
        for (int a = 0; a < 2; ++a)
#pragma unroll
            for (int b = 0; b < 2; ++b)
#pragma unroll
                for (int m = 0; m < 4; ++m)
#pragma unroll
                    for (int n = 0; n < 2; ++n) acc[a][b][m][n] = (f32x4){0.f, 0.f, 0.f, 0.f};
        cur = nxt; cA = nA; cB = nB; ++ui;
        if constexpr (ALIGN_EPI) { if (wr == 1) PG8_BAR; }
    }
    PG8_WAIT_V(0);
    if constexpr (!ALIGN_EPI) { if (wr == 0) PG8_BAR; }
    PG8_BAR;
#undef PG8_SA
#undef PG8_SB
#undef PG8_STAGE
#undef PG8_LDA
#undef PG8_LDB
#undef PG8_MMA
#undef PG8_WAIT_V
#undef PG8_WAIT_L
#undef PG8_BAR
#undef PG8_SCHED
}
}

typedef f32x4 AccT[2][2][4][2];

struct EpiProj {
    const float* rs1; const float* cosT; const float* sinT;
    unsigned char* ws;
    __device__ __forceinline__ void operator()(const AccT& acc, const pg8::Unit& u, int wr, int wc, int fr, int fq) const {
        const int row0 = u.pm * 256 + wr * 64 + fr;
#pragma unroll
        for (int bj = 0; bj < 2; ++bj) {
            const int sec = u.pn * 2 + bj;
            if (sec >= 39) continue;
            if (sec == 38) {
                if (wc == 0 && fq < 3) {
                    float* NG = (float*)(ws + WS_NG);
#pragma unroll
                    for (int ai = 0; ai < 2; ++ai)
#pragma unroll
                        for (int m = 0; m < 4; ++m) { const int r = row0 + ai * 128 + m * 16; const float rs = rs1[r];
                            f32x4 v0 = acc[ai][bj][m][0] * rs, v1 = acc[ai][bj][m][1] * rs;
                            f32x4 o0, o1;
#pragma unroll
                            for (int i = 0; i < 4; ++i) { o0[i] = sigmoidf_(v0[i]); o1[i] = sigmoidf_(v1[i]); }
                            *(f32x4*)(NG + (size_t)r * 24 + fq * 8) = o0; *(f32x4*)(NG + (size_t)r * 24 + fq * 8 + 4) = o1; }
                }
                continue;
            }
            if (sec >= 22) {
                bf16_t* MG = (bf16_t*)(ws + WS_MG);
                const int col = (sec - 22) * 128 + wc * 32 + fq * 8;
#pragma unroll
                for (int ai = 0; ai < 2; ++ai)
#pragma unroll
                    for (int m = 0; m < 4; ++m) { const int r = row0 + ai * 128 + m * 16; const float rs = rs1[r];
                        f32x4 v0 = acc[ai][bj][m][0] * rs, v1 = acc[ai][bj][m][1] * rs;
                        u32x4 w; w.x = cvtpk(sigmoidf_(v0[0]), sigmoidf_(v0[1])); w.y = cvtpk(sigmoidf_(v0[2]), sigmoidf_(v0[3]));
                        w.z = cvtpk(sigmoidf_(v1[0]), sigmoidf_(v1[1])); w.w = cvtpk(sigmoidf_(v1[2]), sigmoidf_(v1[3]));
                        *(u32x4*)(MG + (size_t)r * 2048 + col) = w; }
                continue;
            }
            bf16_t* base; int H, head, HD, coff; bool rope; float scale = 1.f;
            if (sec < 4)       { base = (bf16_t*)(ws + WS_DQ); H = 4; head = sec;      HD = 128; coff = (wc >> 1) * 64; rope = true; scale = C2; }
            else if (sec < 8)  { base = (bf16_t*)(ws + WS_DK); H = 4; head = sec - 4;  HD = 128; coff = (wc >> 1) * 64; rope = true; }
            else if (sec < 12) { base = (bf16_t*)(ws + WS_DV); H = 4; head = sec - 8;  HD = 128; coff = (wc >> 1) * 64; rope = false; }
            else if (sec < 16) { base = (bf16_t*)(ws + WS_NQ); H = 8; head = (sec - 12) * 2 + (wc >> 1); HD = 64; coff = 0; rope = true; scale = C2; }
            else { const int k6 = sec - 16; base = (bf16_t*)(ws + WS_KC + (size_t)k6 * 8 * MiB); H = 2; head = wc >> 1; HD = 64; coff = 0; rope = (k6 & 1) == 0; }
            const int j = 4 * (wc & 1) + fq;
#pragma unroll
            for (int ai = 0; ai < 2; ++ai)
#pragma unroll
                for (int m = 0; m < 4; ++m) { const int r = row0 + ai * 128 + m * 16; const float rs = rs1[r] * scale;
                    const int b = r >> 12, s = r & 4095;
                    bf16_t* p = base + ((size_t)(b * H + head) * S + s) * HD + coff;
                    f32x4 v0 = acc[ai][bj][m][0] * rs, v1 = acc[ai][bj][m][1] * rs;
                    if (rope) {
                        const f32x4 c = *(const f32x4*)(cosT + (size_t)r * 32 + 4 * j), sn = *(const f32x4*)(sinT + (size_t)r * 32 + 4 * j);
                        const f32x4 o1 = v0 * c - v1 * sn, o2 = v1 * c + v0 * sn;
                        u32x2 w1, w2; w1.x = cvtpk(o1[0], o1[1]); w1.y = cvtpk(o1[2], o1[3]); w2.x = cvtpk(o2[0], o2[1]); w2.y = cvtpk(o2[2], o2[3]);
                        *(u32x2*)(p + 4 * j) = w1; *(u32x2*)(p + 32 + 4 * j) = w2;
                    } else {
                        u32x4 w; w.x = cvtpk(v0[0], v0[1]); w.y = cvtpk(v0[2], v0[3]); w.z = cvtpk(v1[0], v1[1]); w.w = cvtpk(v1[2], v1[3]);
                        *(u32x4*)(p + 8 * j) = w;
                    }
                }
        }
    }
};
struct EpiF32 {
    float* O; int ldc;
    __device__ __forceinline__ void operator()(const AccT& acc, const pg8::Unit& u, int wr, int wc, int fr, int fq) const {
        const int row0 = u.pm * 256 + wr * 64 + fr, col0 = u.pn * 256 + wc * 32 + fq * 8;
#pragma unroll
        for (int ai = 0; ai < 2; ++ai)
#pragma unroll
            for (int m = 0; m < 4; ++m)
#pragma unroll
                for (int bj = 0; bj < 2; ++bj) { float* p = O + (size_t)(row0 + ai * 128 + m * 16) * ldc + col0 + bj * 128;
                    *(f32x4*)p = acc[ai][bj][m][0]; *(f32x4*)(p + 4) = acc[ai][bj][m][1]; }
    }
};
template <bool SECOND> struct EpiBranch {
    bf16_t* MERGED; const bf16_t* MG;
    __device__ __forceinline__ void operator()(const AccT& acc, const pg8::Unit& u, int wr, int wc, int fr, int fq) const {
        const int row0 = u.pm * 256 + wr * 64 + fr, col0 = u.pn * 256 + wc * 32 + fq * 8;
#pragma unroll
        for (int ai = 0; ai < 2; ++ai)
#pragma unroll
            for (int m = 0; m < 4; ++m)
#pragma unroll
                for (int bj = 0; bj < 2; ++bj) { const int r = row0 + ai * 128 + m * 16, c = col0 + bj * 128;
                    const u32x4 g = *(const u32x4*)(MG + (size_t)r * 2048 + (SECOND ? 1024 : 0) + c);
                    const f32x4 a0 = acc[ai][bj][m][0], a1 = acc[ai][bj][m][1];
                    float o[8] = {bflo(g.x) * a0[0], bfhi(g.x) * a0[1], bflo(g.y) * a0[2], bfhi(g.y) * a0[3], bflo(g.z) * a1[0], bfhi(g.z) * a1[1], bflo(g.w) * a1[2], bfhi(g.w) * a1[3]};
                    bf16_t* p = MERGED + (size_t)r * 1024 + c;
                    if (SECOND) { const u32x4 pv = *(const u32x4*)p;
                        o[0] += bflo(pv.x); o[1] += bfhi(pv.x); o[2] += bflo(pv.y); o[3] += bfhi(pv.y); o[4] += bflo(pv.z); o[5] += bfhi(pv.z); o[6] += bflo(pv.w); o[7] += bfhi(pv.w); }
                    u32x4 w; w.x = cvtpk(o[0], o[1]); w.y = cvtpk(o[2], o[3]); w.z = cvtpk(o[4], o[5]); w.w = cvtpk(o[6], o[7]);
                    *(u32x4*)p = w; }
    }
};
template <bool WRITE_BF> struct EpiResid {
    const float* base; float* out; bf16_t* HB; float* SSQ;
    __device__ __forceinline__ void operator()(const AccT& acc, const pg8::Unit& u, int wr, int wc, int fr, int fq) const {
        const int row0 = u.pm * 256 + wr * 64 + fr, col0 = u.pn * 256 + wc * 32 + fq * 8;
#pragma unroll
        for (int ai = 0; ai < 2; ++ai)
#pragma unroll
            for (int m = 0; m < 4; ++m) { const int r = row0 + ai * 128 + m * 16; float ss = 0.f;
#pragma unroll
                for (int bj = 0; bj < 2; ++bj) { const size_t off = (size_t)r * 1024 + col0 + bj * 128;
                    const f32x4 h0 = *(const f32x4*)(base + off) + acc[ai][bj][m][0], h1 = *(const f32x4*)(base + off + 4) + acc[ai][bj][m][1];
                    *(f32x4*)(out + off) = h0; *(f32x4*)(out + off + 4) = h1;
                    ss += (h0[0] * h0[0] + h0[1] * h0[1]) + (h0[2] * h0[2] + h0[3] * h0[3]) + (h1[0] * h1[0] + h1[1] * h1[1]) + (h1[2] * h1[2] + h1[3] * h1[3]);
                    if (WRITE_BF) { u32x4 w; w.x = cvtpk(h0[0], h0[1]); w.y = cvtpk(h0[2], h0[3]); w.z = cvtpk(h1[0], h1[1]); w.w = cvtpk(h1[2], h1[3]); *(u32x4*)(HB + off) = w; } }
                ss += __shfl_xor(ss, 16); ss += __shfl_xor(ss, 32);
                if (fq == 0) SSQ[(size_t)r * 16 + u.pn * 4 + wc] = ss; }
    }
};
struct EpiGU {
    const float* SSQ2; bf16_t* ACT;
    __device__ __forceinline__ void operator()(const AccT& acc, const pg8::Unit& u, int wr, int wc, int fr, int fq) const {
        const int row0 = u.pm * 256 + wr * 64 + fr, col0 = u.pn * 128 + wc * 16 + fq * 4;
#pragma unroll
        for (int ai = 0; ai < 2; ++ai)
#pragma unroll
            for (int m = 0; m < 4; ++m) { const int r = row0 + ai * 128 + m * 16;
                const f32x4* sp = (const f32x4*)(SSQ2 + (size_t)r * 16); const f32x4 s0 = sp[0], s1 = sp[1], s2 = sp[2], s3 = sp[3];
                const float tot = ((s0[0] + s0[1]) + (s0[2] + s0[3])) + ((s1[0] + s1[1]) + (s1[2] + s1[3])) + ((s2[0] + s2[1]) + (s2[2] + s2[3])) + ((s3[0] + s3[1]) + (s3[2] + s3[3]));
                const float rs = rsqrtf(tot * (1.f / 1024.f) + EPS);
#pragma unroll
                for (int bj = 0; bj < 2; ++bj) { const f32x4 gv = acc[ai][bj][m][0] * rs, uv = acc[ai][bj][m][1] * rs; float o[4];
#pragma unroll
                    for (int i = 0; i < 4; ++i) o[i] = gv[i] * sigmoidf_(gv[i]) * uv[i];
                    u32x2 w; w.x = cvtpk(o[0], o[1]); w.y = cvtpk(o[2], o[3]);
                    *(u32x2*)(ACT + (size_t)r * FF + col0 + bj * 64) = w; } }
    }
};

typedef std::integral_constant<bool, true> TrueC; typedef std::integral_constant<bool, false> FalseC;
__device__ __forceinline__ int crow(int r, int hi) { return (r & 3) + 8 * (r >> 2) + 4 * hi; }
__device__ __forceinline__ constexpr int ccol(int r) { return (r & 3) + 8 * (r >> 2); }
__device__ __forceinline__ void glds16(const void* g, LAS unsigned char* l) {
    unsigned keep; const unsigned dst = (unsigned)__builtin_amdgcn_readfirstlane((int)(unsigned)(uintptr_t)l);
    asm volatile("s_mov_b32 %0, m0\n\ts_mov_b32 m0, %2\n\ts_nop 0\n\tglobal_load_lds_dwordx4 %1, off\n\ts_mov_b32 m0, %0" : "=&s"(keep) : "v"(g), "s"(dst) : "memory");
}
#define VM_DRAIN_SYNC() do { asm volatile("s_waitcnt vmcnt(0)" ::: "memory"); __syncthreads(); } while (0)
#define WAIT_BAR(N) asm volatile("s_waitcnt vmcnt(" #N ") lgkmcnt(0)\n\ts_barrier" ::: "memory")
__device__ __forceinline__ void wait_bar_n(int n) { if (n == 4) WAIT_BAR(4); else if (n == 2) WAIT_BAR(2); else if (n == 1) WAIT_BAR(1); else WAIT_BAR(0); }
__device__ __forceinline__ void qkt(f32x16& p0, f32x16& p1, const LAS unsigned char* Kslot, const bf16x8* qr, int r32, int hi) {
    const LAS unsigned char* kb = Kslot + hi * 1024 + r32 * 16;
    bf16x8 kf[8];
#pragma unroll
    for (int d0 = 0; d0 < 4; ++d0) { kf[2 * d0] = *(const LAS bf16x8*)(kb + d0 * 2048); kf[2 * d0 + 1] = *(const LAS bf16x8*)(kb + d0 * 2048 + 512); }
    const f32x16 zz = f32x16{};
    p0 = __builtin_amdgcn_mfma_f32_32x32x16_bf16(kf[0], qr[0], zz, 0, 0, 0); p1 = __builtin_amdgcn_mfma_f32_32x32x16_bf16(kf[1], qr[0], zz, 0, 0, 0);
#pragma unroll
    for (int d0 = 1; d0 < 4; ++d0) { p0 = __builtin_amdgcn_mfma_f32_32x32x16_bf16(kf[2 * d0], qr[d0], p0, 0, 0, 0); p1 = __builtin_amdgcn_mfma_f32_32x32x16_bf16(kf[2 * d0 + 1], qr[d0], p1, 0, 0, 0); }
}
__device__ __forceinline__ s16x4 vtr(const LAS unsigned char* p) { return __builtin_bit_cast(s16x4, __builtin_amdgcn_ds_read_tr16_b64_v4i16((LAS s16x4*)p)); }
template <int NDB> struct Flash {
    f32x16 o[NDB]; float mhat, l; bool first;
    __device__ __forceinline__ void reset() {
#pragma unroll
        for (int d = 0; d < NDB; ++d) o[d] = f32x16{};
        mhat = 0.f; l = 0.f; first = true; }
    __device__ __forceinline__ void pre(const f32x16& p0, const f32x16& p1, LAS float* wsf, int r32, int hi, bool rowvalid = true) {
        float a = fmaxf(p0[0], p1[0]);
#pragma unroll
        for (int r = 1; r < 16; ++r) a = fmaxf(a, fmaxf(p0[r], p1[r]));
        float rm = fmaxf(a, __shfl_xor(a, 32)) - mhat;
        if (!rowvalid) rm = -INFINITY;
        bool need; float dl;
        if (first) { need = true; dl = (rm > -1e30f) ? rm : 0.f; }
        else { need = __any(rm > 8.0f); dl = fmaxf(rm, 0.f); }
        if (need) {
            mhat += dl;
            if (!first) {
                const float f = __builtin_amdgcn_exp2f(-dl); l *= f;
                if (hi == 0) wsf[r32] = f;
                asm volatile("s_waitcnt lgkmcnt(0)" ::: "memory");
#pragma unroll
                for (int k = 0; k < 4; ++k) { const f32x4 t = *(const LAS f32x4*)(wsf + 8 * k + 4 * hi);
#pragma unroll
                    for (int d = 0; d < NDB; ++d) { o[d][4 * k] *= t[0]; o[d][4 * k + 1] *= t[1]; o[d][4 * k + 2] *= t[2]; o[d][4 * k + 3] *= t[3]; } }
                asm volatile("s_waitcnt lgkmcnt(0)" ::: "memory");
            }
        }
        first = false;
    }
    __device__ __forceinline__ void expsum(f32x16& p0, f32x16& p1, bool rowvalid = true) {
        const float m = rowvalid ? mhat : INFINITY;
        float s = 0.f;
#pragma unroll
        for (int r = 0; r < 16; ++r) { p0[r] = __builtin_amdgcn_exp2f(p0[r] - m); p1[r] = __builtin_amdgcn_exp2f(p1[r] - m); s += p0[r] + p1[r]; }
        l += s;
    }
    __device__ __forceinline__ void pv(const f32x16& p0, const f32x16& p1, const LAS unsigned char* Vslot, int lane, int hi) {
        u32x4 pw[4];
        pw[0] = (u32x4){cvtpk(p0[0], p0[1]), cvtpk(p0[2], p0[3]), cvtpk(p0[4], p0[5]), cvtpk(p0[6], p0[7])};
        pw[1] = (u32x4){cvtpk(p0[8], p0[9]), cvtpk(p0[10], p0[11]), cvtpk(p0[12], p0[13]), cvtpk(p0[14], p0[15])};
        pw[2] = (u32x4){cvtpk(p1[0], p1[1]), cvtpk(p1[2], p1[3]), cvtpk(p1[4], p1[5]), cvtpk(p1[6], p1[7])};
        pw[3] = (u32x4){cvtpk(p1[8], p1[9]), cvtpk(p1[10], p1[11]), cvtpk(p1[12], p1[13]), cvtpk(p1[14], p1[15])};
        const LAS unsigned char* vp = Vslot + ((lane >> 4) & 1) * 32 + (lane & 3) * 8 + (4 * hi + ((lane & 15) >> 2)) * 64;
#pragma unroll
        for (int d = 0; d < NDB; ++d) {
            bf16x8 vf[4];
#pragma unroll
            for (int ks = 0; ks < 4; ++ks) { const s16x4 lo = vtr(vp + (d * 4 + ks) * 1024), hh = vtr(vp + (d * 4 + ks) * 1024 + 512);
                vf[ks] = (bf16x8){lo[0], lo[1], lo[2], lo[3], hh[0], hh[1], hh[2], hh[3]}; }
#pragma unroll
            for (int ks = 0; ks < 4; ++ks) o[d] = __builtin_amdgcn_mfma_f32_32x32x16_bf16(__builtin_bit_cast(bf16x8, pw[ks]), vf[ks], o[d], 0, 0, 0);
        }
    }
    __device__ __forceinline__ float ltot() const { return l + __shfl_xor(l, 32); }
};
__device__ __forceinline__ void row_bcast(float v, float (&fr_)[16], LAS float* wsf, int r32, int hi) {
    asm volatile("s_waitcnt lgkmcnt(0)" ::: "memory");
    if (hi == 0) wsf[r32] = v;
    asm volatile("s_waitcnt lgkmcnt(0)" ::: "memory");
#pragma unroll
    for (int k = 0; k < 4; ++k) { const f32x4 t = *(const LAS f32x4*)(wsf + 8 * k + 4 * hi); fr_[4 * k] = t[0]; fr_[4 * k + 1] = t[1]; fr_[4 * k + 2] = t[2]; fr_[4 * k + 3] = t[3]; }
    asm volatile("s_waitcnt lgkmcnt(0)" ::: "memory");
}

constexpr int DF_STAGE = 0;
constexpr int DF_WSF = 98304;
__device__ __forceinline__ void diff_unit(LAS unsigned char* L, int b, int h, int qb, const unsigned char* ws, float lam, const float* subg) {
    int tid_ = threadIdx.x; asm volatile("" : "+v"(tid_));
    const int tid = tid_, lane = tid & 63, r32 = lane & 31, hi = lane >> 5, wid = __builtin_amdgcn_readfirstlane(tid >> 6);
    const int comp = wid >> 2, rgi = wid & 3;
    const size_t bh = (size_t)(b * 4 + h) * S;
    const bf16_t* Qp = (const bf16_t*)(ws + WS_DQ) + (bh + qb * 128 + rgi * 32 + r32) * 128 + comp * 64;
    bf16x8 qr[4];
#pragma unroll
    for (int d0 = 0; d0 < 4; ++d0) qr[d0] = *(const bf16x8*)(Qp + d0 * 16 + hi * 8);
    const bf16_t* Kg = (const bf16_t*)(ws + WS_DK) + bh * 128 + (size_t)lane * 128 + wid * 8;
    const bf16_t* Vg = (const bf16_t*)(ws + WS_DV) + bh * 128 + (size_t)(16 * (wid & 3) + (lane >> 2)) * 128 + (wid >> 2) * 32 + (lane & 3) * 8;
    LAS float* wsf = (LAS float*)(L + DF_WSF) + wid * 32;
    const int NT = 2 * qb + 2;
    Flash<4> F; F.reset();
    auto dmaK = [&](int t, int s) { const bf16_t* src = Kg + (size_t)t * 8192; LAS unsigned char* d = L + s * 16384 + wid * 1024; glds16(src, d); glds16(src + 64, d + 8192); };
    auto dmaV = [&](int t, int s) { const bf16_t* src = Vg + (size_t)t * 8192; LAS unsigned char* d = L + 49152 + s * 16384 + wid * 1024; glds16(src, d); glds16(src + 64, d + 8192); };
    dmaK(0, 0); dmaV(0, 0); dmaK(1, 1); dmaV(1, 1); if (NT > 2) dmaK(2, 2);
    WAIT_BAR(0);
    f32x16 a0, a1, b0, b1;
    qkt(a0, a1, L + comp * 8192, qr, r32, hi);
    WAIT_BAR(0);
    const int xq = 32 * rgi + r32 - 4 * hi;
    int s0 = 0, s1 = 1, s2 = 2;
    auto iter = [&](int t, f32x16& c0, f32x16& c1, f32x16& n0, f32x16& n1, auto next) {
        int nis = 0;
        if (t + 3 < NT) { dmaK(t + 3, s0); nis += 2; }
        if (t + 2 < NT) { dmaV(t + 2, s2); nis += 2; }
        if (t >= NT - 2) { const int x = xq - 64 * (t - (NT - 2));
#pragma unroll
            for (int r = 0; r < 16; ++r) { if (ccol(r) > x) c0[r] = -INFINITY; if (ccol(r) + 32 > x) c1[r] = -INFINITY; } }
        F.pre(c0, c1, wsf, r32, hi);
        if constexpr (decltype(next)::value) qkt(n0, n1, L + s1 * 16384 + comp * 8192, qr, r32, hi);
        F.expsum(c0, c1);
        F.pv(c0, c1, L + 49152 + s0 * 16384, lane, hi);
        wait_bar_n(nis);
        const int tmp = s0; s0 = s1; s1 = s2; s2 = tmp;
    };
    int t = 0;
    for (; t < NT - 2; t += 2) { iter(t, a0, a1, b0, b1, TrueC{}); iter(t + 1, b0, b1, a0, a1, TrueC{}); }
    iter(NT - 2, a0, a1, b0, b1, TrueC{});
    iter(NT - 1, b0, b1, a0, a1, FalseC{});
    const float lt = F.ltot();
    float fr_[16];
    row_bcast((comp ? lam : 1.f) / lt, fr_, wsf, r32, hi);
    LAS float* stg = (LAS float*)(L + DF_STAGE) + rgi * 32 * 132;
    if (comp == 1) {
#pragma unroll
        for (int d = 0; d < 4; ++d)
#pragma unroll
            for (int r = 0; r < 16; ++r) stg[crow(r, hi) * 132 + d * 32 + r32] = F.o[d][r] * fr_[r];
    }
    __syncthreads();
    if (comp == 0) {
#pragma unroll
        for (int d = 0; d < 4; ++d)
#pragma unroll
            for (int r = 0; r < 16; ++r) { const int ix = crow(r, hi) * 132 + d * 32 + r32; stg[ix] = F.o[d][r] * fr_[r] - stg[ix]; }
        asm volatile("s_waitcnt lgkmcnt(0)" ::: "memory");
        const LAS float* rowp = stg + r32 * 132 + 64 * hi;
        float ss = 0.f;
#pragma unroll
        for (int k = 0; k < 16; ++k) { const f32x4 v = *(const LAS f32x4*)(rowp + 4 * k); ss += (v[0] * v[0] + v[1] * v[1]) + (v[2] * v[2] + v[3] * v[3]); }
        ss += __shfl_xor(ss, 32);
        const float rstd = rsqrtf(ss * (1.f / 128.f) + EPS) * (1.f - LAM_INIT);
        bf16_t* Yp = (bf16_t*)(ws + WS_YA) + ((size_t)b * S + qb * 128 + rgi * 32 + r32) * 512 + h * 128 + 64 * hi;
#pragma unroll
        for (int k = 0; k < 8; ++k) { const f32x4 v0 = *(const LAS f32x4*)(rowp + 8 * k), v1 = *(const LAS f32x4*)(rowp + 8 * k + 4);
            const f32x4 g0 = *(const f32x4*)(subg + 64 * hi + 8 * k), g1 = *(const f32x4*)(subg + 64 * hi + 8 * k + 4);
            u32x4 w; w.x = cvtpk(v0[0] * rstd * g0[0], v0[1] * rstd * g0[1]); w.y = cvtpk(v0[2] * rstd * g0[2], v0[3] * rstd * g0[3]);
            w.z = cvtpk(v1[0] * rstd * g1[0], v1[1] * rstd * g1[1]); w.w = cvtpk(v1[2] * rstd * g1[2], v1[3] * rstd * g1[3]);
            *(u32x4*)(Yp + 8 * k) = w; }
    }
    __syncthreads();
}

constexpr int NS_CMP = 49152;
constexpr int NS_GL = 114688;
constexpr int NS_WSF = 147456;
template <int MODE>
__device__ __forceinline__ void nsa_kv_pass(LAS unsigned char* L, Flash<2>& F, const bf16x8* qr, const bf16_t* Kg0, const bf16_t* Vg0, int jlo, int jhi, int qblk, int ql, unsigned long long mymask,
                                            LAS float* wsf, int wid, int lane, int r32, int hi) {
    auto dmaK = [&](int j, int s) { glds16(Kg0 + (size_t)j * 4096, L + s * 8192 + wid * 1024); };
    auto dmaV = [&](int j, int s) { glds16(Vg0 + (size_t)j * 4096, L + 24576 + s * 8192 + wid * 1024); };
    dmaK(jlo, 0); dmaV(jlo, 0); if (jlo + 1 <= jhi) { dmaK(jlo + 1, 1); dmaV(jlo + 1, 1); } if (jlo + 2 <= jhi) dmaK(jlo + 2, 2);
    WAIT_BAR(0);
    f32x16 a0, a1, b0, b1;
    qkt(a0, a1, L, qr, r32, hi);
    WAIT_BAR(0);
    const int xq = ql - 4 * hi;
    int s0 = 0, s1 = 1, s2 = 2;
    auto iter = [&](int j, f32x16& c0, f32x16& c1, f32x16& n0, f32x16& n1, auto next) {
        int nis = 0;
        if (j + 3 <= jhi) { dmaK(j + 3, s0); nis += 1; }
        if (j + 2 <= jhi) { dmaV(j + 2, s2); nis += 1; }
        bool rowvalid = true;
        if (MODE == 1) {
            rowvalid = (mymask >> j) & 1ull;
            if (j == qblk) {
#pragma unroll
                for (int r = 0; r < 16; ++r) { if (ccol(r) > xq) c0[r] = -INFINITY; if (ccol(r) + 32 > xq) c1[r] = -INFINITY; } }
        } else {
            if (j == qblk || j == qblk - 8) { const int base = 64 * (qblk - j) + xq;
#pragma unroll
                for (int r = 0; r < 16; ++r) { if ((unsigned)(base - ccol(r)) >= 512u) c0[r] = -INFINITY; if ((unsigned)(base - ccol(r) - 32) >= 512u) c1[r] = -INFINITY; } }
        }
        F.pre(c0, c1, wsf, r32, hi, rowvalid);
        if constexpr (decltype(next)::value) qkt(n0, n1, L + s1 * 8192, qr, r32, hi);
        F.expsum(c0, c1, rowvalid);
        F.pv(c0, c1, L + 24576 + s0 * 8192, lane, hi);
        wait_bar_n(nis);
        const int tmp = s0; s0 = s1; s1 = s2; s2 = tmp;
    };
    int j = jlo;
    for (; j + 2 <= jhi; j += 2) { iter(j, a0, a1, b0, b1, TrueC{}); iter(j + 1, b0, b1, a0, a1, TrueC{}); }
    if (j < jhi) { iter(j, a0, a1, b0, b1, TrueC{}); iter(jhi, b0, b1, a0, a1, FalseC{}); }
    else iter(jhi, a0, a1, b0, b1, FalseC{});
}
__device__ __forceinline__ void nsa_unit(LAS unsigned char* L, int b, int g, int qblk, const unsigned char* ws) {
    int tid_ = threadIdx.x; asm volatile("" : "+v"(tid_));
    const int tid = tid_, lane = tid & 63, r32 = lane & 31, hi = lane >> 5, wid = __builtin_amdgcn_readfirstlane(tid >> 6);
    const int ql = 8 * wid + (r32 & 7), hh = r32 >> 3, head = g * 4 + hh;
    const int qpos = 64 * qblk + ql;
    const size_t tok = (size_t)b * S + qpos;
    const bf16_t* Qp = (const bf16_t*)(ws + WS_NQ) + ((size_t)(b * 8 + head) * S + qpos) * 64;
    bf16x8 qr[4];
#pragma unroll
    for (int d0 = 0; d0 < 4; ++d0) qr[d0] = *(const bf16x8*)(Qp + d0 * 16 + hi * 8);
    const float* NGp = (const float*)(ws + WS_NG) + tok * 24 + head;
    const float g0 = NGp[0], g1 = NGp[8], g2 = NGp[16];
    LAS float* wsf = (LAS float*)(L + NS_WSF) + wid * 32;
    const size_t pg = (size_t)(b * 2 + g);
    LAS float* yst = (LAS float*)(L + NS_CMP) + wid * 2048;
    float fr_[16];
    unsigned long long mymask = 0ull;
    {
        const int ntc = ((4 * qblk + 2) >> 6) + 1;
        const bf16_t* Kc = (const bf16_t*)(ws + WS_KCMP) + (pg * 256 + lane) * 64 + wid * 8;
        const bf16_t* Vc = (const bf16_t*)(ws + WS_VCMP) + (pg * 256 + 16 * (wid & 3) + (lane >> 2)) * 64 + (wid >> 2) * 32 + (lane & 3) * 8;
        for (int ct = 0; ct < ntc; ++ct) { glds16(Kc + (size_t)ct * 4096, L + NS_CMP + ct * 8192 + wid * 1024); glds16(Vc + (size_t)ct * 4096, L + NS_CMP + 32768 + ct * 8192 + wid * 1024); }
        VM_DRAIN_SYNC();
        const int cm = (qpos >= 31) ? ((qpos - 31) >> 4) : -1;
        Flash<2> F; F.reset();
        for (int ct = 0; ct < ntc; ++ct) {
            f32x16 p0, p1;
            qkt(p0, p1, L + NS_CMP + ct * 8192, qr, r32, hi);
            const int x = cm - 64 * ct - 4 * hi;
#pragma unroll
            for (int r = 0; r < 16; ++r) { if (ccol(r) > x) p0[r] = -INFINITY; if (ccol(r) + 32 > x) p1[r] = -INFINITY; }
            F.pre(p0, p1, wsf, r32, hi);
            F.expsum(p0, p1);
            F.pv(p0, p1, L + NS_CMP + 32768 + ct * 8192, lane, hi);
        }
        const float lt = F.ltot();
        const float il = lt > 0.f ? 1.f / lt : 0.f;
        LAS float* Gs = (LAS float*)(L + NS_GL) + wid * 1024;
        LAS float* Ls = Gs + 512;
        for (int ct = 0; ct < ntc; ++ct) {
            f32x16 p0, p1;
            qkt(p0, p1, L + NS_CMP + ct * 8192, qr, r32, hi);
            const int x = cm - 64 * ct - 4 * hi;
#pragma unroll
            for (int r = 0; r < 16; ++r) {
                float a = (ccol(r) > x) ? 0.f : __builtin_amdgcn_exp2f(p0[r] - F.mhat) * il, bq = (ccol(r) + 32 > x) ? 0.f : __builtin_amdgcn_exp2f(p1[r] - F.mhat) * il;
                a += __shfl_xor(a, 8); a += __shfl_xor(a, 16); bq += __shfl_xor(bq, 8); bq += __shfl_xor(bq, 16);
                p0[r] = a; p1[r] = bq; }
            if (r32 < 8) {
#pragma unroll
                for (int k = 0; k < 4; ++k) { const int jj = 16 * ct + 2 * k + hi;
                    Gs[r32 * 64 + jj] = (p0[4 * k] + p0[4 * k + 1]) + (p0[4 * k + 2] + p0[4 * k + 3]); Ls[r32 * 64 + jj] = p0[4 * k + 3];
                    Gs[r32 * 64 + jj + 8] = (p1[4 * k] + p1[4 * k + 1]) + (p1[4 * k + 2] + p1[4 * k + 3]); Ls[r32 * 64 + jj + 8] = p1[4 * k + 3]; }
            }
        }
        asm volatile("s_waitcnt lgkmcnt(0)" ::: "memory");
        const int j = lane, jmax = 16 * ntc;
        for (int qi = 0; qi < 8; ++qi) {
            float v = (j < jmax) ? Gs[qi * 64 + j] : 0.f;
            if (j >= 1 && j - 1 < jmax) v += Ls[qi * 64 + j - 1];
            if (j == 0 || j == qblk || j == qblk - 1) v = 1e9f;
            if (j > qblk) v = -1e30f;
            int cnt = 0;
            for (int i = 0; i < 64; ++i) { const float vi = __uint_as_float(__builtin_amdgcn_readlane(__float_as_uint(v), i)); cnt += (vi > v || (vi == v && i < j)) ? 1 : 0; }
            const unsigned long long m = __ballot((cnt < 16) && (j <= qblk));
            if ((r32 & 7) == qi) mymask = m;
        }
        asm volatile("s_waitcnt lgkmcnt(0)" ::: "memory");
        __syncthreads();
        row_bcast(g0 * il, fr_, wsf, r32, hi);
#pragma unroll
        for (int d = 0; d < 2; ++d)
#pragma unroll
            for (int r = 0; r < 16; ++r) yst[crow(r, hi) * 64 + d * 32 + r32] = F.o[d][r] * fr_[r];
    }
    const size_t koff = (pg * S + lane) * 64 + wid * 8;
    const size_t voff = (pg * S + 16 * (wid & 3) + (lane >> 2)) * 64 + (wid >> 2) * 32 + (lane & 3) * 8;
    {
        Flash<2> F; F.reset();
        nsa_kv_pass<1>(L, F, qr, (const bf16_t*)(ws + WS_KS) + koff, (const bf16_t*)(ws + WS_VS) + voff, 0, qblk, qblk, ql, mymask, wsf, wid, lane, r32, hi);
        const float lt = F.ltot();
        row_bcast(g1 / lt, fr_, wsf, r32, hi);
#pragma unroll
        for (int d = 0; d < 2; ++d)
#pragma unroll
            for (int r = 0; r < 16; ++r) yst[crow(r, hi) * 64 + d * 32 + r32] += F.o[d][r] * fr_[r];
    }
    {
        Flash<2> F; F.reset();
        const int jlo = qblk >= 8 ? qblk - 8 : 0;
        nsa_kv_pass<2>(L, F, qr, (const bf16_t*)(ws + WS_KW) + koff, (const bf16_t*)(ws + WS_VW) + voff, jlo, qblk, qblk, ql, 0ull, wsf, wid, lane, r32, hi);
        const float lt = F.ltot();
        row_bcast(g2 / lt, fr_, wsf, r32, hi);
        LAS bf16_t* stg = (LAS bf16_t*)(L + NS_GL) + wid * 2048;
#pragma unroll
        for (int r = 0; r < 16; ++r) { const int orow = crow(r, hi);
#pragma unroll
            for (int d = 0; d < 2; ++d) { const float yv = yst[orow * 64 + d * 32 + r32] + F.o[d][r] * fr_[r]; stg[orow * 64 + d * 32 + r32] = (bf16_t)(cvtpk(yv, 0.f) & 0xffffu); } }
        asm volatile("s_waitcnt lgkmcnt(0)" ::: "memory");
        bf16_t* Yb = (bf16_t*)(ws + WS_YB);
#pragma unroll
        for (int i = 0; i < 4; ++i) { const int row = i * 8 + (lane >> 3), ch = lane & 7; const u32x4 v = *(const LAS u32x4*)(stg + row * 64 + ch * 8);
            *(u32x4*)(Yb + ((size_t)b * S + 64 * qblk + 8 * wid + (row & 7)) * 512 + (g * 4 + (row >> 3)) * 64 + ch * 8) = v; }
    }
    __syncthreads();
}

#define XB_TMO      128
#define XB_XCNT(j)  (256  + 64 * (j))
#define XB_XSUB(j)  (1280 + 64 * (j))
#define XB_XGEN(j)  (2304 + 64 * (j))
#define XB_TOP      3328
#define XB_TOPGEN   3392
#define XCD_BAR_WORDS 3456
#define XB_SPIN_CAP (1u << 18)

__device__ __forceinline__ unsigned xb_ld(unsigned* p)              { return __hip_atomic_load(p, __ATOMIC_RELAXED, __HIP_MEMORY_SCOPE_AGENT); }
__device__ __forceinline__ unsigned xb_add(unsigned* p, unsigned v) { return __hip_atomic_fetch_add(p, v, __ATOMIC_RELAXED, __HIP_MEMORY_SCOPE_AGENT); }
__device__ __forceinline__ unsigned xb_xcc_id() { return (unsigned)__builtin_amdgcn_s_getreg((3 << 11) | 20) & 0xFu; }
#define XB_SPIN(cond, bar) do { unsigned _sp = 0; while (cond) { __builtin_amdgcn_s_sleep(1); \
    if ((++_sp & 255u) == 0u) { if (xb_ld(&(bar)[XB_TMO])) break; if (_sp > XB_SPIN_CAP) { atomicAdd(&(bar)[XB_TMO], 1u); break; } } } } while (0)

struct XcdBarrier {
    unsigned* bar; unsigned x;
    volatile LAS unsigned* st;
};

__device__ __forceinline__ XcdBarrier xcd_barrier_post(unsigned* bar, volatile LAS unsigned* st) {
    XcdBarrier b; b.bar = bar; b.x = xb_xcc_id(); b.st = st;
    if (threadIdx.x == 0) (void)xb_add(&bar[XB_XCNT(b.x)], 1u);
    return b;
}
__device__ __forceinline__ void xcd_barrier_complete(unsigned* bar, unsigned x, unsigned& nloc, unsigned& nx) {
    const unsigned G = gridDim.x * gridDim.y * gridDim.z;
    unsigned sum, cnt, mine, sp = 0u;
    for (;;) {
        sum = 0u; cnt = 0u; mine = 0u;
#pragma unroll
        for (unsigned j = 0; j < 16; ++j) { const unsigned c = xb_ld(&bar[XB_XCNT(j)]); sum += c; cnt += (c > 0u) ? 1u : 0u; mine = (j == x) ? c : mine; }
        if (sum == G) break;
        __builtin_amdgcn_s_sleep(1);
        if ((++sp & 255u) == 0u) { if (xb_ld(&bar[XB_TMO])) break; if (sp > XB_SPIN_CAP) { atomicAdd(&bar[XB_TMO], 1u); break; } }
    }
    nloc = mine > 0u ? mine : 1u; nx = cnt > 0u ? cnt : 1u;
}

__device__ __forceinline__ void xcd_barrier(const XcdBarrier& b) {
    asm volatile("s_waitcnt vmcnt(0)" ::: "memory");
    __syncthreads();
    if (threadIdx.x == 0) {
        unsigned* bar = b.bar;
        __builtin_amdgcn_s_waitcnt(0);
        unsigned nloc = b.st[0], nx = b.st[1];
        if (nloc == 0u) { xcd_barrier_complete(bar, b.x, nloc, nx); b.st[0] = nloc; b.st[1] = nx; }
        const unsigned old = xb_add(&bar[XB_XSUB(b.x)], 1u);
        const unsigned gen = old / nloc;
        if (old + 1u == (gen + 1u) * nloc) {
            __builtin_amdgcn_fence(__ATOMIC_RELEASE, "agent");
            asm volatile("s_waitcnt vmcnt(0)" ::: "memory");
            const unsigned og = xb_add(&bar[XB_TOP], 1u);
            const unsigned tg = og / nx;
            if (og + 1u == (tg + 1u) * nx) xb_add(&bar[XB_TOPGEN], 1u);
            else XB_SPIN(xb_ld(&bar[XB_TOPGEN]) == tg, bar);
            __builtin_amdgcn_fence(__ATOMIC_ACQUIRE, "agent");
            xb_add(&bar[XB_XGEN(b.x)], 1u);
            asm volatile("s_waitcnt vmcnt(0)" ::: "memory");
        } else {
            XB_SPIN(xb_ld(&bar[XB_XGEN(b.x)]) == gen, bar);
            __builtin_amdgcn_fence(__ATOMIC_ACQUIRE, "agent");
            asm volatile("s_waitcnt vmcnt(0)" ::: "memory");
        }
    }
    __syncthreads();
}


template <class MapF>
__device__ __forceinline__ void tr_item(const float* W, int K, int N, int ldw, bf16_t* WT, const float* kscale, LAS float* scr, int item, int lane, const MapF& map) {
    const int nblk = (N + 31) / 32, kb = item / nblk, nb = item % nblk, k0 = 64 * kb, n0 = 32 * nb;
    const int nn = n0 + (lane & 31);
#pragma unroll 8
    for (int i = 0; i < 32; ++i) { const int kk = 2 * i + (lane >> 5); float v = (nn < N) ? W[(size_t)(k0 + kk) * ldw + nn] : 0.f; if (kscale) v *= kscale[k0 + kk]; scr[kk * 33 + (lane & 31)] = v; }
    asm volatile("s_waitcnt lgkmcnt(0)" ::: "memory");
    const int c = lane & 7;
#pragma unroll
    for (int jx = 0; jx < 4; ++jx) { const int n = (lane >> 3) + 8 * jx; const LAS float* s = scr + (8 * c) * 33 + n;
        u32x4 o; o.x = cvtpk(s[0 * 33], s[1 * 33]); o.y = cvtpk(s[2 * 33], s[3 * 33]); o.z = cvtpk(s[4 * 33], s[5 * 33]); o.w = cvtpk(s[6 * 33], s[7 * 33]);
        if (n0 + n < N) *(u32x4*)(WT + (size_t)map(n0 + n) * K + k0 + 8 * c) = o; }
    asm volatile("s_waitcnt lgkmcnt(0)" ::: "memory");
}
__device__ __forceinline__ int rope_pos(int d) { return d < 32 ? 8 * (d >> 2) + (d & 3) : 8 * ((d - 32) >> 2) + 4 + (d & 3); }
struct MapIn {
    __device__ __forceinline__ int operator()(int n) const {
        if (n >= 2840) return 2816 + (n - 2840);
        if (n >= 2816) return 4864 + (n - 2816);
        bool rope;
        if (n < 1024) rope = true; else if (n < 1536) rope = false; else if (n < 2048) rope = true; else rope = (((n - 2048) >> 7) & 1) == 0;
        return rope ? (n & ~63) + rope_pos(n & 63) : n;
    }
};
struct MapId { int off; __device__ __forceinline__ int operator()(int n) const { return off + n; } };
struct MapGU { int up; __device__ __forceinline__ int operator()(int f) const { return 8 * (f >> 2) + 4 * up + (f & 3); } };

struct Args { const void* in[20]; float* out; unsigned char* ws; };

__global__ void __launch_bounds__(512, 2) hybrid_fwd(Args args) {
    extern __shared__ __attribute__((aligned(16))) unsigned char lds_raw[];
    LAS unsigned char* L = (LAS unsigned char*)lds_raw;
    cg::grid_group grid = cg::this_grid();
    const int tid = threadIdx.x, lane = tid & 63, wave = __builtin_amdgcn_readfirstlane(tid >> 6);
    const int G = gridDim.x, bx = blockIdx.x;
    unsigned char* ws = args.ws;
    const float* x = (const float*)args.in[0];
    const int* positions = (const int*)args.in[1];
    float* out = args.out;
    unsigned* ctl = (unsigned*)(ws + WS_CTL);
    LAS int* misc = (LAS int*)(L + LDS_BYTES - 64);
    if (tid < 16) misc[tid] = 0;
    __syncthreads();
    const XcdBarrier xbar = xcd_barrier_post(ctl + 4096, (volatile LAS unsigned*)(misc + 8));

    {
        LAS float* scr = (LAS float*)(L + wave * 16384);
        const int gw = bx * 8 + wave, NGW = G * 8;
        const float* g1 = (const float*)args.in[2]; const float* g2 = (const float*)args.in[15];
        constexpr int I_IN = 16 * 153, I_G = 16 * 88, I_D = 44 * 32, I_O = 16 * 32, I_A = 8 * 32, I_C = 16 * 8;
        constexpr int NIT = I_IN + 2 * I_G + I_D + I_O + 2 * I_A + 4 * I_C;
        for (int it = gw; it < NIT; it += NGW) {
            int r = it;
            if (r < I_IN) { tr_item((const float*)args.in[3], 1024, 4888, 4888, (bf16_t*)(ws + WS_WIN), g1, scr, r, lane, MapIn{}); continue; } r -= I_IN;
            if (r < I_G) { tr_item((const float*)args.in[16], 1024, FF, FF, (bf16_t*)(ws + WS_WGU), g2, scr, r, lane, MapGU{0}); continue; } r -= I_G;
            if (r < I_G) { tr_item((const float*)args.in[17], 1024, FF, FF, (bf16_t*)(ws + WS_WGU), g2, scr, r, lane, MapGU{1}); continue; } r -= I_G;
            if (r < I_D) { tr_item((const float*)args.in[18], FF, 1024, 1024, (bf16_t*)(ws + WS_WD), nullptr, scr, r, lane, MapId{0}); continue; } r -= I_D;
            if (r < I_O) { tr_item((const float*)args.in[14], 1024, 1024, 1024, (bf16_t*)(ws + WS_WO), nullptr, scr, r, lane, MapId{0}); continue; } r -= I_O;
            if (r < I_A) { tr_item((const float*)args.in[12], 512, 1024, 1024, (bf16_t*)(ws + WS_WA), nullptr, scr, r, lane, MapId{0}); continue; } r -= I_A;
            if (r < I_A) { tr_item((const float*)args.in[13], 512, 1024, 1024, (bf16_t*)(ws + WS_WB), nullptr, scr, r, lane, MapId{0}); continue; } r -= I_A;
            if (r < I_C) { tr_item((const float*)args.in[8], 1024, 256, 256, (bf16_t*)(ws + WS_W1K), nullptr, scr, r, lane, MapId{0}); continue; } r -= I_C;
            if (r < I_C) { tr_item((const float*)args.in[8] + 1024 * 256, 1024, 256, 256, (bf16_t*)(ws + WS_W1K), nullptr, scr, r, lane, MapId{256}); continue; } r -= I_C;
            if (r < I_C) { tr_item((const float*)args.in[10], 1024, 256, 256, (bf16_t*)(ws + WS_W1V), nullptr, scr, r, lane, MapId{0}); continue; } r -= I_C;
            tr_item((const float*)args.in[10] + 1024 * 256, 1024, 256, 256, (bf16_t*)(ws + WS_W1V), nullptr, scr, r, lane, MapId{256});
        }
        bf16_t* XB = (bf16_t*)(ws + WS_XB); float* rs1 = (float*)(ws + WS_RS1);
        float* cosT = (float*)(ws + WS_COS); float* sinT = (float*)(ws + WS_SIN);
        const float invf = 1.0f / powf(10000.0f, (float)(2 * (lane & 31)) / 64.0f);
        for (int m = gw; m < T; m += NGW) {
            const f32x4* xr = (const f32x4*)(x + (size_t)m * D) + lane;
            f32x4 v[4]; float s = 0.f;
#pragma unroll
            for (int jx = 0; jx < 4; ++jx) { v[jx] = xr[64 * jx]; s += (v[jx][0] * v[jx][0] + v[jx][1] * v[jx][1]) + (v[jx][2] * v[jx][2] + v[jx][3] * v[jx][3]); }
            s = wave_sum(s);
            if (lane == 0) rs1[m] = rsqrtf(s * (1.f / D) + EPS);
            u32x2* o8 = (u32x2*)(XB + (size_t)m * D) + lane;
#pragma unroll
            for (int jx = 0; jx < 4; ++jx) { u32x2 w; w.x = cvtpk(v[jx][0], v[jx][1]); w.y = cvtpk(v[jx][2], v[jx][3]); o8[64 * jx] = w; }
            const float ang = (float)positions[m] * invf;
            if (lane < 32) cosT[(size_t)m * 32 + lane] = cosf(ang); else sinT[(size_t)m * 32 + (lane - 32)] = sinf(ang);
        }
        if (bx < 32) {
            const int kv = bx >> 4, slab = bx & 15;
            const float* pe = (const float*)args.in[kv ? 7 : 6]; const float* W1 = (const float*)args.in[kv ? 10 : 8];
            const int n = tid & 255, half = tid >> 8; float acc = 0.f;
            for (int k = slab * 128 + half * 64; k < slab * 128 + half * 64 + 64; ++k) acc += pe[k] * W1[(size_t)k * 256 + n];
            __syncthreads();
            LAS float* red = (LAS float*)L;
            if (half) red[n] = acc;
            __syncthreads();
            if (!half) ((float*)(ws + WS_BIASP))[(kv * 16 + slab) * 256 + n] = acc + red[n];
            __syncthreads();
        }
    }
    grid.sync();
    {
        pg8::Gemm g{(const bf16_t*)(ws + WS_XB), (const bf16_t*)(ws + WS_WIN), T, INP, D}; pg8::StaticOrder SO; SO.init(T, INP, G, bx);
        EpiProj E{(const float*)(ws + WS_RS1), (const float*)(ws + WS_COS), (const float*)(ws + WS_SIN), ws};
        pg8::gemm_phase<EpiProj, true>(L, g, SO, E);
    }
    xcd_barrier(xbar);
    {
        { pg8::Gemm g{(const bf16_t*)(ws + WS_KC), (const bf16_t*)(ws + WS_W1K), 4096, 512, 1024}; pg8::StaticOrder SO; SO.init(4096, 512, G, bx);
          EpiF32 E{(float*)(ws + WS_GK), 512}; pg8::gemm_phase<EpiF32, true>(L, g, SO, E); }
        { pg8::Gemm g{(const bf16_t*)(ws + WS_VC), (const bf16_t*)(ws + WS_W1V), 4096, 512, 1024}; pg8::StaticOrder SO; SO.init(4096, 512, G, (bx + G - 32) % G);
          EpiF32 E{(float*)(ws + WS_GV), 512}; pg8::gemm_phase<EpiF32, true>(L, g, SO, E); }
        __syncthreads();
        const float* lf = (const float*)args.in[4];
        const float sa = wave_sum(lf[lane] * lf[64 + lane]), sb = wave_sum(lf[128 + lane] * lf[192 + lane]);
        const float lam = expf(sa) - expf(sb) + LAM_INIT;
        for (;;) {
            if (tid == 0) misc[0] = (int)atomicAdd(ctl + 64, 1u);
            __syncthreads();
            const int idx = misc[0];
            __syncthreads();
            if (idx >= 1024) break;
            const int qb = 31 - (idx >> 5), bh = idx & 31;
            diff_unit(L, bh >> 2, bh & 3, qb, ws, lam, (const float*)args.in[5]);
        }
    }
    xcd_barrier(xbar);
    {
        LAS float* hid = (LAS float*)L;
        LAS float* bias = hid + 4096;
        for (int un = bx; un < 512; un += G) {
            const int kv = un >> 8, p = (un >> 4) & 15, rb = un & 15;
            const float* Gm = (const float*)(ws + (kv ? WS_GV : WS_GK));
            const float* w2 = (const float*)args.in[kv ? 11 : 9];
            if (tid < 256) { float a = 0.f; const float* bp = (const float*)(ws + WS_BIASP) + kv * 16 * 256 + tid;
#pragma unroll
                for (int s = 0; s < 16; ++s) a += bp[s * 256]; bias[tid] = a; }
            __syncthreads();
#pragma unroll
            for (int i = 0; i < 8; ++i) { const int e = tid + 512 * i, r = e >> 8, k = e & 255, c = 16 * rb + r; const size_t R = (size_t)p * 256 + c;
                float v = Gm[R * 512 + k] + bias[k]; if (c < 255) v += Gm[(R + 1) * 512 + 256 + k];
                hid[r * 256 + k] = v / (1.f + __expf(-v)); }
            __syncthreads();
            const int d = tid & 63, r0 = tid >> 6; float a0 = 0.f, a1 = 0.f;
#pragma unroll 8
            for (int k = 0; k < 256; ++k) { const float w = w2[k * 64 + d]; a0 += hid[r0 * 256 + k] * w; a1 += hid[(r0 + 8) * 256 + k] * w; }
            bf16_t* O = (bf16_t*)(ws + (kv ? WS_VCMP : WS_KCMP)) + ((size_t)p * 256 + 16 * rb) * 64;
            O[r0 * 64 + d] = (bf16_t)(cvtpk(a0, 0.f) & 0xffffu); O[(r0 + 8) * 64 + d] = (bf16_t)(cvtpk(a1, 0.f) & 0xffffu);
            __syncthreads();
        }
    }
    xcd_barrier(xbar);
    {
        for (;;) {
            if (tid == 0) misc[0] = (int)atomicAdd(ctl + 128, 1u);
            __syncthreads();
            const int idx = misc[0];
            __syncthreads();
            if (idx >= 1024) break;
            const int qblk = 63 - (idx >> 4), pgx = idx & 15;
            nsa_unit(L, pgx >> 1, pgx & 1, qblk, ws);
        }
    }
    xcd_barrier(xbar);
    {
        { pg8::Gemm g{(const bf16_t*)(ws + WS_YA), (const bf16_t*)(ws + WS_WA), T, D, 512}; pg8::StaticOrder SO; SO.init(T, D, G, bx);
          EpiBranch<false> E{(bf16_t*)(ws + WS_XB), (const bf16_t*)(ws + WS_MG)}; pg8::gemm_phase<EpiBranch<false>, true>(L, g, SO, E); }
        __syncthreads();
        { pg8::Gemm g{(const bf16_t*)(ws + WS_YB), (const bf16_t*)(ws + WS_WB), T, D, 512}; pg8::StaticOrder SO; SO.init(T, D, G, bx);
          EpiBranch<true> E{(bf16_t*)(ws + WS_XB), (const bf16_t*)(ws + WS_MG)}; pg8::gemm_phase<EpiBranch<true>, true>(L, g, SO, E); }
    }
    xcd_barrier(xbar);
    {
        pg8::Gemm g{(const bf16_t*)(ws + WS_XB), (const bf16_t*)(ws + WS_WO), T, D, D}; pg8::StaticOrder SO; SO.init(T, D, G, bx);
        EpiResid<true> E{x, out, (bf16_t*)(ws + WS_YA), (float*)(ws + WS_SSQ2)};
        pg8::gemm_phase<EpiResid<true>, true>(L, g, SO, E);
    }
    xcd_barrier(xbar);
    {
        pg8::Gemm g{(const bf16_t*)(ws + WS_YA), (const bf16_t*)(ws + WS_WGU), T, FF2, D}; pg8::StaticOrder SO; SO.init(T, FF2, G, bx);
        EpiGU E{(const float*)(ws + WS_SSQ2), (bf16_t*)(ws + WS_ACT)};
        pg8::gemm_phase<EpiGU, true>(L, g, SO, E);
    }
    xcd_barrier(xbar);
    {
        pg8::Gemm g{(const bf16_t*)(ws + WS_ACT), (const bf16_t*)(ws + WS_WD), T, D, FF}; pg8::StaticOrder SO; SO.init(T, D, G, bx);
        EpiResid<false> E{out, out, nullptr, (float*)(ws + WS_SSQ3)};
        pg8::gemm_phase<EpiResid<false>, true>(L, g, SO, E);
    }
    xcd_barrier(xbar);
    {
        const float* gf = (const float*)args.in[19]; const float* SSQ3 = (const float*)(ws + WS_SSQ3);
        const int gw = bx * 8 + wave, NGW = G * 8;
        f32x4 gv[4];
#pragma unroll
        for (int jx = 0; jx < 4; ++jx) gv[jx] = ((const f32x4*)gf)[lane + 64 * jx];
        for (int m = gw; m < T; m += NGW) {
            float s = (lane < 16) ? SSQ3[(size_t)m * 16 + lane] : 0.f;
            s = wave_sum(s);
            const float rs = rsqrtf(s * (1.f / D) + EPS);
            f32x4* xr = (f32x4*)(out + (size_t)m * D) + lane;
#pragma unroll
            for (int jx = 0; jx < 4; ++jx) { f32x4 v = xr[64 * jx]; v = v * rs * gv[jx]; xr[64 * jx] = v; }
        }
    }
}

extern "C" void kernel_launch(void* const* d_in, const int* in_sizes, int n_in, void* d_out, int out_size, void* d_ws, size_t ws_size, hipStream_t stream) {
    static int grid = 0;
    if (grid == 0) {
        if (n_in != 20 || out_size != T * D || ws_size < WS_END) { fprintf(stderr, "kernel_launch: unexpected shapes (n_in %d out %d ws %zu)\n", n_in, out_size, ws_size); grid = -1; return; }
        int dev = 0, cus = 0, per_cu = 0;
        hipGetDevice(&dev);
        hipDeviceGetAttribute(&cus, hipDeviceAttributeMultiprocessorCount, dev);
        hipFuncSetAttribute((const void*)hybrid_fwd, hipFuncAttributeMaxDynamicSharedMemorySize, LDS_BYTES);
        hipOccupancyMaxActiveBlocksPerMultiprocessor(&per_cu, (const void*)hybrid_fwd, 512, LDS_BYTES);
        if (per_cu < 1) { fprintf(stderr, "kernel_launch: occupancy query says %d blocks per CU\n", per_cu); per_cu = 1; }
        (void)hipGetLastError();
        grid = cus * per_cu;
    }
    if (grid < 0) return;
    hipMemsetAsync((char*)d_ws + WS_CTL, 0, 32768, stream);
    Args a{};
    for (int i = 0; i < 20; ++i) a.in[i] = d_in[i];
    a.out = (float*)d_out; a.ws = (unsigned char*)d_ws;
    void* params[] = {&a};
    hipError_t e = hipLaunchCooperativeKernel((const void*)hybrid_fwd, dim3(grid), dim3(512), params, LDS_BYTES, stream);
    if (e != hipSuccess) fprintf(stderr, "cooperative launch failed: %s (grid %d)\n", hipGetErrorString(e), grid);
}
```

```cpp
#include <hip/hip_runtime.h>
#include <hip/hip_cooperative_groups.h>
#include <cstdint>
#include <cstdio>
#include <type_traits>
namespace cg = cooperative_groups;

#define LAS __attribute__((address_space(3)))
typedef unsigned short bf16_t;
typedef short bf16x8 __attribute__((ext_vector_type(8)));
typedef short s16x4 __attribute__((ext_vector_type(4)));
typedef float f32x4 __attribute__((ext_vector_type(4)));
typedef float f32x2 __attribute__((ext_vector_type(2)));
typedef float f32x16 __attribute__((ext_vector_type(16)));
typedef unsigned u32x4 __attribute__((ext_vector_type(4)));
typedef unsigned u32x2 __attribute__((ext_vector_type(2)));
typedef __bf16 bf16x2_t __attribute__((ext_vector_type(2)));

constexpr int NB = 8, S = 4096, T = NB * S, D = 1024, FF = 2816, FF2 = 2 * FF, INP = 5120;
constexpr float EPS = 1e-6f;
constexpr float C2 = 0.125f * 1.4426950408889634f;
constexpr float LAM_INIT = 0.2f;

constexpr size_t MiB = 1u << 20;
constexpr size_t WS_CTL = 0;
constexpr size_t WS_WIN = 1 * MiB, WS_WGU = 11 * MiB, WS_WD = 22 * MiB, WS_WO = 28 * MiB, WS_WA = 30 * MiB, WS_WB = 31 * MiB, WS_W1K = 32 * MiB, WS_W1V = 33 * MiB;
constexpr size_t WS_COS = 34 * MiB, WS_SIN = 38 * MiB;
constexpr size_t WS_RS1 = 42 * MiB, WS_SSQ2 = 43 * MiB, WS_SSQ3 = 45 * MiB, WS_NG = 47 * MiB, WS_BIASP = 50 * MiB;
constexpr size_t WS_GK = 52 * MiB, WS_GV = 60 * MiB, WS_KCMP = 68 * MiB, WS_VCMP = 69 * MiB;
constexpr size_t WS_XB = 70 * MiB;
constexpr size_t WS_DQ = 134 * MiB, WS_DK = 166 * MiB, WS_DV = 198 * MiB, WS_NQ = 230 * MiB;
constexpr size_t WS_KC = 262 * MiB, WS_VC = 270 * MiB, WS_KS = 278 * MiB, WS_VS = 286 * MiB, WS_KW = 294 * MiB, WS_VW = 302 * MiB;
constexpr size_t WS_ACT = 134 * MiB;
constexpr size_t WS_MG = 310 * MiB;
constexpr size_t WS_YA = 438 * MiB, WS_YB = 470 * MiB;
constexpr size_t WS_END = 502 * MiB;
constexpr int LDS_BYTES = 155648;

__device__ __forceinline__ unsigned cvtpk(float lo, float hi) { f32x2 v = {lo, hi}; bf16x2_t b = __builtin_convertvector(v, bf16x2_t); return __builtin_bit_cast(unsigned, b); }
__device__ __forceinline__ float bf2f(unsigned short h) { return __uint_as_float(((unsigned)h) << 16); }
__device__ __forceinline__ float bflo(unsigned w) { return __uint_as_float(w << 16); }
__device__ __forceinline__ float bfhi(unsigned w) { return __uint_as_float(w & 0xffff0000u); }
__device__ __forceinline__ float sigmoidf_(float x) { return 1.f / (1.f + __expf(-x)); }
__device__ __forceinline__ int lane_id() { unsigned z = 0u; asm volatile("" : "+v"(z)); return (int)__builtin_amdgcn_mbcnt_hi(~0u, __builtin_amdgcn_mbcnt_lo(~0u, z)); }
__device__ __forceinline__ float xor32_sum(float v) { auto rr = __builtin_amdgcn_permlane32_swap(__float_as_uint(v), __float_as_uint(v), false, false); return __uint_as_float(rr[0]) + __uint_as_float(rr[1]); }
__device__ __forceinline__ float xor32_max(float v) { auto rr = __builtin_amdgcn_permlane32_swap(__float_as_uint(v), __float_as_uint(v), false, false); return __builtin_fmaxf(__uint_as_float(rr[0]), __uint_as_float(rr[1])); }
__device__ __forceinline__ float wave_sum(float v) {
#pragma unroll
    for (int o = 1; o < 64; o <<= 1) v += __shfl_xor(v, o);
    return v;
}

namespace pg8 {
constexpr int BM = 256, BK = 64, HALF = 128, HTB = HALF * BK * 2, STAGE_BYTES = 8 * HTB, NXCD = 8, WGM = 8;
__host__ __device__ __forceinline__ int lds_byte(int r, int c) { const int st = (r >> 4) * 2 + (c >> 5), rr = r & 15, cc = c & 31, ob = rr * 64 + cc * 2; return st * 1024 + (ob ^ (((ob >> 9) & 1) << 5)); }
__host__ __device__ __forceinline__ void stage_rc(int b, int& R, int& C) { const int st = b / 1024, sb = b % 1024, swz = sb ^ (((sb >> 9) & 1) << 5); R = (st >> 1) * 16 + swz / 64; C = (st & 1) * 32 + (swz % 64) / 2; }
__host__ __device__ __forceinline__ int perm32(int rho) { const int n = rho >> 4, i = rho & 15; return 8 * (i >> 2) + 4 * n + (i & 3); }
struct Unit { int pm, pn; };
struct Gemm { const bf16_t* A; const bf16_t* Bt; int M, N, K; };
struct StaticOrder {
    int nM, nN, nwg, G, c;
    __host__ __device__ void init(int M, int N, int G_, int c_) { nM = M / BM; nN = N / BM; nwg = nM * nN; G = G_; c = c_; }
    __host__ __device__ bool next(int i, Unit& u) const {
        const long L = (long)i * G + c; if (L >= nwg) return false;
        int wgid = (int)L; { const int q = nwg / NXCD, r = nwg % NXCD, xcd = wgid % NXCD, off = wgid / NXCD; wgid = (xcd < r ? xcd * (q + 1) : r * (q + 1) + (xcd - r) * q) + off; }
        const int nig = WGM * nN, gid = wgid / nig, fm = gid * WGM, gsz = (nM - fm) < WGM ? (nM - fm) : WGM;
        u.pm = fm + ((wgid % nig) % gsz); u.pn = (wgid % nig) / gsz; return true;
    }
};
template <class Epi, bool ALIGN_EPI>
__device__ __forceinline__ void gemm_phase(LAS unsigned char* lds, const Gemm g, const StaticOrder& S, const Epi& E, int wv) {
    int tid_ = wv * 64 + lane_id(); asm volatile("" : "+v"(tid_));
    const int tid = tid_, wid = __builtin_amdgcn_readfirstlane(tid >> 6), lane = tid & 63, wr = wid >> 2, wc = wid & 3, fr = lane & 15, fq = lane >> 4;
    const int K = g.K, nt = K / BK;
    unsigned voffA[2], voffB[2];
#pragma unroll
    for (int i = 0; i < 2; ++i) { int R, C; stage_rc(tid * 16 + i * 8192, R, C); const int Rb = (R & ~31) + perm32(R & 31);
        voffA[i] = (unsigned)(R * K + C) * 2u; voffB[i] = (unsigned)(Rb * K + C) * 2u; }
    const size_t kstep = (size_t)(BK * 2);
    const size_t hstep = (size_t)HALF * K * 2;
    const size_t tstep = 2 * hstep;
    const unsigned ldsw = (unsigned)wid * 1024u;
    const int aoff = lds_byte(wr * 64 + fr, fq * 8), boff = lds_byte(wc * 32 + fr, fq * 8);
#define PG8_SA(b, h) (((b) * 2 + (h)) * HTB)
#define PG8_SB(b, h) ((4 + (b) * 2 + (h)) * HTB)
#define PG8_STAGE(bufoff, gbase, voff) do { _Pragma("unroll") for (int _i = 0; _i < 2; ++_i) \
        __builtin_amdgcn_global_load_lds((const unsigned*)((const char*)(gbase) + (voff)[_i]), (LAS unsigned*)(lds + (bufoff) + ldsw + _i * 8192), 16, 0, 0); } while (0)
#define PG8_LDA(dst, b, h) do { _Pragma("unroll") for (int m = 0; m < 4; ++m) _Pragma("unroll") for (int k = 0; k < 2; ++k) dst[m][k] = *(const LAS bf16x8*)(lds + PG8_SA(b, h) + aoff + m * 2048 + k * 1024); } while (0)
#define PG8_LDB(dst, b, h) do { _Pragma("unroll") for (int n = 0; n < 2; ++n) _Pragma("unroll") for (int k = 0; k < 2; ++k) dst[n][k] = *(const LAS bf16x8*)(lds + PG8_SB(b, h) + boff + n * 2048 + k * 1024); } while (0)
#define PG8_MMA(ai, bj, At, Bt) do { __builtin_amdgcn_s_setprio(1); _Pragma("unroll") for (int m = 0; m < 4; ++m) _Pragma("unroll") for (int n = 0; n < 2; ++n) _Pragma("unroll") for (int k = 0; k < 2; ++k) \
        acc[ai][bj][m][n] = __builtin_amdgcn_mfma_f32_16x16x32_bf16(Bt[n][k], At[m][k], acc[ai][bj][m][n], 0, 0, 0); __builtin_amdgcn_s_setprio(0); } while (0)
#define PG8_WAIT_V(n) asm volatile("s_waitcnt vmcnt(" #n ")" ::: "memory")
#define PG8_WAIT_L(n) asm volatile("s_waitcnt lgkmcnt(" #n ")" ::: "memory")
#define PG8_BAR __builtin_amdgcn_s_barrier()
#define PG8_SCHED __builtin_amdgcn_sched_barrier(0)
    Unit cur, nxt; int ui = 0;
    if (!S.next(0, cur)) return;
    f32x4 acc[2][2][4][2];
#pragma unroll
    for (int a = 0; a < 2; ++a)
#pragma unroll
        for (int b = 0; b < 2; ++b)
#pragma unroll
            for (int m = 0; m < 4; ++m)
#pragma unroll
                for (int n = 0; n < 2; ++n) acc[a][b][m][n] = (f32x4){0.f, 0.f, 0.f, 0.f};
    bf16x8 At[4][2], B0[2][2], B1[2][2];
    const char* cA = (const char*)g.A + (size_t)cur.pm * tstep; const char* cB = (const char*)g.Bt + (size_t)cur.pn * tstep;
    PG8_STAGE(PG8_SB(0, 0), cB, voffB); PG8_STAGE(PG8_SB(0, 1), cB + hstep, voffB); PG8_STAGE(PG8_SA(0, 0), cA, voffA); PG8_STAGE(PG8_SA(0, 1), cA + hstep, voffA);
    if (wr == 1) PG8_BAR;
    PG8_WAIT_V(2); PG8_BAR;
    PG8_STAGE(PG8_SB(1, 0), cB + kstep, voffB); PG8_STAGE(PG8_SA(1, 0), cA + kstep, voffA); PG8_STAGE(PG8_SB(1, 1), cB + hstep + kstep, voffB);
    PG8_WAIT_V(6); PG8_BAR;
    for (;;) {
        const bool has_next = S.next(ui + 1, nxt);
        const char* nA = has_next ? (const char*)g.A + (size_t)nxt.pm * tstep : cA; const char* nB = has_next ? (const char*)g.Bt + (size_t)nxt.pn * tstep : cB;
        for (int t = 0; t < nt; t += 2) {
            const bool last = (t == nt - 2);
            const char* a1 = cA + (size_t)(t + 1) * kstep;
            const char* a2 = last ? nA : cA + (size_t)(t + 2) * kstep; const char* b2 = last ? nB : cB + (size_t)(t + 2) * kstep;
            const char* a3 = a2 + kstep; const char* b3 = b2 + kstep;
            PG8_LDB(B0, 0, 0); PG8_LDB(B1, 0, 1); PG8_SCHED; PG8_LDA(At, 0, 0); PG8_STAGE(PG8_SA(1, 1), a1 + hstep, voffA);
            PG8_WAIT_V(8); PG8_WAIT_L(0); PG8_BAR; PG8_MMA(0, 0, At, B0); PG8_MMA(0, 1, At, B1); PG8_BAR; PG8_SCHED;
            PG8_LDA(At, 0, 1); PG8_STAGE(PG8_SB(0, 0), b2, voffB); PG8_STAGE(PG8_SB(0, 1), b2 + hstep, voffB); PG8_STAGE(PG8_SA(0, 0), a2, voffA);
            PG8_WAIT_V(8); PG8_WAIT_L(0); PG8_BAR; PG8_MMA(1, 0, At, B0); PG8_MMA(1, 1, At, B1); PG8_BAR; PG8_SCHED;
            PG8_LDB(B0, 1, 0); PG8_LDB(B1, 1, 1); PG8_SCHED; PG8_LDA(At, 1, 0); PG8_STAGE(PG8_SA(0, 1), a2 + hstep, voffA);
            PG8_WAIT_V(8); PG8_WAIT_L(0); PG8_BAR; PG8_MMA(0, 0, At, B0); PG8_MMA(0, 1, At, B1); PG8_BAR; PG8_SCHED;
            PG8_LDA(At, 1, 1); PG8_STAGE(PG8_SB(1, 0), b3, voffB); PG8_STAGE(PG8_SB(1, 1), b3 + hstep, voffB); PG8_STAGE(PG8_SA(1, 0), a3, voffA);
            PG8_WAIT_V(8); PG8_WAIT_L(0); PG8_BAR; PG8_MMA(1, 0, At, B0); PG8_MMA(1, 1, At, B1); PG8_BAR; PG8_SCHED;
        }
        if constexpr (ALIGN_EPI) { if (wr == 0) PG8_BAR; }
        E(acc, cur, wr, wc, fr, fq);
        if (!has_next) break;
#pragma unroll
        for (int a = 0; a < 2; ++a)
#pragma unroll
            for (int b = 0; b < 2; ++b)
#pragma unroll
                for (int m = 0; m < 4; ++m)
#pragma unroll
                    for (int n = 0; n < 2; ++n) acc[a][b][m][n] = (f32x4){0.f, 0.f, 0.f, 0.f};
        cur = nxt; cA = nA; cB = nB; ++ui;
        if constexpr (ALIGN_EPI) { if (wr == 1) PG8_BAR; }
    }
    PG8_WAIT_V(0);
    if constexpr (!ALIGN_EPI) { if (wr == 0) PG8_BAR; }
    PG8_BAR;
#undef PG8_SA
#undef PG8_SB
#undef PG8_STAGE
#undef PG8_LDA
#undef PG8_LDB
#undef PG8_MMA
#undef PG8_WAIT_V
#undef PG8_WAIT_L
#undef PG8_BAR
#undef PG8_SCHED
}
}

typedef f32x4 AccT[2][2][4][2];

struct EpiProj {
    const float* rs1; const float* cosT; const float* sinT;
    unsigned char* ws;
    __device__ __forceinline__ void operator()(const AccT& acc, const pg8::Unit& u, int wr, int wc, int fr, int fq) const {
        const int row0 = u.pm * 256 + wr * 64 + fr;
#pragma unroll
        for (int bj = 0; bj < 2; ++bj) {
            const int sec = u.pn * 2 + bj;
            if (sec >= 39) continue;
            if (sec == 38) {
                if (wc == 0 && fq < 3) {
                    float* NG = (float*)(ws + WS_NG);
#pragma unroll
                    for (int ai = 0; ai < 2; ++ai)
#pragma unroll
                        for (int m = 0; m < 4; ++m) { const int r = row0 + ai * 128 + m * 16; const float rs = rs1[r];
                            f32x4 v0 = acc[ai][bj][m][0] * rs, v1 = acc[ai][bj][m][1] * rs;
                            f32x4 o0, o1;
#pragma unroll
                            for (int i = 0; i < 4; ++i) { o0[i] = sigmoidf_(v0[i]); o1[i] = sigmoidf_(v1[i]); }
                            *(f32x4*)(NG + (size_t)r * 24 + fq * 8) = o0; *(f32x4*)(NG + (size_t)r * 24 + fq * 8 + 4) = o1; }
                }
                continue;
            }
            if (sec >= 22) {
                bf16_t* MG = (bf16_t*)(ws + WS_MG);
                const int col = (sec - 22) * 128 + wc * 32 + fq * 8;
#pragma unroll
                for (int ai = 0; ai < 2; ++ai)
#pragma unroll
                    for (int m = 0; m < 4; ++m) { const int r = row0 + ai * 128 + m * 16; const float rs = rs1[r];
                        f32x4 v0 = acc[ai][bj][m][0] * rs, v1 = acc[ai][bj][m][1] * rs;
                        u32x4 w; w.x = cvtpk(sigmoidf_(v0[0]), sigmoidf_(v0[1])); w.y = cvtpk(sigmoidf_(v0[2]), sigmoidf_(v0[3]));
                        w.z = cvtpk(sigmoidf_(v1[0]), sigmoidf_(v1[1])); w.w = cvtpk(sigmoidf_(v1[2]), sigmoidf_(v1[3]));
                        *(u32x4*)(MG + (size_t)r * 2048 + col) = w; }
                continue;
            }
            bf16_t* base; int H, head, HD, coff; bool rope; float scale = 1.f;
            if (sec < 4)       { base = (bf16_t*)(ws + WS_DQ); H = 4; head = sec;      HD = 128; coff = (wc >> 1) * 64; rope = true; scale = C2; }
            else if (sec < 8)  { base = (bf16_t*)(ws + WS_DK); H = 8; head = (sec - 4) * 2 + (wc >> 1); HD = 64; coff = 0; rope = true; }
            else if (sec < 12) { base = (bf16_t*)(ws + WS_DV); H = 4; head = sec - 8;  HD = 128; coff = (wc >> 1) * 64; rope = false; }
            else if (sec < 16) { base = (bf16_t*)(ws + WS_NQ); H = 8; head = (sec - 12) * 2 + (wc >> 1); HD = 64; coff = 0; rope = true; scale = C2; }
            else { const int k6 = sec - 16; base = (bf16_t*)(ws + WS_KC + (size_t)k6 * 8 * MiB); H = 2; head = wc >> 1; HD = 64; coff = 0; rope = (k6 & 1) == 0; }
            const int j = 4 * (wc & 1) + fq;
#pragma unroll
            for (int ai = 0; ai < 2; ++ai)
#pragma unroll
                for (int m = 0; m < 4; ++m) { const int r = row0 + ai * 128 + m * 16; const float rs = rs1[r] * scale;
                    const int b = r >> 12, s = r & 4095;
                    bf16_t* p = base + ((size_t)(b * H + head) * S + s) * HD + coff;
                    f32x4 v0 = acc[ai][bj][m][0] * rs, v1 = acc[ai][bj][m][1] * rs;
                    if (rope) {
                        const f32x4 c = *(const f32x4*)(cosT + (size_t)r * 32 + 4 * j), sn = *(const f32x4*)(sinT + (size_t)r * 32 + 4 * j);
                        const f32x4 o1 = v0 * c - v1 * sn, o2 = v1 * c + v0 * sn;
                        u32x2 w1, w2; w1.x = cvtpk(o1[0], o1[1]); w1.y = cvtpk(o1[2], o1[3]); w2.x = cvtpk(o2[0], o2[1]); w2.y = cvtpk(o2[2], o2[3]);
                        *(u32x2*)(p + 4 * j) = w1; *(u32x2*)(p + 32 + 4 * j) = w2;
                    } else {
                        u32x4 w; w.x = cvtpk(v0[0], v0[1]); w.y = cvtpk(v0[2], v0[3]); w.z = cvtpk(v1[0], v1[1]); w.w = cvtpk(v1[2], v1[3]);
                        *(u32x4*)(p + 8 * j) = w;
                    }
                }
        }
    }
};
struct EpiF32 {
    float* O; int ldc;
    __device__ __forceinline__ void operator()(const AccT& acc, const pg8::Unit& u, int wr, int wc, int fr, int fq) const {
        const int row0 = u.pm * 256 + wr * 64 + fr, col0 = u.pn * 256 + wc * 32 + fq * 8;
#pragma unroll
        for (int ai = 0; ai < 2; ++ai)
#pragma unroll
            for (int m = 0; m < 4; ++m)
#pragma unroll
                for (int bj = 0; bj < 2; ++bj) { float* p = O + (size_t)(row0 + ai * 128 + m * 16) * ldc + col0 + bj * 128;
                    *(f32x4*)p = acc[ai][bj][m][0]; *(f32x4*)(p + 4) = acc[ai][bj][m][1]; }
    }
};
template <bool SECOND> struct EpiBranch {
    bf16_t* MERGED; const bf16_t* MG;
    __device__ __forceinline__ void operator()(const AccT& acc, const pg8::Unit& u, int wr, int wc, int fr, int fq) const {
        const int row0 = u.pm * 256 + wr * 64 + fr, col0 = u.pn * 256 + wc * 32 + fq * 8;
#pragma unroll
        for (int ai = 0; ai < 2; ++ai)
#pragma unroll
            for (int m = 0; m < 4; ++m)
#pragma unroll
                for (int bj = 0; bj < 2; ++bj) { const int r = row0 + ai * 128 + m * 16, c = col0 + bj * 128;
                    const u32x4 g = *(const u32x4*)(MG + (size_t)r * 2048 + (SECOND ? 1024 : 0) + c);
                    const f32x4 a0 = acc[ai][bj][m][0], a1 = acc[ai][bj][m][1];
                    float o[8] = {bflo(g.x) * a0[0], bfhi(g.x) * a0[1], bflo(g.y) * a0[2], bfhi(g.y) * a0[3], bflo(g.z) * a1[0], bfhi(g.z) * a1[1], bflo(g.w) * a1[2], bfhi(g.w) * a1[3]};
                    bf16_t* p = MERGED + (size_t)r * 1024 + c;
                    if (SECOND) { const u32x4 pv = *(const u32x4*)p;
                        o[0] += bflo(pv.x); o[1] += bfhi(pv.x); o[2] += bflo(pv.y); o[3] += bfhi(pv.y); o[4] += bflo(pv.z); o[5] += bfhi(pv.z); o[6] += bflo(pv.w); o[7] += bfhi(pv.w); }
                    u32x4 w; w.x = cvtpk(o[0], o[1]); w.y = cvtpk(o[2], o[3]); w.z = cvtpk(o[4], o[5]); w.w = cvtpk(o[6], o[7]);
                    *(u32x4*)p = w; }
    }
};
template <bool WRITE_BF> struct EpiResid {
    const float* base; float* out; bf16_t* HB; float* SSQ;
    __device__ __forceinline__ void operator()(const AccT& acc, const pg8::Unit& u, int wr, int wc, int fr, int fq) const {
        const int row0 = u.pm * 256 + wr * 64 + fr, col0 = u.pn * 256 + wc * 32 + fq * 8;
#pragma unroll
        for (int ai = 0; ai < 2; ++ai)
#pragma unroll
            for (int m = 0; m < 4; ++m) { const int r = row0 + ai * 128 + m * 16; float ss = 0.f;
#pragma unroll
                for (int bj = 0; bj < 2; ++bj) { const size_t off = (size_t)r * 1024 + col0 + bj * 128;
                    const f32x4 h0 = *(const f32x4*)(base + off) + acc[ai][bj][m][0], h1 = *(const f32x4*)(base + off + 4) + acc[ai][bj][m][1];
                    *(f32x4*)(out + off) = h0; *(f32x4*)(out + off + 4) = h1;
                    ss += (h0[0] * h0[0] + h0[1] * h0[1]) + (h0[2] * h0[2] + h0[3] * h0[3]) + (h1[0] * h1[0] + h1[1] * h1[1]) + (h1[2] * h1[2] + h1[3] * h1[3]);
                    if (WRITE_BF) { u32x4 w; w.x = cvtpk(h0[0], h0[1]); w.y = cvtpk(h0[2], h0[3]); w.z = cvtpk(h1[0], h1[1]); w.w = cvtpk(h1[2], h1[3]); *(u32x4*)(HB + off) = w; } }
                ss += __shfl_xor(ss, 16); ss += __shfl_xor(ss, 32);
                if (fq == 0) SSQ[(size_t)r * 16 + u.pn * 4 + wc] = ss; }
    }
};
struct EpiGU {
    const float* SSQ2; bf16_t* ACT;
    __device__ __forceinline__ void operator()(const AccT& acc, const pg8::Unit& u, int wr, int wc, int fr, int fq) const {
        const int row0 = u.pm * 256 + wr * 64 + fr, col0 = u.pn * 128 + wc * 16 + fq * 4;
#pragma unroll
        for (int ai = 0; ai < 2; ++ai)
#pragma unroll
            for (int m = 0; m < 4; ++m) { const int r = row0 + ai * 128 + m * 16;
                const f32x4* sp = (const f32x4*)(SSQ2 + (size_t)r * 16); const f32x4 s0 = sp[0], s1 = sp[1], s2 = sp[2], s3 = sp[3];
                const float tot = ((s0[0] + s0[1]) + (s0[2] + s0[3])) + ((s1[0] + s1[1]) + (s1[2] + s1[3])) + ((s2[0] + s2[1]) + (s2[2] + s2[3])) + ((s3[0] + s3[1]) + (s3[2] + s3[3]));
                const float rs = rsqrtf(tot * (1.f / 1024.f) + EPS);
#pragma unroll
                for (int bj = 0; bj < 2; ++bj) { const f32x4 gv = acc[ai][bj][m][0] * rs, uv = acc[ai][bj][m][1] * rs; float o[4];
#pragma unroll
                    for (int i = 0; i < 4; ++i) o[i] = gv[i] * sigmoidf_(gv[i]) * uv[i];
                    u32x2 w; w.x = cvtpk(o[0], o[1]); w.y = cvtpk(o[2], o[3]);
                    *(u32x2*)(ACT + (size_t)r * FF + col0 + bj * 64) = w; } }
    }
};

typedef std::integral_constant<bool, true> TrueC; typedef std::integral_constant<bool, false> FalseC;
__device__ __forceinline__ int crow(int r, int hi) { return (r & 3) + 8 * (r >> 2) + 4 * hi; }
__device__ __forceinline__ constexpr int ccol(int r) { return (r & 3) + 8 * (r >> 2); }
__device__ __forceinline__ void glds16(const void* g, LAS unsigned char* l) {
    unsigned keep; const unsigned dst = (unsigned)__builtin_amdgcn_readfirstlane((int)(unsigned)(uintptr_t)l);
    asm volatile("s_mov_b32 %0, m0\n\ts_mov_b32 m0, %2\n\ts_nop 0\n\tglobal_load_lds_dwordx4 %1, off\n\ts_mov_b32 m0, %0" : "=&s"(keep) : "v"(g), "s"(dst) : "memory");
}
#define VM_DRAIN_SYNC() do { asm volatile("s_waitcnt vmcnt(0)" ::: "memory"); __syncthreads(); } while (0)
#define WAIT_BAR(N) asm volatile("s_waitcnt vmcnt(" #N ") lgkmcnt(0)\n\ts_barrier" ::: "memory")
__device__ __forceinline__ void wait_bar_n(int n) { if (n == 4) WAIT_BAR(4); else if (n == 2) WAIT_BAR(2); else if (n == 1) WAIT_BAR(1); else WAIT_BAR(0); }
__device__ __forceinline__ int ksrc_off(int wid, int lane) { const int ip = (lane - 8 * (wid & 1)) & 63, rho = ip >> 3, c = (ip & 7) ^ rho; return (8 * wid + rho) * 64 + c * 8; }
__device__ __forceinline__ void kread_offs(int (&koff)[4], int r32, int hi) {
    const int pc = r32 >> 3, rho = r32 & 7;
#pragma unroll
    for (int d0 = 0; d0 < 4; ++d0) koff[d0] = pc * 1024 + (((rho * 8 + ((2 * d0 + hi) ^ rho) + 8 * (pc & 1)) & 63) << 4);
}
__device__ __forceinline__ void qkt(f32x16& p0, f32x16& p1, const LAS unsigned char* Kslot, const int (&koff)[4], const bf16x8* qr) {
    bf16x8 kf[8];
#pragma unroll
    for (int d0 = 0; d0 < 4; ++d0) { kf[2 * d0] = *(const LAS bf16x8*)(Kslot + koff[d0]); kf[2 * d0 + 1] = *(const LAS bf16x8*)(Kslot + koff[d0] + 4096); }
    const f32x16 zz = f32x16{};
    p0 = __builtin_amdgcn_mfma_f32_32x32x16_bf16(kf[0], qr[0], zz, 0, 0, 0); p1 = __builtin_amdgcn_mfma_f32_32x32x16_bf16(kf[1], qr[0], zz, 0, 0, 0);
#pragma unroll
    for (int d0 = 1; d0 < 4; ++d0) { p0 = __builtin_amdgcn_mfma_f32_32x32x16_bf16(kf[2 * d0], qr[d0], p0, 0, 0, 0); p1 = __builtin_amdgcn_mfma_f32_32x32x16_bf16(kf[2 * d0 + 1], qr[d0], p1, 0, 0, 0); }
}
__device__ __forceinline__ s16x4 vtr(const LAS unsigned char* p) { return __builtin_bit_cast(s16x4, __builtin_amdgcn_ds_read_tr16_b64_v4i16((LAS s16x4*)p)); }
template <int NDB> struct Flash {
    f32x16 o[NDB]; float mhat, l; bool first;
    __device__ __forceinline__ void reset() {
#pragma unroll
        for (int d = 0; d < NDB; ++d) o[d] = f32x16{};
        mhat = 0.f; l = 0.f; first = true; }
    static __device__ __forceinline__ float rowmax_abs(const f32x16& p0, const f32x16& p1) {
        float a = __builtin_fmaxf(__builtin_fmaxf(p0[0], p0[1]), p1[0]), c = __builtin_fmaxf(__builtin_fmaxf(p0[2], p0[3]), p1[1]);
        a = __builtin_fmaxf(__builtin_fmaxf(a, p1[2]), p1[3]);
#pragma unroll
        for (int r = 4; r < 16; r += 4) { a = __builtin_fmaxf(__builtin_fmaxf(a, p0[r]), p0[r + 1]); c = __builtin_fmaxf(__builtin_fmaxf(c, p0[r + 2]), p0[r + 3]);
            a = __builtin_fmaxf(__builtin_fmaxf(a, p1[r]), p1[r + 1]); c = __builtin_fmaxf(__builtin_fmaxf(c, p1[r + 2]), p1[r + 3]); }
        return xor32_max(__builtin_fmaxf(a, c));
    }
    __device__ __forceinline__ void decide(float rmabs, bool rowvalid, LAS float* wsf, int r32, int hi) {
        const float rm = rowvalid ? rmabs - mhat : -INFINITY;
        bool need; float dl;
        if (first) { need = true; dl = (rm > -1e30f) ? rm : 0.f; }
        else { need = __any(rm > 8.0f); dl = fmaxf(rm, 0.f); }
        if (need) {
            mhat += dl;
            if (!first) {
                const float f = __builtin_amdgcn_exp2f(-dl); l *= f;
                if (hi == 0) wsf[r32] = f;
                asm volatile("s_waitcnt lgkmcnt(0)" ::: "memory");
                const f32x4 t0 = *(const LAS f32x4*)(wsf + 4 * hi), t1 = *(const LAS f32x4*)(wsf + 8 + 4 * hi), t2 = *(const LAS f32x4*)(wsf + 16 + 4 * hi), t3 = *(const LAS f32x4*)(wsf + 24 + 4 * hi);
                const f32x16 fv = {t0[0], t0[1], t0[2], t0[3], t1[0], t1[1], t1[2], t1[3], t2[0], t2[1], t2[2], t2[3], t3[0], t3[1], t3[2], t3[3]};
#pragma unroll
                for (int d = 0; d < NDB; ++d) o[d] = o[d] * fv;
                asm volatile("s_waitcnt lgkmcnt(0)" ::: "memory");
            }
        }
        first = false;
    }
    __device__ __forceinline__ void exphalf(f32x16& p, float mm, u32x4& w0, u32x4& w1) {
        p = p - mm;
        f32x2 sa = {0.f, 0.f};
#pragma unroll
        for (int r = 0; r < 16; r += 2) { p[r] = __builtin_amdgcn_exp2f(p[r]); p[r + 1] = __builtin_amdgcn_exp2f(p[r + 1]); sa += (f32x2){p[r], p[r + 1]}; }
        l += sa[0] + sa[1];
        w0 = (u32x4){cvtpk(p[0], p[1]), cvtpk(p[2], p[3]), cvtpk(p[4], p[5]), cvtpk(p[6], p[7])};
        w1 = (u32x4){cvtpk(p[8], p[9]), cvtpk(p[10], p[11]), cvtpk(p[12], p[13]), cvtpk(p[14], p[15])};
    }
    __device__ __forceinline__ void pv_half(const u32x4& w0, const u32x4& w1, const LAS unsigned char* Vslot, int lane, int hi, int kb) {
        const LAS unsigned char* vp = Vslot + ((lane >> 4) & 1) * 32 + (lane & 3) * 8 + (4 * hi + ((lane & 15) >> 2)) * 64;
#pragma unroll
        for (int d = 0; d < NDB; ++d) {
            const s16x4 l0 = vtr(vp + (d * 4 + kb) * 1024), h0 = vtr(vp + (d * 4 + kb) * 1024 + 512), l1 = vtr(vp + (d * 4 + kb + 1) * 1024), h1 = vtr(vp + (d * 4 + kb + 1) * 1024 + 512);
            o[d] = __builtin_amdgcn_mfma_f32_32x32x16_bf16(__builtin_bit_cast(bf16x8, w0), (bf16x8){l0[0], l0[1], l0[2], l0[3], h0[0], h0[1], h0[2], h0[3]}, o[d], 0, 0, 0);
            o[d] = __builtin_amdgcn_mfma_f32_32x32x16_bf16(__builtin_bit_cast(bf16x8, w1), (bf16x8){l1[0], l1[1], l1[2], l1[3], h1[0], h1[1], h1[2], h1[3]}, o[d], 0, 0, 0);
        }
    }
    __device__ __forceinline__ void tile(f32x16& p0, f32x16& p1, const LAS unsigned char* Vslot, LAS float* wsf, int lane, int r32, int hi) {
        decide(rowmax_abs(p0, p1), true, wsf, r32, hi);
        u32x4 w0, w1, w2, w3;
        exphalf(p0, mhat, w0, w1); pv_half(w0, w1, Vslot, lane, hi, 0);
        exphalf(p1, mhat, w2, w3); pv_half(w2, w3, Vslot, lane, hi, 2);
    }
    __device__ __forceinline__ float ltot() const { return xor32_sum(l); }
};
__device__ __forceinline__ void row_bcast(float v, float (&fr_)[16], LAS float* wsf, int r32, int hi) {
    asm volatile("s_waitcnt lgkmcnt(0)" ::: "memory");
    if (hi == 0) wsf[r32] = v;
    asm volatile("s_waitcnt lgkmcnt(0)" ::: "memory");
#pragma unroll
    for (int k = 0; k < 4; ++k) { const f32x4 t = *(const LAS f32x4*)(wsf + 8 * k + 4 * hi); fr_[4 * k] = t[0]; fr_[4 * k + 1] = t[1]; fr_[4 * k + 2] = t[2]; fr_[4 * k + 3] = t[3]; }
    asm volatile("s_waitcnt lgkmcnt(0)" ::: "memory");
}

constexpr int DF_STAGE = 0;
constexpr int DF_WSF = 98304;
__device__ __forceinline__ void diff_unit(LAS unsigned char* L, int b, int h, int qb, const unsigned char* ws, float lam, const float* subg, int wv) {
    int tid_ = wv * 64 + lane_id(); asm volatile("" : "+v"(tid_));
    const int tid = tid_, lane = tid & 63, r32 = lane & 31, hi = lane >> 5, wid = __builtin_amdgcn_readfirstlane(tid >> 6);
    const int comp = wid >> 2, rgi = wid & 3;
    const size_t bh = (size_t)(b * 4 + h) * S;
    const bf16_t* Qp = (const bf16_t*)(ws + WS_DQ) + (bh + qb * 128 + rgi * 32 + r32) * 128 + comp * 64;
    bf16x8 qr[4];
#pragma unroll
    for (int d0 = 0; d0 < 4; ++d0) qr[d0] = *(const bf16x8*)(Qp + d0 * 16 + hi * 8);
    const bf16_t* Kg = (const bf16_t*)(ws + WS_DK) + bh * 128 + ksrc_off(wid, lane);
    int koff[4]; kread_offs(koff, r32, hi);
    const bf16_t* Vg = (const bf16_t*)(ws + WS_DV) + bh * 128 + (size_t)(16 * (wid & 3) + (lane >> 2)) * 128 + (wid >> 2) * 32 + (lane & 3) * 8;
    LAS float* wsf = (LAS float*)(L + DF_WSF) + wid * 32;
    const int NT = 2 * qb + 2;
    Flash<4> F; F.reset();
    auto dmaK = [&](int t, int s) { const bf16_t* src = Kg + (size_t)t * 4096; LAS unsigned char* d = L + s * 16384 + wid * 1024; glds16(src, d); glds16(src + (size_t)S * 64, d + 8192); };
    auto dmaV = [&](int t, int s) { const bf16_t* src = Vg + (size_t)t * 8192; LAS unsigned char* d = L + 49152 + s * 16384 + wid * 1024; glds16(src, d); glds16(src + 64, d + 8192); };
    dmaK(0, 0); dmaV(0, 0); dmaK(1, 1); dmaV(1, 1); if (NT > 2) dmaK(2, 2);
    WAIT_BAR(0);
    f32x16 a0, a1, b0, b1; float ra, rb;
    const int xq = 32 * rgi + r32 - 4 * hi;
    auto cmask = [&](f32x16& c0, f32x16& c1, int t) { const int x = xq - 64 * (t - (NT - 2));
#pragma unroll
        for (int r = 0; r < 16; ++r) { if (ccol(r) > x) c0[r] = -INFINITY; if (ccol(r) + 32 > x) c1[r] = -INFINITY; } };
    qkt(a0, a1, L + comp * 8192, koff, qr);
    if (NT == 2) cmask(a0, a1, 0);
    ra = Flash<4>::rowmax_abs(a0, a1);
    WAIT_BAR(0);
    int s0 = 0, s1 = 1, s2 = 2;
    auto iter = [&](int t, f32x16& c0, f32x16& c1, float& rc, f32x16& n0, f32x16& n1, float& rn, auto next) {
        int nis = 0;
        if (t + 3 < NT) { dmaK(t + 3, s0); nis += 2; }
        if (t + 2 < NT) { dmaV(t + 2, s2); nis += 2; }
        F.decide(rc, true, wsf, r32, hi);
        const LAS unsigned char* Vs = L + 49152 + s0 * 16384;
        u32x4 w0, w1, w2, w3;
        if constexpr (decltype(next)::value) qkt(n0, n1, L + s1 * 16384 + comp * 8192, koff, qr);
        F.exphalf(c0, F.mhat, w0, w1);
        F.pv_half(w0, w1, Vs, lane, hi, 0);
        F.exphalf(c1, F.mhat, w2, w3);
        F.pv_half(w2, w3, Vs, lane, hi, 2);
        if constexpr (decltype(next)::value) { rn = Flash<4>::rowmax_abs(n0, n1); if (t + 1 >= NT - 2) { cmask(n0, n1, t + 1); rn = Flash<4>::rowmax_abs(n0, n1); } }
        wait_bar_n(nis);
        const int tmp = s0; s0 = s1; s1 = s2; s2 = tmp;
    };
    int t = 0;
    for (; t < NT - 2; t += 2) { iter(t, a0, a1, ra, b0, b1, rb, TrueC{}); iter(t + 1, b0, b1, rb, a0, a1, ra, TrueC{}); }
    iter(NT - 2, a0, a1, ra, b0, b1, rb, TrueC{});
    iter(NT - 1, b0, b1, rb, a0, a1, ra, FalseC{});
    const float lt = F.ltot();
    float fr_[16];
    row_bcast((comp ? lam : 1.f) / lt, fr_, wsf, r32, hi);
    LAS float* stg = (LAS float*)(L + DF_STAGE) + rgi * 32 * 132;
    if (comp == 1) {
#pragma unroll
        for (int d = 0; d < 4; ++d)
#pragma unroll
            for (int r = 0; r < 16; ++r) stg[crow(r, hi) * 132 + d * 32 + r32] = F.o[d][r] * fr_[r];
    }
    __syncthreads();
    if (comp == 0) {
#pragma unroll
        for (int d = 0; d < 4; ++d)
#pragma unroll
            for (int r = 0; r < 16; ++r) { const int ix = crow(r, hi) * 132 + d * 32 + r32; stg[ix] = F.o[d][r] * fr_[r] - stg[ix]; }
        asm volatile("s_waitcnt lgkmcnt(0)" ::: "memory");
        const LAS float* rowp = stg + r32 * 132 + 64 * hi;
        float ss = 0.f;
#pragma unroll
        for (int k = 0; k < 16; ++k) { const f32x4 v = *(const LAS f32x4*)(rowp + 4 * k); ss += (v[0] * v[0] + v[1] * v[1]) + (v[2] * v[2] + v[3] * v[3]); }
        ss = xor32_sum(ss);
        const float rstd = rsqrtf(ss * (1.f / 128.f) + EPS) * (1.f - LAM_INIT);
        bf16_t* Yp = (bf16_t*)(ws + WS_YA) + ((size_t)b * S + qb * 128 + rgi * 32 + r32) * 512 + h * 128 + 64 * hi;
#pragma unroll
        for (int k = 0; k < 8; ++k) { const f32x4 v0 = *(const LAS f32x4*)(rowp + 8 * k), v1 = *(const LAS f32x4*)(rowp + 8 * k + 4);
            const f32x4 g0 = *(const f32x4*)(subg + 64 * hi + 8 * k), g1 = *(const f32x4*)(subg + 64 * hi + 8 * k + 4);
            u32x4 w; w.x = cvtpk(v0[0] * rstd * g0[0], v0[1] * rstd * g0[1]); w.y = cvtpk(v0[2] * rstd * g0[2], v0[3] * rstd * g0[3]);
            w.z = cvtpk(v1[0] * rstd * g1[0], v1[1] * rstd * g1[1]); w.w = cvtpk(v1[2] * rstd * g1[2], v1[3] * rstd * g1[3]);
            *(u32x4*)(Yp + 8 * k) = w; }
    }
    __syncthreads();
}

constexpr int NS_CMP = 49152;
constexpr int NS_GL = 114688;
constexpr int NS_WSF = 147456;
template <int MODE>
__device__ __forceinline__ void nsa_kv_pass(LAS unsigned char* L, Flash<2>& F, const bf16x8* qr, const int (&koff)[4], const bf16_t* Kg0, const bf16_t* Vg0, int jlo, int jhi, int qblk, int ql, unsigned long long mymask,
                                            LAS float* wsf, int wid, int lane, int r32, int hi) {
    auto dmaK = [&](int j, int s) { glds16(Kg0 + (size_t)j * 4096, L + s * 8192 + wid * 1024); };
    auto dmaV = [&](int j, int s) { glds16(Vg0 + (size_t)j * 4096, L + 24576 + s * 8192 + wid * 1024); };
    dmaK(jlo, 0); dmaV(jlo, 0); if (jlo + 1 <= jhi) { dmaK(jlo + 1, 1); dmaV(jlo + 1, 1); } if (jlo + 2 <= jhi) dmaK(jlo + 2, 2);
    WAIT_BAR(0);
    f32x16 a0, a1, b0, b1; float ra, rb;
    const int xq = ql - 4 * hi;
    auto masked = [&](int j) { return MODE == 1 ? (j == qblk) : (j == qblk || j == qblk - 8); };
    auto amask = [&](f32x16& c0, f32x16& c1, int j) {
        if (MODE == 1) {
#pragma unroll
            for (int r = 0; r < 16; ++r) { if (ccol(r) > xq) c0[r] = -INFINITY; if (ccol(r) + 32 > xq) c1[r] = -INFINITY; }
        } else { const int base = 64 * (qblk - j) + xq;
#pragma unroll
            for (int r = 0; r < 16; ++r) { if ((unsigned)(base - ccol(r)) >= 512u) c0[r] = -INFINITY; if ((unsigned)(base - ccol(r) - 32) >= 512u) c1[r] = -INFINITY; } } };
    qkt(a0, a1, L, koff, qr);
    if (masked(jlo)) amask(a0, a1, jlo);
    ra = Flash<2>::rowmax_abs(a0, a1);
    WAIT_BAR(0);
    int s0 = 0, s1 = 1, s2 = 2;
    auto iter = [&](int j, f32x16& c0, f32x16& c1, float& rc, f32x16& n0, f32x16& n1, float& rn, auto next) {
        int nis = 0;
        if (j + 3 <= jhi) { dmaK(j + 3, s0); nis += 1; }
        if (j + 2 <= jhi) { dmaV(j + 2, s2); nis += 1; }
        const bool rowvalid = (MODE == 1) ? (bool)((mymask >> j) & 1ull) : true;
        F.decide(rc, rowvalid, wsf, r32, hi);
        const float mm = rowvalid ? F.mhat : INFINITY;
        const LAS unsigned char* Vs = L + 24576 + s0 * 8192;
        u32x4 w0, w1, w2, w3;
        if constexpr (decltype(next)::value) qkt(n0, n1, L + s1 * 8192, koff, qr);
        F.exphalf(c0, mm, w0, w1);
        F.pv_half(w0, w1, Vs, lane, hi, 0);
        F.exphalf(c1, mm, w2, w3);
        F.pv_half(w2, w3, Vs, lane, hi, 2);
        if constexpr (decltype(next)::value) { rn = Flash<2>::rowmax_abs(n0, n1); if (masked(j + 1)) { amask(n0, n1, j + 1); rn = Flash<2>::rowmax_abs(n0, n1); } }
        wait_bar_n(nis);
        const int tmp = s0; s0 = s1; s1 = s2; s2 = tmp;
    };
    int j = jlo;
    for (; j + 2 <= jhi; j += 2) { iter(j, a0, a1, ra, b0, b1, rb, TrueC{}); iter(j + 1, b0, b1, rb, a0, a1, ra, TrueC{}); }
    if (j < jhi) { iter(j, a0, a1, ra, b0, b1, rb, TrueC{}); iter(jhi, b0, b1, rb, a0, a1, ra, FalseC{}); }
    else iter(jhi, a0, a1, ra, b0, b1, rb, FalseC{});
}
__device__ __forceinline__ void nsa_unit(LAS unsigned char* L, int b, int g, int qblk, const unsigned char* ws, int wv) {
    int tid_ = wv * 64 + lane_id(); asm volatile("" : "+v"(tid_));
    const int tid = tid_, lane = tid & 63, r32 = lane & 31, hi = lane >> 5, wid = __builtin_amdgcn_readfirstlane(tid >> 6);
    const int ql = 8 * wid + (r32 & 7), hh = r32 >> 3, head = g * 4 + hh;
    const int qpos = 64 * qblk + ql;
    const size_t tok = (size_t)b * S + qpos;
    const bf16_t* Qp = (const bf16_t*)(ws + WS_NQ) + ((size_t)(b * 8 + head) * S + qpos) * 64;
    bf16x8 qr[4];
#pragma unroll
    for (int d0 = 0; d0 < 4; ++d0) qr[d0] = *(const bf16x8*)(Qp + d0 * 16 + hi * 8);
    const float* NGp = (const float*)(ws + WS_NG) + tok * 24 + head;
    const float g0 = NGp[0], g1 = NGp[8], g2 = NGp[16];
    LAS float* wsf = (LAS float*)(L + NS_WSF) + wid * 32;
    const size_t pg = (size_t)(b * 2 + g);
    LAS float* yst = (LAS float*)(L + NS_CMP) + wid * 2048;
    float fr_[16];
    unsigned long long mymask = 0ull;
    int koff[4]; kread_offs(koff, r32, hi);
    {
        const int ntc = ((4 * qblk + 2) >> 6) + 1;
        const bf16_t* Kc = (const bf16_t*)(ws + WS_KCMP) + pg * 256 * 64 + ksrc_off(wid, lane);
        const bf16_t* Vc = (const bf16_t*)(ws + WS_VCMP) + (pg * 256 + 16 * (wid & 3) + (lane >> 2)) * 64 + (wid >> 2) * 32 + (lane & 3) * 8;
        for (int ct = 0; ct < ntc; ++ct) { glds16(Kc + (size_t)ct * 4096, L + NS_CMP + ct * 8192 + wid * 1024); glds16(Vc + (size_t)ct * 4096, L + NS_CMP + 32768 + ct * 8192 + wid * 1024); }
        VM_DRAIN_SYNC();
        const int cm = (qpos >= 31) ? ((qpos - 31) >> 4) : -1;
        Flash<2> F; F.reset();
        for (int ct = 0; ct < ntc; ++ct) {
            f32x16 p0, p1;
            qkt(p0, p1, L + NS_CMP + ct * 8192, koff, qr);
            const int x = cm - 64 * ct - 4 * hi;
#pragma unroll
            for (int r = 0; r < 16; ++r) { if (ccol(r) > x) p0[r] = -INFINITY; if (ccol(r) + 32 > x) p1[r] = -INFINITY; }
            F.tile(p0, p1, L + NS_CMP + 32768 + ct * 8192, wsf, lane, r32, hi);
        }
        const float lt = F.ltot();
        const float il = lt > 0.f ? 1.f / lt : 0.f;
        LAS float* Gs = (LAS float*)(L + NS_GL) + wid * 1024;
        LAS float* Ls = Gs + 512;
        for (int ct = 0; ct < ntc; ++ct) {
            f32x16 p0, p1;
            qkt(p0, p1, L + NS_CMP + ct * 8192, koff, qr);
            const int x = cm - 64 * ct - 4 * hi;
#pragma unroll
            for (int r = 0; r < 16; ++r) {
                float a = (ccol(r) > x) ? 0.f : __builtin_amdgcn_exp2f(p0[r] - F.mhat) * il, bq = (ccol(r) + 32 > x) ? 0.f : __builtin_amdgcn_exp2f(p1[r] - F.mhat) * il;
                a += __shfl_xor(a, 8); a += __shfl_xor(a, 16); bq += __shfl_xor(bq, 8); bq += __shfl_xor(bq, 16);
                p0[r] = a; p1[r] = bq; }
            if (r32 < 8) {
#pragma unroll
                for (int k = 0; k < 4; ++k) { const int jj = 16 * ct + 2 * k + hi;
                    Gs[r32 * 64 + jj] = (p0[4 * k] + p0[4 * k + 1]) + (p0[4 * k + 2] + p0[4 * k + 3]); Ls[r32 * 64 + jj] = p0[4 * k + 3];
                    Gs[r32 * 64 + jj + 8] = (p1[4 * k] + p1[4 * k + 1]) + (p1[4 * k + 2] + p1[4 * k + 3]); Ls[r32 * 64 + jj + 8] = p1[4 * k + 3]; }
            }
        }
        asm volatile("s_waitcnt lgkmcnt(0)" ::: "memory");
        const int j = lane, jmax = 16 * ntc;
        for (int qi = 0; qi < 8; ++qi) {
            float v = (j < jmax) ? Gs[qi * 64 + j] : 0.f;
            if (j >= 1 && j - 1 < jmax) v += Ls[qi * 64 + j - 1];
            if (j == 0 || j == qblk || j == qblk - 1) v = 1e9f;
            if (j > qblk) v = -1e30f;
            unsigned key = __float_as_uint(v); key = (key & 0x80000000u) ? ~key : (key | 0x80000000u);
            unsigned long long C = ~0ull; int kk = 16;
            for (int bit = 31; bit >= 0; --bit) {
                const unsigned long long bs = __ballot((key >> bit) & 1u) & C;
                const int c1 = __popcll(bs);
                if (c1 >= kk) C = bs; else { kk -= c1; C &= ~bs; }
            }
            const unsigned Tk = (unsigned)__builtin_amdgcn_readlane((int)key, (int)__builtin_ctzll(C));
            unsigned long long selm = __ballot(key > Tk);
            for (int i = 0; i < kk; ++i) { const unsigned long long low = C & (0ull - C); selm |= low; C ^= low; }
            const unsigned long long m = selm & ((qblk >= 63) ? ~0ull : ((1ull << (qblk + 1)) - 1ull));
            if ((r32 & 7) == qi) mymask = m;
        }
        asm volatile("s_waitcnt lgkmcnt(0)" ::: "memory");
        __syncthreads();
        row_bcast(g0 * il, fr_, wsf, r32, hi);
#pragma unroll
        for (int d = 0; d < 2; ++d)
#pragma unroll
            for (int r = 0; r < 16; ++r) yst[crow(r, hi) * 64 + d * 32 + r32] = F.o[d][r] * fr_[r];
    }
    const size_t ksrc = pg * S * 64 + ksrc_off(wid, lane);
    const size_t voff = (pg * S + 16 * (wid & 3) + (lane >> 2)) * 64 + (wid >> 2) * 32 + (lane & 3) * 8;
    {
        Flash<2> F; F.reset();
        nsa_kv_pass<1>(L, F, qr, koff, (const bf16_t*)(ws + WS_KS) + ksrc, (const bf16_t*)(ws + WS_VS) + voff, 0, qblk, qblk, ql, mymask, wsf, wid, lane, r32, hi);
        const float lt = F.ltot();
        row_bcast(g1 / lt, fr_, wsf, r32, hi);
#pragma unroll
        for (int d = 0; d < 2; ++d)
#pragma unroll
            for (int r = 0; r < 16; ++r) yst[crow(r, hi) * 64 + d * 32 + r32] += F.o[d][r] * fr_[r];
    }
    {
        Flash<2> F; F.reset();
        const int jlo = qblk >= 8 ? qblk - 8 : 0;
        nsa_kv_pass<2>(L, F, qr, koff, (const bf16_t*)(ws + WS_KW) + ksrc, (const bf16_t*)(ws + WS_VW) + voff, jlo, qblk, qblk, ql, 0ull, wsf, wid, lane, r32, hi);
        const float lt = F.ltot();
        row_bcast(g2 / lt, fr_, wsf, r32, hi);
        LAS bf16_t* stg = (LAS bf16_t*)(L + NS_GL) + wid * 2048;
#pragma unroll
        for (int r = 0; r < 16; ++r) { const int orow = crow(r, hi);
#pragma unroll
            for (int d = 0; d < 2; ++d) { const float yv = yst[orow * 64 + d * 32 + r32] + F.o[d][r] * fr_[r]; stg[orow * 64 + d * 32 + r32] = (bf16_t)(cvtpk(yv, 0.f) & 0xffffu); } }
        asm volatile("s_waitcnt lgkmcnt(0)" ::: "memory");
        bf16_t* Yb = (bf16_t*)(ws + WS_YB);
#pragma unroll
        for (int i = 0; i < 4; ++i) { const int row = i * 8 + (lane >> 3), ch = lane & 7; const u32x4 v = *(const LAS u32x4*)(stg + row * 64 + ch * 8);
            *(u32x4*)(Yb + ((size_t)b * S + 64 * qblk + 8 * wid + (row & 7)) * 512 + (g * 4 + (row >> 3)) * 64 + ch * 8) = v; }
    }
    __syncthreads();
}

#define XB_TMO      128
#define XB_XCNT(j)  (256  + 64 * (j))
#define XB_XSUB(j)  (1280 + 64 * (j))
#define XB_XGEN(j)  (2304 + 64 * (j))
#define XB_TOP      3328
#define XB_TOPGEN   3392
#define XCD_BAR_WORDS 3456
#define XB_SPIN_CAP (1u << 18)

__device__ __forceinline__ unsigned xb_ld(unsigned* p)              { return __hip_atomic_load(p, __ATOMIC_RELAXED, __HIP_MEMORY_SCOPE_AGENT); }
__device__ __forceinline__ unsigned xb_add(unsigned* p, unsigned v) { return __hip_atomic_fetch_add(p, v, __ATOMIC_RELAXED, __HIP_MEMORY_SCOPE_AGENT); }
__device__ __forceinline__ unsigned xb_xcc_id() { return (unsigned)__builtin_amdgcn_s_getreg((3 << 11) | 20) & 0xFu; }
#define XB_SPIN(cond, bar) do { unsigned _sp = 0; while (cond) { __builtin_amdgcn_s_sleep(1); \
    if ((++_sp & 255u) == 0u) { if (xb_ld(&(bar)[XB_TMO])) break; if (_sp > XB_SPIN_CAP) { atomicAdd(&(bar)[XB_TMO], 1u); break; } } } } while (0)

struct XcdBarrier {
    unsigned* bar; unsigned x;
    volatile LAS unsigned* st;
    bool lead;
};

__device__ __forceinline__ XcdBarrier xcd_barrier_post(unsigned* bar, volatile LAS unsigned* st, bool lead) {
    XcdBarrier b; b.bar = bar; b.x = xb_xcc_id(); b.st = st; b.lead = lead;
    if (b.lead && lane_id() == 0) (void)xb_add(&bar[XB_XCNT(b.x)], 1u);
    return b;
}
__device__ __forceinline__ void xcd_barrier_complete(unsigned* bar, unsigned x, unsigned& nloc, unsigned& nx) {
    const unsigned G = gridDim.x * gridDim.y * gridDim.z;
    unsigned sum, cnt, mine, sp = 0u;
    for (;;) {
        sum = 0u; cnt = 0u; mine = 0u;
#pragma unroll
        for (unsigned j = 0; j < 16; ++j) { const unsigned c = xb_ld(&bar[XB_XCNT(j)]); sum += c; cnt += (c > 0u) ? 1u : 0u; mine = (j == x) ? c : mine; }
        if (sum == G) break;
        __builtin_amdgcn_s_sleep(1);
        if ((++sp & 255u) == 0u) { if (xb_ld(&bar[XB_TMO])) break; if (sp > XB_SPIN_CAP) { atomicAdd(&bar[XB_TMO], 1u); break; } }
    }
    nloc = mine > 0u ? mine : 1u; nx = cnt > 0u ? cnt : 1u;
}

__device__ __forceinline__ void xcd_barrier(const XcdBarrier& b) {
    asm volatile("s_waitcnt vmcnt(0)" ::: "memory");
    __syncthreads();
    if (b.lead && lane_id() == 0) {
        unsigned* bar = b.bar;
        __builtin_amdgcn_s_waitcnt(0);
        unsigned nloc = b.st[0], nx = b.st[1];
        if (nloc == 0u) { xcd_barrier_complete(bar, b.x, nloc, nx); b.st[0] = nloc; b.st[1] = nx; }
        const unsigned old = xb_add(&bar[XB_XSUB(b.x)], 1u);
        const unsigned gen = old / nloc;
        if (old + 1u == (gen + 1u) * nloc) {
            __builtin_amdgcn_fence(__ATOMIC_RELEASE, "agent");
            asm volatile("s_waitcnt vmcnt(0)" ::: "memory");
            const unsigned og = xb_add(&bar[XB_TOP], 1u);
            const unsigned tg = og / nx;
            if (og + 1u == (tg + 1u) * nx) xb_add(&bar[XB_TOPGEN], 1u);
            else XB_SPIN(xb_ld(&bar[XB_TOPGEN]) == tg, bar);
            __builtin_amdgcn_fence(__ATOMIC_ACQUIRE, "agent");
            xb_add(&bar[XB_XGEN(b.x)], 1u);
            asm volatile("s_waitcnt vmcnt(0)" ::: "memory");
        } else {
            XB_SPIN(xb_ld(&bar[XB_XGEN(b.x)]) == gen, bar);
            __builtin_amdgcn_fence(__ATOMIC_ACQUIRE, "agent");
            asm volatile("s_waitcnt vmcnt(0)" ::: "memory");
        }
    }
    __syncthreads();
}


template <class MapF>
__device__ __forceinline__ void tr_item(const float* W, int K, int N, int ldw, bf16_t* WT, const float* kscale, LAS float* scr, int item, int lane, const MapF& map) {
    const int nblk = (N + 31) / 32, kb = item / nblk, nb = item % nblk, k0 = 64 * kb, n0 = 32 * nb;
    const int nn = n0 + (lane & 31);
#pragma unroll 8
    for (int i = 0; i < 32; ++i) { const int kk = 2 * i + (lane >> 5); float v = (nn < N) ? W[(size_t)(k0 + kk) * ldw + nn] : 0.f; if (kscale) v *= kscale[k0 + kk]; scr[kk * 33 + (lane & 31)] = v; }
    asm volatile("s_waitcnt lgkmcnt(0)" ::: "memory");
    const int c = lane & 7;
#pragma unroll
    for (int jx = 0; jx < 4; ++jx) { const int n = (lane >> 3) + 8 * jx; const LAS float* s = scr + (8 * c) * 33 + n;
        u32x4 o; o.x = cvtpk(s[0 * 33], s[1 * 33]); o.y = cvtpk(s[2 * 33], s[3 * 33]); o.z = cvtpk(s[4 * 33], s[5 * 33]); o.w = cvtpk(s[6 * 33], s[7 * 33]);
        if (n0 + n < N) *(u32x4*)(WT + (size_t)map(n0 + n) * K + k0 + 8 * c) = o; }
    asm volatile("s_waitcnt lgkmcnt(0)" ::: "memory");
}
__device__ __forceinline__ int rope_pos(int d) { return d < 32 ? 8 * (d >> 2) + (d & 3) : 8 * ((d - 32) >> 2) + 4 + (d & 3); }
struct MapIn {
    __device__ __forceinline__ int operator()(int n) const {
        if (n >= 2840) return 2816 + (n - 2840);
        if (n >= 2816) return 4864 + (n - 2816);
        bool rope;
        if (n < 1024) rope = true; else if (n < 1536) rope = false; else if (n < 2048) rope = true; else rope = (((n - 2048) >> 7) & 1) == 0;
        return rope ? (n & ~63) + rope_pos(n & 63) : n;
    }
};
struct MapId { int off; __device__ __forceinline__ int operator()(int n) const { return off + n; } };
struct MapGU { int up; __device__ __forceinline__ int operator()(int f) const { return 8 * (f >> 2) + 4 * up + (f & 3); } };

__device__ __forceinline__ int queue_fetch(unsigned* qbase, unsigned x, LAS int* kstate) {
    int k = *kstate;
    while (k < 8) { const unsigned q = (x + (unsigned)k) & 7u; const unsigned li = atomicAdd(qbase + 64 * q, 1u); if (li < 128u) { *kstate = k; return (int)(q * 128u + li); } ++k; }
    *kstate = k; return -1;
}
struct Args { const void* in[20]; float* out; unsigned char* ws; };

__global__ void __launch_bounds__(512, 2) hybrid_fwd(Args args) {
    extern __shared__ __attribute__((aligned(16))) unsigned char lds_raw[];
    LAS unsigned char* L = (LAS unsigned char*)lds_raw;
    cg::grid_group grid = cg::this_grid();
    const int wave_s = __builtin_amdgcn_readfirstlane((int)(threadIdx.x >> 6));
#define PHASE_IDS() int tid_ = wave_s * 64 + lane_id(); asm volatile("" : "+v"(tid_)); const int tid = tid_, lane = tid & 63, wave = __builtin_amdgcn_readfirstlane(tid >> 6); (void)lane; (void)wave
    const int G = gridDim.x, bx = blockIdx.x;
    unsigned char* ws = args.ws;
    const float* x = (const float*)args.in[0];
    const int* positions = (const int*)args.in[1];
    float* out = args.out;
    unsigned* ctl = (unsigned*)(ws + WS_CTL);
    LAS int* misc = (LAS int*)(L + LDS_BYTES - 64);
    { const int t0 = wave_s * 64 + lane_id(); if (t0 < 16) misc[t0] = 0; }
    __syncthreads();
    const XcdBarrier xbar = xcd_barrier_post(ctl + 4096, (volatile LAS unsigned*)(misc + 8), wave_s == 0);

    {
        PHASE_IDS();
        LAS float* scr = (LAS float*)(L + wave * 16384);
        const int gw = bx * 8 + wave, NGW = G * 8;
        const float* g1 = (const float*)args.in[2]; const float* g2 = (const float*)args.in[15];
        constexpr int I_IN = 16 * 153, I_G = 16 * 88, I_D = 44 * 32, I_O = 16 * 32, I_A = 8 * 32, I_C = 16 * 8;
        constexpr int NIT = I_IN + 2 * I_G + I_D + I_O + 2 * I_A + 4 * I_C;
        for (int it = gw; it < NIT; it += NGW) {
            int r = it;
            if (r < I_IN) { tr_item((const float*)args.in[3], 1024, 4888, 4888, (bf16_t*)(ws + WS_WIN), g1, scr, r, lane, MapIn{}); continue; } r -= I_IN;
            if (r < I_G) { tr_item((const float*)args.in[16], 1024, FF, FF, (bf16_t*)(ws + WS_WGU), g2, scr, r, lane, MapGU{0}); continue; } r -= I_G;
            if (r < I_G) { tr_item((const float*)args.in[17], 1024, FF, FF, (bf16_t*)(ws + WS_WGU), g2, scr, r, lane, MapGU{1}); continue; } r -= I_G;
            if (r < I_D) { tr_item((const float*)args.in[18], FF, 1024, 1024, (bf16_t*)(ws + WS_WD), nullptr, scr, r, lane, MapId{0}); continue; } r -= I_D;
            if (r < I_O) { tr_item((const float*)args.in[14], 1024, 1024, 1024, (bf16_t*)(ws + WS_WO), nullptr, scr, r, lane, MapId{0}); continue; } r -= I_O;
            if (r < I_A) { tr_item((const float*)args.in[12], 512, 1024, 1024, (bf16_t*)(ws + WS_WA), nullptr, scr, r, lane, MapId{0}); continue; } r -= I_A;
            if (r < I_A) { tr_item((const float*)args.in[13], 512, 1024, 1024, (bf16_t*)(ws + WS_WB), nullptr, scr, r, lane, MapId{0}); continue; } r -= I_A;
            if (r < I_C) { tr_item((const float*)args.in[8], 1024, 256, 256, (bf16_t*)(ws + WS_W1K), nullptr, scr, r, lane, MapId{0}); continue; } r -= I_C;
            if (r < I_C) { tr_item((const float*)args.in[8] + 1024 * 256, 1024, 256, 256, (bf16_t*)(ws + WS_W1K), nullptr, scr, r, lane, MapId{256}); continue; } r -= I_C;
            if (r < I_C) { tr_item((const float*)args.in[10], 1024, 256, 256, (bf16_t*)(ws + WS_W1V), nullptr, scr, r, lane, MapId{0}); continue; } r -= I_C;
            tr_item((const float*)args.in[10] + 1024 * 256, 1024, 256, 256, (bf16_t*)(ws + WS_W1V), nullptr, scr, r, lane, MapId{256});
        }
        bf16_t* XB = (bf16_t*)(ws + WS_XB); float* rs1 = (float*)(ws + WS_RS1);
        float* cosT = (float*)(ws + WS_COS); float* sinT = (float*)(ws + WS_SIN);
        const float invf = 1.0f / powf(10000.0f, (float)(2 * (lane & 31)) / 64.0f);
        for (int m = gw; m < T; m += NGW) {
            const f32x4* xr = (const f32x4*)(x + (size_t)m * D) + lane;
            f32x4 v[4]; float s = 0.f;
#pragma unroll
            for (int jx = 0; jx < 4; ++jx) { v[jx] = xr[64 * jx]; s += (v[jx][0] * v[jx][0] + v[jx][1] * v[jx][1]) + (v[jx][2] * v[jx][2] + v[jx][3] * v[jx][3]); }
            s = wave_sum(s);
            if (lane == 0) rs1[m] = rsqrtf(s * (1.f / D) + EPS);
            u32x2* o8 = (u32x2*)(XB + (size_t)m * D) + lane;
#pragma unroll
            for (int jx = 0; jx < 4; ++jx) { u32x2 w; w.x = cvtpk(v[jx][0], v[jx][1]); w.y = cvtpk(v[jx][2], v[jx][3]); o8[64 * jx] = w; }
            const float ang = (float)positions[m] * invf;
            if (lane < 32) cosT[(size_t)m * 32 + lane] = cosf(ang); else sinT[(size_t)m * 32 + (lane - 32)] = sinf(ang);
        }
        if (bx < 32) {
            const int kv = bx >> 4, slab = bx & 15;
            const float* pe = (const float*)args.in[kv ? 7 : 6]; const float* W1 = (const float*)args.in[kv ? 10 : 8];
            const int n = tid & 255, half = tid >> 8; float acc = 0.f;
            for (int k = slab * 128 + half * 64; k < slab * 128 + half * 64 + 64; ++k) acc += pe[k] * W1[(size_t)k * 256 + n];
            __syncthreads();
            LAS float* red = (LAS float*)L;
            if (half) red[n] = acc;
            __syncthreads();
            if (!half) ((float*)(ws + WS_BIASP))[(kv * 16 + slab) * 256 + n] = acc + red[n];
            __syncthreads();
        }
    }
    grid.sync();
    {
        pg8::Gemm g{(const bf16_t*)(ws + WS_XB), (const bf16_t*)(ws + WS_WIN), T, INP, D}; pg8::StaticOrder SO; SO.init(T, INP, G, bx);
        EpiProj E{(const float*)(ws + WS_RS1), (const float*)(ws + WS_COS), (const float*)(ws + WS_SIN), ws};
        pg8::gemm_phase<EpiProj, true>(L, g, SO, E, wave_s);
    }
    xcd_barrier(xbar);
    {
        PHASE_IDS();
        { pg8::Gemm g{(const bf16_t*)(ws + WS_KC), (const bf16_t*)(ws + WS_W1K), 4096, 512, 1024}; pg8::StaticOrder SO; SO.init(4096, 512, G, bx);
          EpiF32 E{(float*)(ws + WS_GK), 512}; pg8::gemm_phase<EpiF32, true>(L, g, SO, E, wave_s); }
        { pg8::Gemm g{(const bf16_t*)(ws + WS_VC), (const bf16_t*)(ws + WS_W1V), 4096, 512, 1024}; pg8::StaticOrder SO; SO.init(4096, 512, G, (bx + G - 32) % G);
          EpiF32 E{(float*)(ws + WS_GV), 512}; pg8::gemm_phase<EpiF32, true>(L, g, SO, E, wave_s); }
        __syncthreads();
        const float* lf = (const float*)args.in[4];
        float sa = 0.f, sb = 0.f;
        for (int d = 0; d < 64; ++d) { sa += lf[d] * lf[64 + d]; sb += lf[128 + d] * lf[192 + d]; }
        const float lam = __uint_as_float((unsigned)__builtin_amdgcn_readfirstlane((int)__float_as_uint(expf(sa) - expf(sb) + LAM_INIT)));
        if (wave_s == 0 && lane_id() == 0) misc[1] = 0;
        for (;;) {
            if (wave_s == 0 && lane_id() == 0) misc[0] = queue_fetch(ctl + 512, xbar.x & 7u, misc + 1);
            __syncthreads();
            const int idx = misc[0];
            __syncthreads();
            if (idx < 0) break;
            const int li = idx & 127, qb = 31 - (li >> 2), bh = (idx >> 7) * 4 + (li & 3);
            diff_unit(L, bh >> 2, bh & 3, qb, ws, lam, (const float*)args.in[5], wave_s);
        }
    }
    xcd_barrier(xbar);
    {
        PHASE_IDS();
        LAS float* hid = (LAS float*)L;
        LAS float* bias = hid + 4096;
        for (int un = bx; un < 512; un += G) {
            const int kv = un >> 8, p = (un >> 4) & 15, rb = un & 15;
            const float* Gm = (const float*)(ws + (kv ? WS_GV : WS_GK));
            const float* w2 = (const float*)args.in[kv ? 11 : 9];
            if (tid < 256) { float a = 0.f; const float* bp = (const float*)(ws + WS_BIASP) + kv * 16 * 256 + tid;
#pragma unroll
                for (int s = 0; s < 16; ++s) a += bp[s * 256]; bias[tid] = a; }
            __syncthreads();
#pragma unroll
            for (int i = 0; i < 8; ++i) { const int e = tid + 512 * i, r = e >> 8, k = e & 255, c = 16 * rb + r; const size_t R = (size_t)p * 256 + c;
                float v = Gm[R * 512 + k] + bias[k]; if (c < 255) v += Gm[(R + 1) * 512 + 256 + k];
                hid[r * 256 + k] = v / (1.f + __expf(-v)); }
            __syncthreads();
            const int d = tid & 63, r0 = tid >> 6; float a0 = 0.f, a1 = 0.f;
#pragma unroll 8
            for (int k = 0; k < 256; ++k) { const float w = w2[k * 64 + d]; a0 += hid[r0 * 256 + k] * w; a1 += hid[(r0 + 8) * 256 + k] * w; }
            bf16_t* O = (bf16_t*)(ws + (kv ? WS_VCMP : WS_KCMP)) + ((size_t)p * 256 + 16 * rb) * 64;
            O[r0 * 64 + d] = (bf16_t)(cvtpk(a0, 0.f) & 0xffffu); O[(r0 + 8) * 64 + d] = (bf16_t)(cvtpk(a1, 0.f) & 0xffffu);
            __syncthreads();
        }
    }
    xcd_barrier(xbar);
    {
        PHASE_IDS();
        if (wave_s == 0 && lane_id() == 0) misc[1] = 0;
        for (;;) {
            if (wave_s == 0 && lane_id() == 0) misc[0] = queue_fetch(ctl + 1024, xbar.x & 7u, misc + 1);
            __syncthreads();
            const int idx = misc[0];
            __syncthreads();
            if (idx < 0) break;
            const int li = idx & 127, qblk = 63 - (li >> 1), pgx = (idx >> 7) * 2 + (li & 1);
            nsa_unit(L, pgx >> 1, pgx & 1, qblk, ws, wave_s);
        }
    }
    xcd_barrier(xbar);
    {
        { pg8::Gemm g{(const bf16_t*)(ws + WS_YA), (const bf16_t*)(ws + WS_WA), T, D, 512}; pg8::StaticOrder SO; SO.init(T, D, G, bx);
          EpiBranch<false> E{(bf16_t*)(ws + WS_XB), (const bf16_t*)(ws + WS_MG)}; pg8::gemm_phase<EpiBranch<false>, true>(L, g, SO, E, wave_s); }
        __syncthreads();
        { pg8::Gemm g{(const bf16_t*)(ws + WS_YB), (const bf16_t*)(ws + WS_WB), T, D, 512}; pg8::StaticOrder SO; SO.init(T, D, G, bx);
          EpiBranch<true> E{(bf16_t*)(ws + WS_XB), (const bf16_t*)(ws + WS_MG)}; pg8::gemm_phase<EpiBranch<true>, true>(L, g, SO, E, wave_s); }
    }
    xcd_barrier(xbar);
    {
        pg8::Gemm g{(const bf16_t*)(ws + WS_XB), (const bf16_t*)(ws + WS_WO), T, D, D}; pg8::StaticOrder SO; SO.init(T, D, G, bx);
        EpiResid<true> E{x, out, (bf16_t*)(ws + WS_YA), (float*)(ws + WS_SSQ2)};
        pg8::gemm_phase<EpiResid<true>, true>(L, g, SO, E, wave_s);
    }
    xcd_barrier(xbar);
    {
        pg8::Gemm g{(const bf16_t*)(ws + WS_YA), (const bf16_t*)(ws + WS_WGU), T, FF2, D}; pg8::StaticOrder SO; SO.init(T, FF2, G, bx);
        EpiGU E{(const float*)(ws + WS_SSQ2), (bf16_t*)(ws + WS_ACT)};
        pg8::gemm_phase<EpiGU, true>(L, g, SO, E, wave_s);
    }
    xcd_barrier(xbar);
    {
        pg8::Gemm g{(const bf16_t*)(ws + WS_ACT), (const bf16_t*)(ws + WS_WD), T, D, FF}; pg8::StaticOrder SO; SO.init(T, D, G, bx);
        EpiResid<false> E{out, out, nullptr, (float*)(ws + WS_SSQ3)};
        pg8::gemm_phase<EpiResid<false>, true>(L, g, SO, E, wave_s);
    }
    xcd_barrier(xbar);
    {
        PHASE_IDS();
        const float* gf = (const float*)args.in[19]; const float* SSQ3 = (const float*)(ws + WS_SSQ3);
        const int gw = bx * 8 + wave, NGW = G * 8;
        f32x4 gv[4];
#pragma unroll
        for (int jx = 0; jx < 4; ++jx) gv[jx] = ((const f32x4*)gf)[lane + 64 * jx];
        for (int m = gw; m < T; m += NGW) {
            float s = (lane < 16) ? SSQ3[(size_t)m * 16 + lane] : 0.f;
            s = wave_sum(s);
            const float rs = rsqrtf(s * (1.f / D) + EPS);
            f32x4* xr = (f32x4*)(out + (size_t)m * D) + lane;
#pragma unroll
            for (int jx = 0; jx < 4; ++jx) { f32x4 v = xr[64 * jx]; v = v * rs * gv[jx]; xr[64 * jx] = v; }
        }
    }
}

extern "C" void kernel_launch(void* const* d_in, const int* in_sizes, int n_in, void* d_out, int out_size, void* d_ws, size_t ws_size, hipStream_t stream) {
    static int grid = 0;
    if (grid == 0) {
        if (n_in != 20 || out_size != T * D || ws_size < WS_END) { fprintf(stderr, "kernel_launch: unexpected shapes (n_in %d out %d ws %zu)\n", n_in, out_size, ws_size); grid = -1; return; }
        int dev = 0, cus = 0, per_cu = 0;
        hipGetDevice(&dev);
        hipDeviceGetAttribute(&cus, hipDeviceAttributeMultiprocessorCount, dev);
        hipFuncSetAttribute((const void*)hybrid_fwd, hipFuncAttributeMaxDynamicSharedMemorySize, LDS_BYTES);
        hipOccupancyMaxActiveBlocksPerMultiprocessor(&per_cu, (const void*)hybrid_fwd, 512, LDS_BYTES);
        if (per_cu < 1) { fprintf(stderr, "kernel_launch: occupancy query says %d blocks per CU\n", per_cu); per_cu = 1; }
        (void)hipGetLastError();
        grid = cus * per_cu;
    }
    if (grid < 0) return;
    hipMemsetAsync((char*)d_ws + WS_CTL, 0, 32768, stream);
    Args a{};
    for (int i = 0; i < 20; ++i) a.in[i] = d_in[i];
    a.out = (float*)d_out; a.ws = (unsigned char*)d_ws;
    void* params[] = {&a};
    hipError_t e = hipLaunchCooperativeKernel((const void*)hybrid_fwd, dim3(grid), dim3(512), params, LDS_BYTES, stream);
    if (e != hipSuccess) fprintf(stderr, "cooperative launch failed: %s (grid %d)\n", hipGetErrorString(e), grid);
}
```

```cpp
#include <hip/hip_runtime.h>
#include <hip/hip_cooperative_groups.h>
#include <cstdint>
#include <cstdio>
#include <type_traits>
namespace cg = cooperative_groups;

#define LAS __attribute__((address_space(3)))
typedef unsigned short bf16_t;
typedef short bf16x8 __attribute__((ext_vector_type(8)));
typedef short s16x4 __attribute__((ext_vector_type(4)));
typedef float f32x4 __attribute__((ext_vector_type(4)));
typedef float f32x2 __attribute__((ext_vector_type(2)));
typedef float f32x16 __attribute__((ext_vector_type(16)));
typedef unsigned u32x4 __attribute__((ext_vector_type(4)));
typedef unsigned u32x2 __attribute__((ext_vector_type(2)));
typedef __bf16 bf16x2_t __attribute__((ext_vector_type(2)));

constexpr int NB = 8, S = 4096, T = NB * S, D = 1024, FF = 2816, FF2 = 2 * FF, INP = 5120;
constexpr float EPS = 1e-6f;
constexpr float C2 = 0.125f * 1.4426950408889634f;
constexpr float LAM_INIT = 0.2f;

constexpr size_t MiB = 1u << 20;
constexpr size_t WS_CTL = 0;
constexpr size_t WS_WIN = 1 * MiB, WS_WGU = 11 * MiB, WS_WD = 22 * MiB, WS_WO = 28 * MiB, WS_WA = 30 * MiB, WS_WB = 31 * MiB, WS_W1K = 32 * MiB, WS_W1V = 33 * MiB;
constexpr size_t WS_COS = 34 * MiB, WS_SIN = 38 * MiB;
constexpr size_t WS_RS1 = 42 * MiB, WS_SSQ2 = 43 * MiB, WS_SSQ3 = 45 * MiB, WS_NG = 47 * MiB, WS_BIASP = 50 * MiB;
constexpr size_t WS_GK = 52 * MiB, WS_GV = 60 * MiB, WS_KCMP = 68 * MiB, WS_VCMP = 69 * MiB;
constexpr size_t WS_XB = 70 * MiB;
constexpr size_t WS_DQ = 134 * MiB, WS_DK = 166 * MiB, WS_DV = 198 * MiB, WS_NQ = 230 * MiB;
constexpr size_t WS_KC = 262 * MiB, WS_VC = 270 * MiB, WS_KS = 278 * MiB, WS_VS = 286 * MiB, WS_KW = 294 * MiB, WS_VW = 302 * MiB;
constexpr size_t WS_ACT = 134 * MiB;
constexpr size_t WS_MG = 310 * MiB;
constexpr size_t WS_YA = 438 * MiB, WS_YB = 470 * MiB;
constexpr size_t WS_END = 502 * MiB;
constexpr int LDS_BYTES = 155648;

__device__ __forceinline__ unsigned cvtpk(float lo, float hi) { f32x2 v = {lo, hi}; bf16x2_t b = __builtin_convertvector(v, bf16x2_t); return __builtin_bit_cast(unsigned, b); }
__device__ __forceinline__ float bf2f(unsigned short h) { return __uint_as_float(((unsigned)h) << 16); }
__device__ __forceinline__ float bflo(unsigned w) { return __uint_as_float(w << 16); }
__device__ __forceinline__ float bfhi(unsigned w) { return __uint_as_float(w & 0xffff0000u); }
__device__ __forceinline__ float sigmoidf_(float x) { return 1.f / (1.f + __expf(-x)); }
__device__ __forceinline__ int lane_id() { unsigned z = 0u; asm volatile("" : "+v"(z)); return (int)__builtin_amdgcn_mbcnt_hi(~0u, __builtin_amdgcn_mbcnt_lo(~0u, z)); }
__device__ __forceinline__ float xor32_sum(float v) { auto rr = __builtin_amdgcn_permlane32_swap(__float_as_uint(v), __float_as_uint(v), false, false); return __uint_as_float(rr[0]) + __uint_as_float(rr[1]); }
__device__ __forceinline__ float xor32_max(float v) { auto rr = __builtin_amdgcn_permlane32_swap(__float_as_uint(v), __float_as_uint(v), false, false); return __builtin_fmaxf(__uint_as_float(rr[0]), __uint_as_float(rr[1])); }
__device__ __forceinline__ float wave_sum(float v) {
#pragma unroll
    for (int o = 1; o < 64; o <<= 1) v += __shfl_xor(v, o);
    return v;
}

namespace pg8 {
constexpr int BM = 256, BK = 64, HALF = 128, HTB = HALF * BK * 2, STAGE_BYTES = 8 * HTB, NXCD = 8, WGM = 8;
__host__ __device__ __forceinline__ int lds_byte(int r, int c) { const int st = (r >> 4) * 2 + (c >> 5), rr = r & 15, cc = c & 31, ob = rr * 64 + cc * 2; return st * 1024 + (ob ^ (((ob >> 9) & 1) << 5)); }
__host__ __device__ __forceinline__ void stage_rc(int b, int& R, int& C) { const int st = b / 1024, sb = b % 1024, swz = sb ^ (((sb >> 9) & 1) << 5); R = (st >> 1) * 16 + swz / 64; C = (st & 1) * 32 + (swz % 64) / 2; }
__host__ __device__ __forceinline__ int perm32(int rho) { const int n = rho >> 4, i = rho & 15; return 8 * (i >> 2) + 4 * n + (i & 3); }
struct Unit { int pm, pn; };
struct Gemm { const bf16_t* A; const bf16_t* Bt; int M, N, K; };
struct StaticOrder {
    int nM, nN, nwg, G, c;
    __host__ __device__ void init(int M, int N, int G_, int c_) { nM = M / BM; nN = N / BM; nwg = nM * nN; G = G_; c = c_; }
    __host__ __device__ bool next(int i, Unit& u) const {
        const long L = (long)i * G + c; if (L >= nwg) return false;
        int wgid = (int)L; { const int q = nwg / NXCD, r = nwg % NXCD, xcd = wgid % NXCD, off = wgid / NXCD; wgid = (xcd < r ? xcd * (q + 1) : r * (q + 1) + (xcd - r) * q) + off; }
        const int nig = WGM * nN, gid = wgid / nig, fm = gid * WGM, gsz = (nM - fm) < WGM ? (nM - fm) : WGM;
        u.pm = fm + ((wgid % nig) % gsz); u.pn = (wgid % nig) / gsz; return true;
    }
};
template <class Epi, bool ALIGN_EPI>
__device__ __forceinline__ void gemm_phase(LAS unsigned char* lds, const Gemm g, const StaticOrder& S, const Epi& E, int wv) {
    int tid_ = wv * 64 + lane_id(); asm volatile("" : "+v"(tid_));
    const int tid = tid_, wid = __builtin_amdgcn_readfirstlane(tid >> 6), lane = tid & 63, wr = wid >> 2, wc = wid & 3, fr = lane & 15, fq = lane >> 4;
    const int K = g.K, nt = K / BK;
    unsigned voffA[2], voffB[2];
#pragma unroll
    for (int i = 0; i < 2; ++i) { int R, C; stage_rc(tid * 16 + i * 8192, R, C); const int Rb = (R & ~31) + perm32(R & 31);
        voffA[i] = (unsigned)(R * K + C) * 2u; voffB[i] = (unsigned)(Rb * K + C) * 2u; }
    const size_t kstep = (size_t)(BK * 2);
    const size_t hstep = (size_t)HALF * K * 2;
    const size_t tstep = 2 * hstep;
    const unsigned ldsw = (unsigned)wid * 1024u;
    const int aoff = lds_byte(wr * 64 + fr, fq * 8), boff = lds_byte(wc * 32 + fr, fq * 8);
#define PG8_SA(b, h) (((b) * 2 + (h)) * HTB)
#define PG8_SB(b, h) ((4 + (b) * 2 + (h)) * HTB)
#define PG8_STAGE(bufoff, gbase, voff) do { _Pragma("unroll") for (int _i = 0; _i < 2; ++_i) \
        __builtin_amdgcn_global_load_lds((const unsigned*)((const char*)(gbase) + (voff)[_i]), (LAS unsigned*)(lds + (bufoff) + ldsw + _i * 8192), 16, 0, 0); } while (0)
#define PG8_LDA(dst, b, h) do { _Pragma("unroll") for (int m = 0; m < 4; ++m) _Pragma("unroll") for (int k = 0; k < 2; ++k) dst[m][k] = *(const LAS bf16x8*)(lds + PG8_SA(b, h) + aoff + m * 2048 + k * 1024); } while (0)
#define PG8_LDB(dst, b, h) do { _Pragma("unroll") for (int n = 0; n < 2; ++n) _Pragma("unroll") for (int k = 0; k < 2; ++k) dst[n][k] = *(const LAS bf16x8*)(lds + PG8_SB(b, h) + boff + n * 2048 + k * 1024); } while (0)
#define PG8_MMA(ai, bj, At, Bt) do { __builtin_amdgcn_s_setprio(1); _Pragma("unroll") for (int m = 0; m < 4; ++m) _Pragma("unroll") for (int n = 0; n < 2; ++n) _Pragma("unroll") for (int k = 0; k < 2; ++k) \
        acc[ai][bj][m][n] = __builtin_amdgcn_mfma_f32_16x16x32_bf16(Bt[n][k], At[m][k], acc[ai][bj][m][n], 0, 0, 0); __builtin_amdgcn_s_setprio(0); } while (0)
#define PG8_WAIT_V(n) asm volatile("s_waitcnt vmcnt(" #n ")" ::: "memory")
#define PG8_WAIT_L(n) asm volatile("s_waitcnt lgkmcnt(" #n ")" ::: "memory")
#define PG8_BAR __builtin_amdgcn_s_barrier()
#define PG8_SCHED __builtin_amdgcn_sched_barrier(0)
    Unit cur, nxt; int ui = 0;
    if (!S.next(0, cur)) return;
    f32x4 acc[2][2][4][2];
#pragma unroll
    for (int a = 0; a < 2; ++a)
#pragma unroll
        for (int b = 0; b < 2; ++b)
#pragma unroll
            for (int m = 0; m < 4; ++m)
#pragma unroll
                for (int n = 0; n < 2; ++n) acc[a][b][m][n] = (f32x4){0.f, 0.f, 0.f, 0.f};
    bf16x8 At[4][2], B0[2][2], B1[2][2];
    const char* cA = (const char*)g.A + (size_t)cur.pm * tstep; const char* cB = (const char*)g.Bt + (size_t)cur.pn * tstep;
    PG8_STAGE(PG8_SB(0, 0), cB, voffB); PG8_STAGE(PG8_SB(0, 1), cB + hstep, voffB); PG8_STAGE(PG8_SA(0, 0), cA, voffA); PG8_STAGE(PG8_SA(0, 1), cA + hstep, voffA);
    if (wr == 1) PG8_BAR;
    PG8_WAIT_V(2); PG8_BAR;
    PG8_STAGE(PG8_SB(1, 0), cB + kstep, voffB); PG8_STAGE(PG8_SA(1, 0), cA + kstep, voffA); PG8_STAGE(PG8_SB(1, 1), cB + hstep + kstep, voffB);
    PG8_WAIT_V(6); PG8_BAR;
    for (;;) {
        const bool has_next = S.next(ui + 1, nxt);
        const char* nA = has_next ? (const char*)g.A + (size_t)nxt.pm * tstep : cA; const char* nB = has_next ? (const char*)g.Bt + (size_t)nxt.pn * tstep : cB;
        for (int t = 0; t < nt; t += 2) {
            const bool last = (t == nt - 2);
            const char* a1 = cA + (size_t)(t + 1) * kstep;
            const char* a2 = last ? nA : cA + (size_t)(t + 2) * kstep; const char* b2 = last ? nB : cB + (size_t)(t + 2) * kstep;
            const char* a3 = a2 + kstep; const char* b3 = b2 + kstep;
            PG8_LDB(B0, 0, 0); PG8_LDB(B1, 0, 1); PG8_SCHED; PG8_LDA(At, 0, 0); PG8_STAGE(PG8_SA(1, 1), a1 + hstep, voffA);
            PG8_WAIT_V(8); PG8_WAIT_L(0); PG8_BAR; PG8_MMA(0, 0, At, B0); PG8_MMA(0, 1, At, B1); PG8_BAR; PG8_SCHED;
            PG8_LDA(At, 0, 1); PG8_STAGE(PG8_SB(0, 0), b2, voffB); PG8_STAGE(PG8_SB(0, 1), b2 + hstep, voffB); PG8_STAGE(PG8_SA(0, 0), a2, voffA);
            PG8_WAIT_V(8); PG8_WAIT_L(0); PG8_BAR; PG8_MMA(1, 0, At, B0); PG8_MMA(1, 1, At, B1); PG8_BAR; PG8_SCHED;
            PG8_LDB(B0, 1, 0); PG8_LDB(B1, 1, 1); PG8_SCHED; PG8_LDA(At, 1, 0); PG8_STAGE(PG8_SA(0, 1), a2 + hstep, voffA);
            PG8_WAIT_V(8); PG8_WAIT_L(0); PG8_BAR; PG8_MMA(0, 0, At, B0); PG8_MMA(0, 1, At, B1); PG8_BAR; PG8_SCHED;
            PG8_LDA(At, 1, 1); PG8_STAGE(PG8_SB(1, 0), b3, voffB); PG8_STAGE(PG8_SB(1, 1), b3 + hstep, voffB); PG8_STAGE(PG8_SA(1, 0), a3, voffA);
            PG8_WAIT_V(8); PG8_WAIT_L(0); PG8_BAR; PG8_MMA(1, 0, At, B0); PG8_MMA(1, 1, At, B1); PG8_BAR; PG8_SCHED;
        }
        if constexpr (ALIGN_EPI) { if (wr == 0) PG8_BAR; }
        E(acc, cur, wr, wc, fr, fq);
        if (!has_next) break;
#pragma unroll
        for (int a = 0; a < 2; ++a)
#pragma unroll
            for (int b = 0; b < 2; ++b)
#pragma unroll
                for (int m = 0; m < 4; ++m)
#pragma unroll
                    for (int n = 0; n < 2; ++n) acc[a][b][m][n] = (f32x4){0.f, 0.f, 0.f, 0.f};
        cur = nxt; cA = nA; cB = nB; ++ui;
        if constexpr (ALIGN_EPI) { if (wr == 1) PG8_BAR; }
    }
    PG8_WAIT_V(0);
    if constexpr (!ALIGN_EPI) { if (wr == 0) PG8_BAR; }
    PG8_BAR;
#undef PG8_SA
#undef PG8_SB
#undef PG8_STAGE
#undef PG8_LDA
#undef PG8_LDB
#undef PG8_MMA
#undef PG8_WAIT_V
#undef PG8_WAIT_L
#undef PG8_BAR
#undef PG8_SCHED
}
}

typedef f32x4 AccT[2][2][4][2];

struct EpiProj {
    const float* rs1; const float* cosT; const float* sinT;
    unsigned char* ws;
    __device__ __forceinline__ void operator()(const AccT& acc, const pg8::Unit& u, int wr, int wc, int fr, int fq) const {
        const int row0 = u.pm * 256 + wr * 64 + fr;
#pragma unroll
        for (int bj = 0; bj < 2; ++bj) {
            const int sec = u.pn * 2 + bj;
            if (sec >= 39) continue;
            if (sec == 38) {
                if (wc == 0 && fq < 3) {
                    float* NG = (float*)(ws + WS_NG);
#pragma unroll
                    for (int ai = 0; ai < 2; ++ai)
#pragma unroll
                        for (int m = 0; m < 4; ++m) { const int r = row0 + ai * 128 + m * 16; const float rs = rs1[r];
                            f32x4 v0 = acc[ai][bj][m][0] * rs, v1 = acc[ai][bj][m][1] * rs;
                            f32x4 o0, o1;
#pragma unroll
                            for (int i = 0; i < 4; ++i) { o0[i] = sigmoidf_(v0[i]); o1[i] = sigmoidf_(v1[i]); }
                            *(f32x4*)(NG + (size_t)r * 24 + fq * 8) = o0; *(f32x4*)(NG + (size_t)r * 24 + fq * 8 + 4) = o1; }
                }
                continue;
            }
            if (sec >= 22) {
                bf16_t* MG = (bf16_t*)(ws + WS_MG);
                const int col = (sec - 22) * 128 + wc * 32 + fq * 8;
#pragma unroll
                for (int ai = 0; ai < 2; ++ai)
#pragma unroll
                    for (int m = 0; m < 4; ++m) { const int r = row0 + ai * 128 + m * 16; const float rs = rs1[r];
                        f32x4 v0 = acc[ai][bj][m][0] * rs, v1 = acc[ai][bj][m][1] * rs;
                        u32x4 w; w.x = cvtpk(sigmoidf_(v0[0]), sigmoidf_(v0[1])); w.y = cvtpk(sigmoidf_(v0[2]), sigmoidf_(v0[3]));
                        w.z = cvtpk(sigmoidf_(v1[0]), sigmoidf_(v1[1])); w.w = cvtpk(sigmoidf_(v1[2]), sigmoidf_(v1[3]));
                        *(u32x4*)(MG + (size_t)r * 2048 + col) = w; }
                continue;
            }
            bf16_t* base; int H, head, HD, coff; bool rope; float scale = 1.f;
            if (sec < 4)       { base = (bf16_t*)(ws + WS_DQ); H = 4; head = sec;      HD = 128; coff = (wc >> 1) * 64; rope = true; scale = C2; }
            else if (sec < 8)  { base = (bf16_t*)(ws + WS_DK); H = 8; head = (sec - 4) * 2 + (wc >> 1); HD = 64; coff = 0; rope = true; }
            else if (sec < 12) { base = (bf16_t*)(ws + WS_DV); H = 4; head = sec - 8;  HD = 128; coff = (wc >> 1) * 64; rope = false; }
            else if (sec < 16) { base = (bf16_t*)(ws + WS_NQ); H = 8; head = (sec - 12) * 2 + (wc >> 1); HD = 64; coff = 0; rope = true; scale = C2; }
            else { const int k6 = sec - 16; base = (bf16_t*)(ws + WS_KC + (size_t)k6 * 8 * MiB); H = 2; head = wc >> 1; HD = 64; coff = 0; rope = (k6 & 1) == 0; }
            const int j = 4 * (wc & 1) + fq;
#pragma unroll
            for (int ai = 0; ai < 2; ++ai)
#pragma unroll
                for (int m = 0; m < 4; ++m) { const int r = row0 + ai * 128 + m * 16; const float rs = rs1[r] * scale;
                    const int b = r >> 12, s = r & 4095;
                    bf16_t* p = base + ((size_t)(b * H + head) * S + s) * HD + coff;
                    f32x4 v0 = acc[ai][bj][m][0] * rs, v1 = acc[ai][bj][m][1] * rs;
                    if (rope) {
                        const f32x4 c = *(const f32x4*)(cosT + (size_t)r * 32 + 4 * j), sn = *(const f32x4*)(sinT + (size_t)r * 32 + 4 * j);
                        const f32x4 o1 = v0 * c - v1 * sn, o2 = v1 * c + v0 * sn;
                        u32x2 w1, w2; w1.x = cvtpk(o1[0], o1[1]); w1.y = cvtpk(o1[2], o1[3]); w2.x = cvtpk(o2[0], o2[1]); w2.y = cvtpk(o2[2], o2[3]);
                        *(u32x2*)(p + 4 * j) = w1; *(u32x2*)(p + 32 + 4 * j) = w2;
                    } else {
                        u32x4 w; w.x = cvtpk(v0[0], v0[1]); w.y = cvtpk(v0[2], v0[3]); w.z = cvtpk(v1[0], v1[1]); w.w = cvtpk(v1[2], v1[3]);
                        *(u32x4*)(p + 8 * j) = w;
                    }
                }
        }
    }
};
struct EpiF32 {
    float* O; int ldc;
    __device__ __forceinline__ void operator()(const AccT& acc, const pg8::Unit& u, int wr, int wc, int fr, int fq) const {
        const int row0 = u.pm * 256 + wr * 64 + fr, col0 = u.pn * 256 + wc * 32 + fq * 8;
#pragma unroll
        for (int ai = 0; ai < 2; ++ai)
#pragma unroll
            for (int m = 0; m < 4; ++m)
#pragma unroll
                for (int bj = 0; bj < 2; ++bj) { float* p = O + (size_t)(row0 + ai * 128 + m * 16) * ldc + col0 + bj * 128;
                    *(f32x4*)p = acc[ai][bj][m][0]; *(f32x4*)(p + 4) = acc[ai][bj][m][1]; }
    }
};
template <bool SECOND> struct EpiBranch {
    bf16_t* MERGED; const bf16_t* MG;
    __device__ __forceinline__ void operator()(const AccT& acc, const pg8::Unit& u, int wr, int wc, int fr, int fq) const {
        const int row0 = u.pm * 256 + wr * 64 + fr, col0 = u.pn * 256 + wc * 32 + fq * 8;
#pragma unroll
        for (int ai = 0; ai < 2; ++ai)
#pragma unroll
            for (int m = 0; m < 4; ++m)
#pragma unroll
                for (int bj = 0; bj < 2; ++bj) { const int r = row0 + ai * 128 + m * 16, c = col0 + bj * 128;
                    const u32x4 g = *(const u32x4*)(MG + (size_t)r * 2048 + (SECOND ? 1024 : 0) + c);
                    const f32x4 a0 = acc[ai][bj][m][0], a1 = acc[ai][bj][m][1];
                    float o[8] = {bflo(g.x) * a0[0], bfhi(g.x) * a0[1], bflo(g.y) * a0[2], bfhi(g.y) * a0[3], bflo(g.z) * a1[0], bfhi(g.z) * a1[1], bflo(g.w) * a1[2], bfhi(g.w) * a1[3]};
                    bf16_t* p = MERGED + (size_t)r * 1024 + c;
                    if (SECOND) { const u32x4 pv = *(const u32x4*)p;
                        o[0] += bflo(pv.x); o[1] += bfhi(pv.x); o[2] += bflo(pv.y); o[3] += bfhi(pv.y); o[4] += bflo(pv.z); o[5] += bfhi(pv.z); o[6] += bflo(pv.w); o[7] += bfhi(pv.w); }
                    u32x4 w; w.x = cvtpk(o[0], o[1]); w.y = cvtpk(o[2], o[3]); w.z = cvtpk(o[4], o[5]); w.w = cvtpk(o[6], o[7]);
                    *(u32x4*)p = w; }
    }
};
template <bool WRITE_BF> struct EpiResid {
    const float* base; float* out; bf16_t* HB; float* SSQ;
    __device__ __forceinline__ void operator()(const AccT& acc, const pg8::Unit& u, int wr, int wc, int fr, int fq) const {
        const int row0 = u.pm * 256 + wr * 64 + fr, col0 = u.pn * 256 + wc * 32 + fq * 8;
#pragma unroll
        for (int ai = 0; ai < 2; ++ai)
#pragma unroll
            for (int m = 0; m < 4; ++m) { const int r = row0 + ai * 128 + m * 16; float ss = 0.f;
#pragma unroll
                for (int bj = 0; bj < 2; ++bj) { const size_t off = (size_t)r * 1024 + col0 + bj * 128;
                    const f32x4 h0 = *(const f32x4*)(base + off) + acc[ai][bj][m][0], h1 = *(const f32x4*)(base + off + 4) + acc[ai][bj][m][1];
                    *(f32x4*)(out + off) = h0; *(f32x4*)(out + off + 4) = h1;
                    ss += (h0[0] * h0[0] + h0[1] * h0[1]) + (h0[2] * h0[2] + h0[3] * h0[3]) + (h1[0] * h1[0] + h1[1] * h1[1]) + (h1[2] * h1[2] + h1[3] * h1[3]);
                    if (WRITE_BF) { u32x4 w; w.x = cvtpk(h0[0], h0[1]); w.y = cvtpk(h0[2], h0[3]); w.z = cvtpk(h1[0], h1[1]); w.w = cvtpk(h1[2], h1[3]); *(u32x4*)(HB + off) = w; } }
                ss += __shfl_xor(ss, 16); ss += __shfl_xor(ss, 32);
                if (fq == 0) SSQ[(size_t)r * 16 + u.pn * 4 + wc] = ss; }
    }
};
struct EpiGU {
    const float* SSQ2; bf16_t* ACT;
    __device__ __forceinline__ void operator()(const AccT& acc, const pg8::Unit& u, int wr, int wc, int fr, int fq) const {
        const int row0 = u.pm * 256 + wr * 64 + fr, col0 = u.pn * 128 + wc * 16 + fq * 4;
#pragma unroll
        for (int ai = 0; ai < 2; ++ai)
#pragma unroll
            for (int m = 0; m < 4; ++m) { const int r = row0 + ai * 128 + m * 16;
                const f32x4* sp = (const f32x4*)(SSQ2 + (size_t)r * 16); const f32x4 s0 = sp[0], s1 = sp[1], s2 = sp[2], s3 = sp[3];
                const float tot = ((s0[0] + s0[1]) + (s0[2] + s0[3])) + ((s1[0] + s1[1]) + (s1[2] + s1[3])) + ((s2[0] + s2[1]) + (s2[2] + s2[3])) + ((s3[0] + s3[1]) + (s3[2] + s3[3]));
                const float rs = rsqrtf(tot * (1.f / 1024.f) + EPS);
#pragma unroll
                for (int bj = 0; bj < 2; ++bj) { const f32x4 gv = acc[ai][bj][m][0] * rs, uv = acc[ai][bj][m][1] * rs; float o[4];
#pragma unroll
                    for (int i = 0; i < 4; ++i) o[i] = gv[i] * sigmoidf_(gv[i]) * uv[i];
                    u32x2 w; w.x = cvtpk(o[0], o[1]); w.y = cvtpk(o[2], o[3]);
                    *(u32x2*)(ACT + (size_t)r * FF + col0 + bj * 64) = w; } }
    }
};

typedef std::integral_constant<bool, true> TrueC; typedef std::integral_constant<bool, false> FalseC;
__device__ __forceinline__ int crow(int r, int hi) { return (r & 3) + 8 * (r >> 2) + 4 * hi; }
__device__ __forceinline__ constexpr int ccol(int r) { return (r & 3) + 8 * (r >> 2); }
__device__ __forceinline__ void glds16(const void* g, LAS unsigned char* l) {
    unsigned keep; const unsigned dst = (unsigned)__builtin_amdgcn_readfirstlane((int)(unsigned)(uintptr_t)l);
    asm volatile("s_mov_b32 %0, m0\n\ts_mov_b32 m0, %2\n\ts_nop 0\n\tglobal_load_lds_dwordx4 %1, off\n\ts_mov_b32 m0, %0" : "=&s"(keep) : "v"(g), "s"(dst) : "memory");
}
#define VM_DRAIN_SYNC() do { asm volatile("s_waitcnt vmcnt(0)" ::: "memory"); __syncthreads(); } while (0)
#define WAIT_BAR(N) asm volatile("s_waitcnt vmcnt(" #N ") lgkmcnt(0)\n\ts_barrier" ::: "memory")
__device__ __forceinline__ void wait_bar_n(int n) { if (n == 4) WAIT_BAR(4); else if (n == 2) WAIT_BAR(2); else if (n == 1) WAIT_BAR(1); else WAIT_BAR(0); }
__device__ __forceinline__ int ksrc_off(int wid, int lane) { const int ip = (lane - 8 * (wid & 1)) & 63, rho = ip >> 3, c = (ip & 7) ^ rho; return (8 * wid + rho) * 64 + c * 8; }
__device__ __forceinline__ void kread_offs(int (&koff)[4], int r32, int hi) {
    const int pc = r32 >> 3, rho = r32 & 7;
#pragma unroll
    for (int d0 = 0; d0 < 4; ++d0) koff[d0] = pc * 1024 + (((rho * 8 + ((2 * d0 + hi) ^ rho) + 8 * (pc & 1)) & 63) << 4);
}
__device__ __forceinline__ void qkt(f32x16& p0, f32x16& p1, const LAS unsigned char* Kslot, const int (&koff)[4], const bf16x8* qr) {
    bf16x8 kf[8];
#pragma unroll
    for (int d0 = 0; d0 < 4; ++d0) { kf[2 * d0] = *(const LAS bf16x8*)(Kslot + koff[d0]); kf[2 * d0 + 1] = *(const LAS bf16x8*)(Kslot + koff[d0] + 4096); }
    const f32x16 zz = f32x16{};
    p0 = __builtin_amdgcn_mfma_f32_32x32x16_bf16(kf[0], qr[0], zz, 0, 0, 0); p1 = __builtin_amdgcn_mfma_f32_32x32x16_bf16(kf[1], qr[0], zz, 0, 0, 0);
#pragma unroll
    for (int d0 = 1; d0 < 4; ++d0) { p0 = __builtin_amdgcn_mfma_f32_32x32x16_bf16(kf[2 * d0], qr[d0], p0, 0, 0, 0); p1 = __builtin_amdgcn_mfma_f32_32x32x16_bf16(kf[2 * d0 + 1], qr[d0], p1, 0, 0, 0); }
}
__device__ __forceinline__ s16x4 vtr(const LAS unsigned char* p) { return __builtin_bit_cast(s16x4, __builtin_amdgcn_ds_read_tr16_b64_v4i16((LAS s16x4*)p)); }
template <int NDB> struct Flash {
    f32x16 o[NDB]; float mhat, l; bool first;
    __device__ __forceinline__ void reset() {
#pragma unroll
        for (int d = 0; d < NDB; ++d) o[d] = f32x16{};
        mhat = 0.f; l = 0.f; first = true; }
    static __device__ __forceinline__ float rowmax_abs(const f32x16& p0, const f32x16& p1) {
        float a = __builtin_fmaxf(__builtin_fmaxf(p0[0], p0[1]), p1[0]), c = __builtin_fmaxf(__builtin_fmaxf(p0[2], p0[3]), p1[1]);
        a = __builtin_fmaxf(__builtin_fmaxf(a, p1[2]), p1[3]);
#pragma unroll
        for (int r = 4; r < 16; r += 4) { a = __builtin_fmaxf(__builtin_fmaxf(a, p0[r]), p0[r + 1]); c = __builtin_fmaxf(__builtin_fmaxf(c, p0[r + 2]), p0[r + 3]);
            a = __builtin_fmaxf(__builtin_fmaxf(a, p1[r]), p1[r + 1]); c = __builtin_fmaxf(__builtin_fmaxf(c, p1[r + 2]), p1[r + 3]); }
        return xor32_max(__builtin_fmaxf(a, c));
    }
    __device__ __forceinline__ void decide(float rmabs, bool rowvalid, LAS float* wsf, int r32, int hi) {
        const float rm = rowvalid ? rmabs - mhat : -INFINITY;
        bool need; float dl;
        if (first) { need = true; dl = (rm > -1e30f) ? rm : 0.f; }
        else { need = __any(rm > 8.0f); dl = fmaxf(rm, 0.f); }
        if (need) {
            mhat += dl;
            if (!first) {
                const float f = __builtin_amdgcn_exp2f(-dl); l *= f;
                if (hi == 0) wsf[r32] = f;
                asm volatile("s_waitcnt lgkmcnt(0)" ::: "memory");
                const f32x4 t0 = *(const LAS f32x4*)(wsf + 4 * hi), t1 = *(const LAS f32x4*)(wsf + 8 + 4 * hi), t2 = *(const LAS f32x4*)(wsf + 16 + 4 * hi), t3 = *(const LAS f32x4*)(wsf + 24 + 4 * hi);
                const f32x16 fv = {t0[0], t0[1], t0[2], t0[3], t1[0], t1[1], t1[2], t1[3], t2[0], t2[1], t2[2], t2[3], t3[0], t3[1], t3[2], t3[3]};
#pragma unroll
                for (int d = 0; d < NDB; ++d) o[d] = o[d] * fv;
                asm volatile("s_waitcnt lgkmcnt(0)" ::: "memory");
            }
        }
        first = false;
    }
    __device__ __forceinline__ void exphalf(f32x16& p, float mm, u32x4& w0, u32x4& w1) {
        p = p - mm;
        float sa = 0.f, sb = 0.f;
#pragma unroll
        for (int r = 0; r < 16; r += 2) { p[r] = __builtin_amdgcn_exp2f(p[r]); p[r + 1] = __builtin_amdgcn_exp2f(p[r + 1]); sa += p[r]; sb += p[r + 1]; }
        l += sa + sb;
        w0 = (u32x4){cvtpk(p[0], p[1]), cvtpk(p[2], p[3]), cvtpk(p[4], p[5]), cvtpk(p[6], p[7])};
        w1 = (u32x4){cvtpk(p[8], p[9]), cvtpk(p[10], p[11]), cvtpk(p[12], p[13]), cvtpk(p[14], p[15])};
    }
    __device__ __forceinline__ void pv_half(const u32x4& w0, const u32x4& w1, const LAS unsigned char* Vslot, int lane, int hi, int kb) {
        const LAS unsigned char* vp = Vslot + ((lane >> 4) & 1) * 32 + (lane & 3) * 8 + (4 * hi + ((lane & 15) >> 2)) * 64;
#pragma unroll
        for (int d = 0; d < NDB; ++d) {
            const s16x4 l0 = vtr(vp + (d * 4 + kb) * 1024), h0 = vtr(vp + (d * 4 + kb) * 1024 + 512), l1 = vtr(vp + (d * 4 + kb + 1) * 1024), h1 = vtr(vp + (d * 4 + kb + 1) * 1024 + 512);
            o[d] = __builtin_amdgcn_mfma_f32_32x32x16_bf16(__builtin_bit_cast(bf16x8, w0), (bf16x8){l0[0], l0[1], l0[2], l0[3], h0[0], h0[1], h0[2], h0[3]}, o[d], 0, 0, 0);
            o[d] = __builtin_amdgcn_mfma_f32_32x32x16_bf16(__builtin_bit_cast(bf16x8, w1), (bf16x8){l1[0], l1[1], l1[2], l1[3], h1[0], h1[1], h1[2], h1[3]}, o[d], 0, 0, 0);
        }
    }
    __device__ __forceinline__ void tile(f32x16& p0, f32x16& p1, const LAS unsigned char* Vslot, LAS float* wsf, int lane, int r32, int hi) {
        decide(rowmax_abs(p0, p1), true, wsf, r32, hi);
        u32x4 w0, w1, w2, w3;
        exphalf(p0, mhat, w0, w1); pv_half(w0, w1, Vslot, lane, hi, 0);
        exphalf(p1, mhat, w2, w3); pv_half(w2, w3, Vslot, lane, hi, 2);
    }
    __device__ __forceinline__ float ltot() const { return xor32_sum(l); }
};
__device__ __forceinline__ void row_bcast(float v, float (&fr_)[16], LAS float* wsf, int r32, int hi) {
    asm volatile("s_waitcnt lgkmcnt(0)" ::: "memory");
    if (hi == 0) wsf[r32] = v;
    asm volatile("s_waitcnt lgkmcnt(0)" ::: "memory");
#pragma unroll
    for (int k = 0; k < 4; ++k) { const f32x4 t = *(const LAS f32x4*)(wsf + 8 * k + 4 * hi); fr_[4 * k] = t[0]; fr_[4 * k + 1] = t[1]; fr_[4 * k + 2] = t[2]; fr_[4 * k + 3] = t[3]; }
    asm volatile("s_waitcnt lgkmcnt(0)" ::: "memory");
}

constexpr int DF_STAGE = 0;
constexpr int DF_WSF = 98304;
__device__ __forceinline__ void diff_unit(LAS unsigned char* L, int b, int h, int qb, const unsigned char* ws, float lam, const float* subg, int wv) {
    int tid_ = wv * 64 + lane_id(); asm volatile("" : "+v"(tid_));
    const int tid = tid_, lane = tid & 63, r32 = lane & 31, hi = lane >> 5, wid = __builtin_amdgcn_readfirstlane(tid >> 6);
    const int comp = wid >> 2, rgi = wid & 3;
    const size_t bh = (size_t)(b * 4 + h) * S;
    const bf16_t* Qp = (const bf16_t*)(ws + WS_DQ) + (bh + qb * 128 + rgi * 32 + r32) * 128 + comp * 64;
    bf16x8 qr[4];
#pragma unroll
    for (int d0 = 0; d0 < 4; ++d0) qr[d0] = *(const bf16x8*)(Qp + d0 * 16 + hi * 8);
    const bf16_t* Kg = (const bf16_t*)(ws + WS_DK) + bh * 128 + ksrc_off(wid, lane);
    int koff[4]; kread_offs(koff, r32, hi);
    const bf16_t* Vg = (const bf16_t*)(ws + WS_DV) + bh * 128 + (size_t)(16 * (wid & 3) + (lane >> 2)) * 128 + (wid >> 2) * 32 + (lane & 3) * 8;
    LAS float* wsf = (LAS float*)(L + DF_WSF) + wid * 32;
    const int NT = 2 * qb + 2;
    Flash<4> F; F.reset();
    auto dmaK = [&](int t, int s) { const bf16_t* src = Kg + (size_t)t * 4096; LAS unsigned char* d = L + s * 16384 + wid * 1024; glds16(src, d); glds16(src + (size_t)S * 64, d + 8192); };
    auto dmaV = [&](int t, int s) { const bf16_t* src = Vg + (size_t)t * 8192; LAS unsigned char* d = L + 49152 + s * 16384 + wid * 1024; glds16(src, d); glds16(src + 64, d + 8192); };
    dmaK(0, 0); dmaV(0, 0); dmaK(1, 1); dmaV(1, 1); if (NT > 2) dmaK(2, 2);
    WAIT_BAR(0);
    f32x16 a0, a1, b0, b1; float ra, rb;
    const int xq = 32 * rgi + r32 - 4 * hi;
    auto cmask = [&](f32x16& c0, f32x16& c1, int t) { const int x = xq - 64 * (t - (NT - 2));
#pragma unroll
        for (int r = 0; r < 16; ++r) { if (ccol(r) > x) c0[r] = -INFINITY; if (ccol(r) + 32 > x) c1[r] = -INFINITY; } };
    qkt(a0, a1, L + comp * 8192, koff, qr);
    if (NT == 2) cmask(a0, a1, 0);
    ra = Flash<4>::rowmax_abs(a0, a1);
    WAIT_BAR(0);
    int s0 = 0, s1 = 1, s2 = 2;
    auto iter = [&](int t, f32x16& c0, f32x16& c1, float& rc, f32x16& n0, f32x16& n1, float& rn, auto next) {
        int nis = 0;
        if (t + 3 < NT) { dmaK(t + 3, s0); nis += 2; }
        if (t + 2 < NT) { dmaV(t + 2, s2); nis += 2; }
        F.decide(rc, true, wsf, r32, hi);
        const LAS unsigned char* Vs = L + 49152 + s0 * 16384;
        u32x4 w0, w1, w2, w3;
        if constexpr (decltype(next)::value) qkt(n0, n1, L + s1 * 16384 + comp * 8192, koff, qr);
        F.exphalf(c0, F.mhat, w0, w1);
        F.pv_half(w0, w1, Vs, lane, hi, 0);
        F.exphalf(c1, F.mhat, w2, w3);
        F.pv_half(w2, w3, Vs, lane, hi, 2);
        if constexpr (decltype(next)::value) { rn = Flash<4>::rowmax_abs(n0, n1); if (t + 1 >= NT - 2) { cmask(n0, n1, t + 1); rn = Flash<4>::rowmax_abs(n0, n1); } }
        wait_bar_n(nis);
        const int tmp = s0; s0 = s1; s1 = s2; s2 = tmp;
    };
    int t = 0;
    for (; t < NT - 2; t += 2) { iter(t, a0, a1, ra, b0, b1, rb, TrueC{}); iter(t + 1, b0, b1, rb, a0, a1, ra, TrueC{}); }
    iter(NT - 2, a0, a1, ra, b0, b1, rb, TrueC{});
    iter(NT - 1, b0, b1, rb, a0, a1, ra, FalseC{});
    const float lt = F.ltot();
    float fr_[16];
    row_bcast((comp ? lam : 1.f) / lt, fr_, wsf, r32, hi);
    LAS float* stg = (LAS float*)(L + DF_STAGE) + rgi * 32 * 132;
    if (comp == 1) {
#pragma unroll
        for (int d = 0; d < 4; ++d)
#pragma unroll
            for (int r = 0; r < 16; ++r) stg[crow(r, hi) * 132 + d * 32 + r32] = F.o[d][r] * fr_[r];
    }
    __syncthreads();
    if (comp == 0) {
#pragma unroll
        for (int d = 0; d < 4; ++d)
#pragma unroll
            for (int r = 0; r < 16; ++r) { const int ix = crow(r, hi) * 132 + d * 32 + r32; stg[ix] = F.o[d][r] * fr_[r] - stg[ix]; }
        asm volatile("s_waitcnt lgkmcnt(0)" ::: "memory");
        const LAS float* rowp = stg + r32 * 132 + 64 * hi;
        float ss = 0.f;
#pragma unroll
        for (int k = 0; k < 16; ++k) { const f32x4 v = *(const LAS f32x4*)(rowp + 4 * k); ss += (v[0] * v[0] + v[1] * v[1]) + (v[2] * v[2] + v[3] * v[3]); }
        ss = xor32_sum(ss);
        const float rstd = rsqrtf(ss * (1.f / 128.f) + EPS) * (1.f - LAM_INIT);
        bf16_t* Yp = (bf16_t*)(ws + WS_YA) + ((size_t)b * S + qb * 128 + rgi * 32 + r32) * 512 + h * 128 + 64 * hi;
#pragma unroll
        for (int k = 0; k < 8; ++k) { const f32x4 v0 = *(const LAS f32x4*)(rowp + 8 * k), v1 = *(const LAS f32x4*)(rowp + 8 * k + 4);
            const f32x4 g0 = *(const f32x4*)(subg + 64 * hi + 8 * k), g1 = *(const f32x4*)(subg + 64 * hi + 8 * k + 4);
            u32x4 w; w.x = cvtpk(v0[0] * rstd * g0[0], v0[1] * rstd * g0[1]); w.y = cvtpk(v0[2] * rstd * g0[2], v0[3] * rstd * g0[3]);
            w.z = cvtpk(v1[0] * rstd * g1[0], v1[1] * rstd * g1[1]); w.w = cvtpk(v1[2] * rstd * g1[2], v1[3] * rstd * g1[3]);
            *(u32x4*)(Yp + 8 * k) = w; }
    }
    __syncthreads();
}

constexpr int NS_CMP = 49152;
constexpr int NS_GL = 114688;
constexpr int NS_WSF = 147456;
template <int MODE>
__device__ __forceinline__ void nsa_kv_pass(LAS unsigned char* L, Flash<2>& F, const bf16x8* qr, const int (&koff)[4], const bf16_t* Kg0, const bf16_t* Vg0, int jlo, int jhi, int qblk, int ql, unsigned long long mymask,
                                            LAS float* wsf, int wid, int lane, int r32, int hi) {
    auto dmaK = [&](int j, int s) { glds16(Kg0 + (size_t)j * 4096, L + s * 8192 + wid * 1024); };
    auto dmaV = [&](int j, int s) { glds16(Vg0 + (size_t)j * 4096, L + 24576 + s * 8192 + wid * 1024); };
    dmaK(jlo, 0); dmaV(jlo, 0); if (jlo + 1 <= jhi) { dmaK(jlo + 1, 1); dmaV(jlo + 1, 1); } if (jlo + 2 <= jhi) dmaK(jlo + 2, 2);
    WAIT_BAR(0);
    f32x16 a0, a1, b0, b1; float ra, rb;
    const int xq = ql - 4 * hi;
    auto masked = [&](int j) { return MODE == 1 ? (j == qblk) : (j == qblk || j == qblk - 8); };
    auto amask = [&](f32x16& c0, f32x16& c1, int j) {
        if (MODE == 1) {
#pragma unroll
            for (int r = 0; r < 16; ++r) { if (ccol(r) > xq) c0[r] = -INFINITY; if (ccol(r) + 32 > xq) c1[r] = -INFINITY; }
        } else { const int base = 64 * (qblk - j) + xq;
#pragma unroll
            for (int r = 0; r < 16; ++r) { if ((unsigned)(base - ccol(r)) >= 512u) c0[r] = -INFINITY; if ((unsigned)(base - ccol(r) - 32) >= 512u) c1[r] = -INFINITY; } } };
    qkt(a0, a1, L, koff, qr);
    if (masked(jlo)) amask(a0, a1, jlo);
    ra = Flash<2>::rowmax_abs(a0, a1);
    WAIT_BAR(0);
    int s0 = 0, s1 = 1, s2 = 2;
    auto iter = [&](int j, f32x16& c0, f32x16& c1, float& rc, f32x16& n0, f32x16& n1, float& rn, auto next) {
        int nis = 0;
        if (j + 3 <= jhi) { dmaK(j + 3, s0); nis += 1; }
        if (j + 2 <= jhi) { dmaV(j + 2, s2); nis += 1; }
        const bool rowvalid = (MODE == 1) ? (bool)((mymask >> j) & 1ull) : true;
        F.decide(rc, rowvalid, wsf, r32, hi);
        const float mm = rowvalid ? F.mhat : INFINITY;
        const LAS unsigned char* Vs = L + 24576 + s0 * 8192;
        u32x4 w0, w1, w2, w3;
        if constexpr (decltype(next)::value) qkt(n0, n1, L + s1 * 8192, koff, qr);
        F.exphalf(c0, mm, w0, w1);
        F.pv_half(w0, w1, Vs, lane, hi, 0);
        F.exphalf(c1, mm, w2, w3);
        F.pv_half(w2, w3, Vs, lane, hi, 2);
        if constexpr (decltype(next)::value) { rn = Flash<2>::rowmax_abs(n0, n1); if (masked(j + 1)) { amask(n0, n1, j + 1); rn = Flash<2>::rowmax_abs(n0, n1); } }
        wait_bar_n(nis);
        const int tmp = s0; s0 = s1; s1 = s2; s2 = tmp;
    };
    int j = jlo;
    for (; j + 2 <= jhi; j += 2) { iter(j, a0, a1, ra, b0, b1, rb, TrueC{}); iter(j + 1, b0, b1, rb, a0, a1, ra, TrueC{}); }
    if (j < jhi) { iter(j, a0, a1, ra, b0, b1, rb, TrueC{}); iter(jhi, b0, b1, rb, a0, a1, ra, FalseC{}); }
    else iter(jhi, a0, a1, ra, b0, b1, rb, FalseC{});
}
__device__ __forceinline__ void nsa_unit(LAS unsigned char* L, int b, int g, int qblk, const unsigned char* ws, int wv) {
    int tid_ = wv * 64 + lane_id(); asm volatile("" : "+v"(tid_));
    const int tid = tid_, lane = tid & 63, r32 = lane & 31, hi = lane >> 5, wid = __builtin_amdgcn_readfirstlane(tid >> 6);
    const int ql = 8 * wid + (r32 & 7), hh = r32 >> 3, head = g * 4 + hh;
    const int qpos = 64 * qblk + ql;
    const size_t tok = (size_t)b * S + qpos;
    const bf16_t* Qp = (const bf16_t*)(ws + WS_NQ) + ((size_t)(b * 8 + head) * S + qpos) * 64;
    bf16x8 qr[4];
#pragma unroll
    for (int d0 = 0; d0 < 4; ++d0) qr[d0] = *(const bf16x8*)(Qp + d0 * 16 + hi * 8);
    const float* NGp = (const float*)(ws + WS_NG) + tok * 24 + head;
    const float g0 = NGp[0], g1 = NGp[8], g2 = NGp[16];
    LAS float* wsf = (LAS float*)(L + NS_WSF) + wid * 32;
    const size_t pg = (size_t)(b * 2 + g);
    LAS float* yst = (LAS float*)(L + NS_CMP) + wid * 2048;
    float fr_[16];
    unsigned long long mymask = 0ull;
    int koff[4]; kread_offs(koff, r32, hi);
    {
        const int ntc = ((4 * qblk + 2) >> 6) + 1;
        const bf16_t* Kc = (const bf16_t*)(ws + WS_KCMP) + pg * 256 * 64 + ksrc_off(wid, lane);
        const bf16_t* Vc = (const bf16_t*)(ws + WS_VCMP) + (pg * 256 + 16 * (wid & 3) + (lane >> 2)) * 64 + (wid >> 2) * 32 + (lane & 3) * 8;
        for (int ct = 0; ct < ntc; ++ct) { glds16(Kc + (size_t)ct * 4096, L + NS_CMP + ct * 8192 + wid * 1024); glds16(Vc + (size_t)ct * 4096, L + NS_CMP + 32768 + ct * 8192 + wid * 1024); }
        VM_DRAIN_SYNC();
        const int cm = (qpos >= 31) ? ((qpos - 31) >> 4) : -1;
        Flash<2> F; F.reset();
        for (int ct = 0; ct < ntc; ++ct) {
            f32x16 p0, p1;
            qkt(p0, p1, L + NS_CMP + ct * 8192, koff, qr);
            const int x = cm - 64 * ct - 4 * hi;
#pragma unroll
            for (int r = 0; r < 16; ++r) { if (ccol(r) > x) p0[r] = -INFINITY; if (ccol(r) + 32 > x) p1[r] = -INFINITY; }
            F.tile(p0, p1, L + NS_CMP + 32768 + ct * 8192, wsf, lane, r32, hi);
        }
        const float lt = F.ltot();
        const float il = lt > 0.f ? 1.f / lt : 0.f;
        LAS float* Gs = (LAS float*)(L + NS_GL) + wid * 1024;
        LAS float* Ls = Gs + 512;
        for (int ct = 0; ct < ntc; ++ct) {
            f32x16 p0, p1;
            qkt(p0, p1, L + NS_CMP + ct * 8192, koff, qr);
            const int x = cm - 64 * ct - 4 * hi;
#pragma unroll
            for (int r = 0; r < 16; ++r) {
                float a = (ccol(r) > x) ? 0.f : __builtin_amdgcn_exp2f(p0[r] - F.mhat) * il, bq = (ccol(r) + 32 > x) ? 0.f : __builtin_amdgcn_exp2f(p1[r] - F.mhat) * il;
                a += __shfl_xor(a, 8); a += __shfl_xor(a, 16); bq += __shfl_xor(bq, 8); bq += __shfl_xor(bq, 16);
                p0[r] = a; p1[r] = bq; }
            if (r32 < 8) {
#pragma unroll
                for (int k = 0; k < 4; ++k) { const int jj = 16 * ct + 2 * k + hi;
                    Gs[r32 * 64 + jj] = (p0[4 * k] + p0[4 * k + 1]) + (p0[4 * k + 2] + p0[4 * k + 3]); Ls[r32 * 64 + jj] = p0[4 * k + 3];
                    Gs[r32 * 64 + jj + 8] = (p1[4 * k] + p1[4 * k + 1]) + (p1[4 * k + 2] + p1[4 * k + 3]); Ls[r32 * 64 + jj + 8] = p1[4 * k + 3]; }
            }
        }
        asm volatile("s_waitcnt lgkmcnt(0)" ::: "memory");
        const int j = lane, jmax = 16 * ntc;
        for (int qi = 0; qi < 8; ++qi) {
            float v = (j < jmax) ? Gs[qi * 64 + j] : 0.f;
            if (j >= 1 && j - 1 < jmax) v += Ls[qi * 64 + j - 1];
            if (j == 0 || j == qblk || j == qblk - 1) v = 1e9f;
            if (j > qblk) v = -1e30f;
            unsigned key = __float_as_uint(v); key = (key & 0x80000000u) ? ~key : (key | 0x80000000u);
            unsigned long long C = ~0ull; int kk = 16;
            for (int bit = 31; bit >= 0; --bit) {
                const unsigned long long bs = __ballot((key >> bit) & 1u) & C;
                const int c1 = __popcll(bs);
                if (c1 >= kk) C = bs; else { kk -= c1; C &= ~bs; }
            }
            const unsigned Tk = (unsigned)__builtin_amdgcn_readlane((int)key, (int)__builtin_ctzll(C));
            unsigned long long selm = __ballot(key > Tk);
            for (int i = 0; i < kk; ++i) { const unsigned long long low = C & (0ull - C); selm |= low; C ^= low; }
            const unsigned long long m = selm & ((qblk >= 63) ? ~0ull : ((1ull << (qblk + 1)) - 1ull));
            if ((r32 & 7) == qi) mymask = m;
        }
        asm volatile("s_waitcnt lgkmcnt(0)" ::: "memory");
        __syncthreads();
        row_bcast(g0 * il, fr_, wsf, r32, hi);
#pragma unroll
        for (int d = 0; d < 2; ++d)
#pragma unroll
            for (int r = 0; r < 16; ++r) yst[crow(r, hi) * 64 + d * 32 + r32] = F.o[d][r] * fr_[r];
    }
    const size_t ksrc = pg * S * 64 + ksrc_off(wid, lane);
    const size_t voff = (pg * S + 16 * (wid & 3) + (lane >> 2)) * 64 + (wid >> 2) * 32 + (lane & 3) * 8;
    {
        Flash<2> F; F.reset();
        nsa_kv_pass<1>(L, F, qr, koff, (const bf16_t*)(ws + WS_KS) + ksrc, (const bf16_t*)(ws + WS_VS) + voff, 0, qblk, qblk, ql, mymask, wsf, wid, lane, r32, hi);
        const float lt = F.ltot();
        row_bcast(g1 / lt, fr_, wsf, r32, hi);
#pragma unroll
        for (int d = 0; d < 2; ++d)
#pragma unroll
            for (int r = 0; r < 16; ++r) yst[crow(r, hi) * 64 + d * 32 + r32] += F.o[d][r] * fr_[r];
    }
    {
        Flash<2> F; F.reset();
        const int jlo = qblk >= 8 ? qblk - 8 : 0;
        nsa_kv_pass<2>(L, F, qr, koff, (const bf16_t*)(ws + WS_KW) + ksrc, (const bf16_t*)(ws + WS_VW) + voff, jlo, qblk, qblk, ql, 0ull, wsf, wid, lane, r32, hi);
        const float lt = F.ltot();
        row_bcast(g2 / lt, fr_, wsf, r32, hi);
        LAS bf16_t* stg = (LAS bf16_t*)(L + NS_GL) + wid * 2048;
#pragma unroll
        for (int r = 0; r < 16; ++r) { const int orow = crow(r, hi);
#pragma unroll
            for (int d = 0; d < 2; ++d) { const float yv = yst[orow * 64 + d * 32 + r32] + F.o[d][r] * fr_[r]; stg[orow * 64 + d * 32 + r32] = (bf16_t)(cvtpk(yv, 0.f) & 0xffffu); } }
        asm volatile("s_waitcnt lgkmcnt(0)" ::: "memory");
        bf16_t* Yb = (bf16_t*)(ws + WS_YB);
#pragma unroll
        for (int i = 0; i < 4; ++i) { const int row = i * 8 + (lane >> 3), ch = lane & 7; const u32x4 v = *(const LAS u32x4*)(stg + row * 64 + ch * 8);
            *(u32x4*)(Yb + ((size_t)b * S + 64 * qblk + 8 * wid + (row & 7)) * 512 + (g * 4 + (row >> 3)) * 64 + ch * 8) = v; }
    }
    __syncthreads();
}

#define XB_TMO      128
#define XB_XCNT(j)  (256  + 64 * (j))
#define XB_XSUB(j)  (1280 + 64 * (j))
#define XB_XGEN(j)  (2304 + 64 * (j))
#define XB_TOP      3328
#define XB_TOPGEN   3392
#define XCD_BAR_WORDS 3456
#define XB_SPIN_CAP (1u << 18)

__device__ __forceinline__ unsigned xb_ld(unsigned* p)              { return __hip_atomic_load(p, __ATOMIC_RELAXED, __HIP_MEMORY_SCOPE_AGENT); }
__device__ __forceinline__ unsigned xb_add(unsigned* p, unsigned v) { return __hip_atomic_fetch_add(p, v, __ATOMIC_RELAXED, __HIP_MEMORY_SCOPE_AGENT); }
__device__ __forceinline__ unsigned xb_xcc_id() { return (unsigned)__builtin_amdgcn_s_getreg((3 << 11) | 20) & 0xFu; }
#define XB_SPIN(cond, bar) do { unsigned _sp = 0; while (cond) { __builtin_amdgcn_s_sleep(1); \
    if ((++_sp & 255u) == 0u) { if (xb_ld(&(bar)[XB_TMO])) break; if (_sp > XB_SPIN_CAP) { atomicAdd(&(bar)[XB_TMO], 1u); break; } } } } while (0)

struct XcdBarrier {
    unsigned* bar; unsigned x;
    volatile LAS unsigned* st;
    bool lead;
};

__device__ __forceinline__ XcdBarrier xcd_barrier_post(unsigned* bar, volatile LAS unsigned* st, bool lead) {
    XcdBarrier b; b.bar = bar; b.x = xb_xcc_id(); b.st = st; b.lead = lead;
    if (b.lead && lane_id() == 0) (void)xb_add(&bar[XB_XCNT(b.x)], 1u);
    return b;
}
__device__ __forceinline__ void xcd_barrier_complete(unsigned* bar, unsigned x, unsigned& nloc, unsigned& nx) {
    const unsigned G = gridDim.x * gridDim.y * gridDim.z;
    unsigned sum, cnt, mine, sp = 0u;
    for (;;) {
        sum = 0u; cnt = 0u; mine = 0u;
#pragma unroll
        for (unsigned j = 0; j < 16; ++j) { const unsigned c = xb_ld(&bar[XB_XCNT(j)]); sum += c; cnt += (c > 0u) ? 1u : 0u; mine = (j == x) ? c : mine; }
        if (sum == G) break;
        __builtin_amdgcn_s_sleep(1);
        if ((++sp & 255u) == 0u) { if (xb_ld(&bar[XB_TMO])) break; if (sp > XB_SPIN_CAP) { atomicAdd(&bar[XB_TMO], 1u); break; } }
    }
    nloc = mine > 0u ? mine : 1u; nx = cnt > 0u ? cnt : 1u;
}

__device__ __forceinline__ void xcd_barrier(const XcdBarrier& b) {
    asm volatile("s_waitcnt vmcnt(0)" ::: "memory");
    __syncthreads();
    if (b.lead && lane_id() == 0) {
        unsigned* bar = b.bar;
        __builtin_amdgcn_s_waitcnt(0);
        unsigned nloc = b.st[0], nx = b.st[1];
        if (nloc == 0u) { xcd_barrier_complete(bar, b.x, nloc, nx); b.st[0] = nloc; b.st[1] = nx; }
        const unsigned old = xb_add(&bar[XB_XSUB(b.x)], 1u);
        const unsigned gen = old / nloc;
        if (old + 1u == (gen + 1u) * nloc) {
            __builtin_amdgcn_fence(__ATOMIC_RELEASE, "agent");
            asm volatile("s_waitcnt vmcnt(0)" ::: "memory");
            const unsigned og = xb_add(&bar[XB_TOP], 1u);
            const unsigned tg = og / nx;
            if (og + 1u == (tg + 1u) * nx) xb_add(&bar[XB_TOPGEN], 1u);
            else XB_SPIN(xb_ld(&bar[XB_TOPGEN]) == tg, bar);
            __builtin_amdgcn_fence(__ATOMIC_ACQUIRE, "agent");
            xb_add(&bar[XB_XGEN(b.x)], 1u);
            asm volatile("s_waitcnt vmcnt(0)" ::: "memory");
        } else {
            XB_SPIN(xb_ld(&bar[XB_XGEN(b.x)]) == gen, bar);
            __builtin_amdgcn_fence(__ATOMIC_ACQUIRE, "agent");
            asm volatile("s_waitcnt vmcnt(0)" ::: "memory");
        }
    }
    __syncthreads();
}


template <class MapF>
__device__ __forceinline__ void tr_item(const float* W, int K, int N, int ldw, bf16_t* WT, const float* kscale, LAS float* scr, int item, int lane, const MapF& map) {
    const int nblk = (N + 31) / 32, kb = item / nblk, nb = item % nblk, k0 = 64 * kb, n0 = 32 * nb;
    const int nn = n0 + (lane & 31);
#pragma unroll 8
    for (int i = 0; i < 32; ++i) { const int kk = 2 * i + (lane >> 5); float v = (nn < N) ? W[(size_t)(k0 + kk) * ldw + nn] : 0.f; if (kscale) v *= kscale[k0 + kk]; scr[kk * 33 + (lane & 31)] = v; }
    asm volatile("s_waitcnt lgkmcnt(0)" ::: "memory");
    const int c = lane & 7;
#pragma unroll
    for (int jx = 0; jx < 4; ++jx) { const int n = (lane >> 3) + 8 * jx; const LAS float* s = scr + (8 * c) * 33 + n;
        u32x4 o; o.x = cvtpk(s[0 * 33], s[1 * 33]); o.y = cvtpk(s[2 * 33], s[3 * 33]); o.z = cvtpk(s[4 * 33], s[5 * 33]); o.w = cvtpk(s[6 * 33], s[7 * 33]);
        if (n0 + n < N) *(u32x4*)(WT + (size_t)map(n0 + n) * K + k0 + 8 * c) = o; }
    asm volatile("s_waitcnt lgkmcnt(0)" ::: "memory");
}
__device__ __forceinline__ int rope_pos(int d) { return d < 32 ? 8 * (d >> 2) + (d & 3) : 8 * ((d - 32) >> 2) + 4 + (d & 3); }
struct MapIn {
    __device__ __forceinline__ int operator()(int n) const {
        if (n >= 2840) return 2816 + (n - 2840);
        if (n >= 2816) return 4864 + (n - 2816);
        bool rope;
        if (n < 1024) rope = true; else if (n < 1536) rope = false; else if (n < 2048) rope = true; else rope = (((n - 2048) >> 7) & 1) == 0;
        return rope ? (n & ~63) + rope_pos(n & 63) : n;
    }
};
struct MapId { int off; __device__ __forceinline__ int operator()(int n) const { return off + n; } };
struct MapGU { int up; __device__ __forceinline__ int operator()(int f) const { return 8 * (f >> 2) + 4 * up + (f & 3); } };

__device__ __forceinline__ int queue_fetch(unsigned* qbase, unsigned x, LAS int* kstate) {
    int k = *kstate;
    while (k < 8) { const unsigned q = (x + (unsigned)k) & 7u; const unsigned li = atomicAdd(qbase + 64 * q, 1u); if (li < 128u) { *kstate = k; return (int)(q * 128u + li); } ++k; }
    *kstate = k; return -1;
}
struct Args { const void* in[20]; float* out; unsigned char* ws; int use_cg; int pad; };

__global__ void __launch_bounds__(512, 2) hybrid_fwd(Args args) {
    extern __shared__ __attribute__((aligned(16))) unsigned char lds_raw[];
    LAS unsigned char* L = (LAS unsigned char*)lds_raw;
    cg::grid_group grid = cg::this_grid();
    const int wave_s = __builtin_amdgcn_readfirstlane((int)(threadIdx.x >> 6));
#define PHASE_IDS() int tid_ = wave_s * 64 + lane_id(); asm volatile("" : "+v"(tid_)); const int tid = tid_, lane = tid & 63, wave = __builtin_amdgcn_readfirstlane(tid >> 6); (void)lane; (void)wave
    const int G = gridDim.x, bx = blockIdx.x;
    unsigned char* ws = args.ws;
    const float* x = (const float*)args.in[0];
    const int* positions = (const int*)args.in[1];
    float* out = args.out;
    unsigned* ctl = (unsigned*)(ws + WS_CTL);
    LAS int* misc = (LAS int*)(L + LDS_BYTES - 64);
    { const int t0 = wave_s * 64 + lane_id(); if (t0 < 16) misc[t0] = 0; }
    __syncthreads();
    const XcdBarrier xbar = xcd_barrier_post(ctl + 4096, (volatile LAS unsigned*)(misc + 8), wave_s == 0);

    {
        PHASE_IDS();
        LAS float* scr = (LAS float*)(L + wave * 16384);
        const int gw = bx * 8 + wave, NGW = G * 8;
        const float* g1 = (const float*)args.in[2]; const float* g2 = (const float*)args.in[15];
        constexpr int I_IN = 16 * 153, I_G = 16 * 88, I_D = 44 * 32, I_O = 16 * 32, I_A = 8 * 32, I_C = 16 * 8;
        constexpr int NIT = I_IN + 2 * I_G + I_D + I_O + 2 * I_A + 4 * I_C;
        for (int it = gw; it < NIT; it += NGW) {
            int r = it;
            if (r < I_IN) { tr_item((const float*)args.in[3], 1024, 4888, 4888, (bf16_t*)(ws + WS_WIN), g1, scr, r, lane, MapIn{}); continue; } r -= I_IN;
            if (r < I_G) { tr_item((const float*)args.in[16], 1024, FF, FF, (bf16_t*)(ws + WS_WGU), g2, scr, r, lane, MapGU{0}); continue; } r -= I_G;
            if (r < I_G) { tr_item((const float*)args.in[17], 1024, FF, FF, (bf16_t*)(ws + WS_WGU), g2, scr, r, lane, MapGU{1}); continue; } r -= I_G;
            if (r < I_D) { tr_item((const float*)args.in[18], FF, 1024, 1024, (bf16_t*)(ws + WS_WD), nullptr, scr, r, lane, MapId{0}); continue; } r -= I_D;
            if (r < I_O) { tr_item((const float*)args.in[14], 1024, 1024, 1024, (bf16_t*)(ws + WS_WO), nullptr, scr, r, lane, MapId{0}); continue; } r -= I_O;
            if (r < I_A) { tr_item((const float*)args.in[12], 512, 1024, 1024, (bf16_t*)(ws + WS_WA), nullptr, scr, r, lane, MapId{0}); continue; } r -= I_A;
            if (r < I_A) { tr_item((const float*)args.in[13], 512, 1024, 1024, (bf16_t*)(ws + WS_WB), nullptr, scr, r, lane, MapId{0}); continue; } r -= I_A;
            if (r < I_C) { tr_item((const float*)args.in[8], 1024, 256, 256, (bf16_t*)(ws + WS_W1K), nullptr, scr, r, lane, MapId{0}); continue; } r -= I_C;
            if (r < I_C) { tr_item((const float*)args.in[8] + 1024 * 256, 1024, 256, 256, (bf16_t*)(ws + WS_W1K), nullptr, scr, r, lane, MapId{256}); continue; } r -= I_C;
            if (r < I_C) { tr_item((const float*)args.in[10], 1024, 256, 256, (bf16_t*)(ws + WS_W1V), nullptr, scr, r, lane, MapId{0}); continue; } r -= I_C;
            tr_item((const float*)args.in[10] + 1024 * 256, 1024, 256, 256, (bf16_t*)(ws + WS_W1V), nullptr, scr, r, lane, MapId{256});
        }
        bf16_t* XB = (bf16_t*)(ws + WS_XB); float* rs1 = (float*)(ws + WS_RS1);
        float* cosT = (float*)(ws + WS_COS); float* sinT = (float*)(ws + WS_SIN);
        const float invf = 1.0f / powf(10000.0f, (float)(2 * (lane & 31)) / 64.0f);
        for (int m = gw; m < T; m += NGW) {
            const f32x4* xr = (const f32x4*)(x + (size_t)m * D) + lane;
            f32x4 v[4]; float s = 0.f;
#pragma unroll
            for (int jx = 0; jx < 4; ++jx) { v[jx] = xr[64 * jx]; s += (v[jx][0] * v[jx][0] + v[jx][1] * v[jx][1]) + (v[jx][2] * v[jx][2] + v[jx][3] * v[jx][3]); }
            s = wave_sum(s);
            if (lane == 0) rs1[m] = rsqrtf(s * (1.f / D) + EPS);
            u32x2* o8 = (u32x2*)(XB + (size_t)m * D) + lane;
#pragma unroll
            for (int jx = 0; jx < 4; ++jx) { u32x2 w; w.x = cvtpk(v[jx][0], v[jx][1]); w.y = cvtpk(v[jx][2], v[jx][3]); o8[64 * jx] = w; }
            const float ang = (float)positions[m] * invf;
            if (lane < 32) cosT[(size_t)m * 32 + lane] = cosf(ang); else sinT[(size_t)m * 32 + (lane - 32)] = sinf(ang);
        }
        if (bx < 32) {
            const int kv = bx >> 4, slab = bx & 15;
            const float* pe = (const float*)args.in[kv ? 7 : 6]; const float* W1 = (const float*)args.in[kv ? 10 : 8];
            const int n = tid & 255, half = tid >> 8; float acc = 0.f;
            for (int k = slab * 128 + half * 64; k < slab * 128 + half * 64 + 64; ++k) acc += pe[k] * W1[(size_t)k * 256 + n];
            __syncthreads();
            LAS float* red = (LAS float*)L;
            if (half) red[n] = acc;
            __syncthreads();
            if (!half) ((float*)(ws + WS_BIASP))[(kv * 16 + slab) * 256 + n] = acc + red[n];
            __syncthreads();
        }
    }
    if (args.use_cg) grid.sync(); else xcd_barrier(xbar);
    {
        pg8::Gemm g{(const bf16_t*)(ws + WS_XB), (const bf16_t*)(ws + WS_WIN), T, INP, D}; pg8::StaticOrder SO; SO.init(T, INP, G, bx);
        EpiProj E{(const float*)(ws + WS_RS1), (const float*)(ws + WS_COS), (const float*)(ws + WS_SIN), ws};
        pg8::gemm_phase<EpiProj, true>(L, g, SO, E, wave_s);
    }
    xcd_barrier(xbar);
    {
        PHASE_IDS();
        { pg8::Gemm g{(const bf16_t*)(ws + WS_KC), (const bf16_t*)(ws + WS_W1K), 4096, 512, 1024}; pg8::StaticOrder SO; SO.init(4096, 512, G, bx);
          EpiF32 E{(float*)(ws + WS_GK), 512}; pg8::gemm_phase<EpiF32, true>(L, g, SO, E, wave_s); }
        { pg8::Gemm g{(const bf16_t*)(ws + WS_VC), (const bf16_t*)(ws + WS_W1V), 4096, 512, 1024}; pg8::StaticOrder SO; SO.init(4096, 512, G, (bx + G - 32) % G);
          EpiF32 E{(float*)(ws + WS_GV), 512}; pg8::gemm_phase<EpiF32, true>(L, g, SO, E, wave_s); }
        __syncthreads();
        const float* lf = (const float*)args.in[4];
        float sa = 0.f, sb = 0.f;
        for (int d = 0; d < 64; ++d) { sa += lf[d] * lf[64 + d]; sb += lf[128 + d] * lf[192 + d]; }
        const float lam = __uint_as_float((unsigned)__builtin_amdgcn_readfirstlane((int)__float_as_uint(expf(sa) - expf(sb) + LAM_INIT)));
        if (wave_s == 0 && lane_id() == 0) misc[1] = 0;
        for (;;) {
            if (wave_s == 0 && lane_id() == 0) misc[0] = queue_fetch(ctl + 512, xbar.x & 7u, misc + 1);
            __syncthreads();
            const int idx = misc[0];
            __syncthreads();
            if (idx < 0) break;
            const int li = idx & 127, qb = 31 - (li >> 2), bh = (idx >> 7) * 4 + (li & 3);
            diff_unit(L, bh >> 2, bh & 3, qb, ws, lam, (const float*)args.in[5], wave_s);
        }
    }
    xcd_barrier(xbar);
    {
        PHASE_IDS();
        LAS float* hid = (LAS float*)L;
        LAS float* bias = hid + 4096;
        for (int un = bx; un < 512; un += G) {
            const int kv = un >> 8, p = (un >> 4) & 15, rb = un & 15;
            const float* Gm = (const float*)(ws + (kv ? WS_GV : WS_GK));
            const float* w2 = (const float*)args.in[kv ? 11 : 9];
            if (tid < 256) { float a = 0.f; const float* bp = (const float*)(ws + WS_BIASP) + kv * 16 * 256 + tid;
#pragma unroll
                for (int s = 0; s < 16; ++s) a += bp[s * 256]; bias[tid] = a; }
            __syncthreads();
#pragma unroll
            for (int i = 0; i < 8; ++i) { const int e = tid + 512 * i, r = e >> 8, k = e & 255, c = 16 * rb + r; const size_t R = (size_t)p * 256 + c;
                float v = Gm[R * 512 + k] + bias[k]; if (c < 255) v += Gm[(R + 1) * 512 + 256 + k];
                hid[r * 256 + k] = v / (1.f + __expf(-v)); }
            __syncthreads();
            const int d = tid & 63, r0 = tid >> 6; float a0 = 0.f, a1 = 0.f;
#pragma unroll 8
            for (int k = 0; k < 256; ++k) { const float w = w2[k * 64 + d]; a0 += hid[r0 * 256 + k] * w; a1 += hid[(r0 + 8) * 256 + k] * w; }
            bf16_t* O = (bf16_t*)(ws + (kv ? WS_VCMP : WS_KCMP)) + ((size_t)p * 256 + 16 * rb) * 64;
            O[r0 * 64 + d] = (bf16_t)(cvtpk(a0, 0.f) & 0xffffu); O[(r0 + 8) * 64 + d] = (bf16_t)(cvtpk(a1, 0.f) & 0xffffu);
            __syncthreads();
        }
    }
    xcd_barrier(xbar);
    {
        PHASE_IDS();
        if (wave_s == 0 && lane_id() == 0) misc[1] = 0;
        for (;;) {
            if (wave_s == 0 && lane_id() == 0) misc[0] = queue_fetch(ctl + 1024, xbar.x & 7u, misc + 1);
            __syncthreads();
            const int idx = misc[0];
            __syncthreads();
            if (idx < 0) break;
            const int li = idx & 127, qblk = 63 - (li >> 1), pgx = (idx >> 7) * 2 + (li & 1);
            nsa_unit(L, pgx >> 1, pgx & 1, qblk, ws, wave_s);
        }
    }
    xcd_barrier(xbar);
    {
        { pg8::Gemm g{(const bf16_t*)(ws + WS_YA), (const bf16_t*)(ws + WS_WA), T, D, 512}; pg8::StaticOrder SO; SO.init(T, D, G, bx);
          EpiBranch<false> E{(bf16_t*)(ws + WS_XB), (const bf16_t*)(ws + WS_MG)}; pg8::gemm_phase<EpiBranch<false>, true>(L, g, SO, E, wave_s); }
        __syncthreads();
        { pg8::Gemm g{(const bf16_t*)(ws + WS_YB), (const bf16_t*)(ws + WS_WB), T, D, 512}; pg8::StaticOrder SO; SO.init(T, D, G, bx);
          EpiBranch<true> E{(bf16_t*)(ws + WS_XB), (const bf16_t*)(ws + WS_MG)}; pg8::gemm_phase<EpiBranch<true>, true>(L, g, SO, E, wave_s); }
    }
    xcd_barrier(xbar);
    {
        pg8::Gemm g{(const bf16_t*)(ws + WS_XB), (const bf16_t*)(ws + WS_WO), T, D, D}; pg8::StaticOrder SO; SO.init(T, D, G, bx);
        EpiResid<true> E{x, out, (bf16_t*)(ws + WS_YA), (float*)(ws + WS_SSQ2)};
        pg8::gemm_phase<EpiResid<true>, true>(L, g, SO, E, wave_s);
    }
    xcd_barrier(xbar);
    {
        pg8::Gemm g{(const bf16_t*)(ws + WS_YA), (const bf16_t*)(ws + WS_WGU), T, FF2, D}; pg8::StaticOrder SO; SO.init(T, FF2, G, bx);
        EpiGU E{(const float*)(ws + WS_SSQ2), (bf16_t*)(ws + WS_ACT)};
        pg8::gemm_phase<EpiGU, true>(L, g, SO, E, wave_s);
    }
    xcd_barrier(xbar);
    {
        pg8::Gemm g{(const bf16_t*)(ws + WS_ACT), (const bf16_t*)(ws + WS_WD), T, D, FF}; pg8::StaticOrder SO; SO.init(T, D, G, bx);
        EpiResid<false> E{out, out, nullptr, (float*)(ws + WS_SSQ3)};
        pg8::gemm_phase<EpiResid<false>, true>(L, g, SO, E, wave_s);
    }
    xcd_barrier(xbar);
    {
        PHASE_IDS();
        const float* gf = (const float*)args.in[19]; const float* SSQ3 = (const float*)(ws + WS_SSQ3);
        const int gw = bx * 8 + wave, NGW = G * 8;
        f32x4 gv[4];
#pragma unroll
        for (int jx = 0; jx < 4; ++jx) gv[jx] = ((const f32x4*)gf)[lane + 64 * jx];
        for (int m = gw; m < T; m += NGW) {
            float s = (lane < 16) ? SSQ3[(size_t)m * 16 + lane] : 0.f;
            s = wave_sum(s);
            const float rs = rsqrtf(s * (1.f / D) + EPS);
            f32x4* xr = (f32x4*)(out + (size_t)m * D) + lane;
#pragma unroll
            for (int jx = 0; jx < 4; ++jx) { f32x4 v = xr[64 * jx]; v = v * rs * gv[jx]; xr[64 * jx] = v; }
        }
    }
}

extern "C" void kernel_launch(void* const* d_in, const int* in_sizes, int n_in, void* d_out, int out_size, void* d_ws, size_t ws_size, hipStream_t stream) {
    static int grid = 0;
    if (grid == 0) {
        if (n_in != 20 || out_size != T * D || ws_size < WS_END) { fprintf(stderr, "kernel_launch: unexpected shapes (n_in %d out %d ws %zu)\n", n_in, out_size, ws_size); grid = -1; return; }
        int dev = 0, cus = 0, per_cu = 0;
        hipGetDevice(&dev);
        hipDeviceGetAttribute(&cus, hipDeviceAttributeMultiprocessorCount, dev);
        hipFuncSetAttribute((const void*)hybrid_fwd, hipFuncAttributeMaxDynamicSharedMemorySize, LDS_BYTES);
        hipOccupancyMaxActiveBlocksPerMultiprocessor(&per_cu, (const void*)hybrid_fwd, 512, LDS_BYTES);
        if (per_cu < 1) { fprintf(stderr, "kernel_launch: occupancy query says %d blocks per CU\n", per_cu); per_cu = 1; }
        (void)hipGetLastError();
        grid = cus * per_cu;
    }
    if (grid < 0) return;
    hipMemsetAsync((char*)d_ws + WS_CTL, 0, 32768, stream);
    Args a{};
    for (int i = 0; i < 20; ++i) a.in[i] = d_in[i];
    a.out = (float*)d_out; a.ws = (unsigned char*)d_ws;
    void* params[] = {&a};
    hipError_t e = hipLaunchCooperativeKernel((const void*)hybrid_fwd, dim3(grid), dim3(512), params, LDS_BYTES, stream);
    if (e != hipSuccess) fprintf(stderr, "cooperative launch failed: %s (grid %d)\n", hipGetErrorString(e), grid);
}
```

```cpp
#include <hip/hip_runtime.h>
#include <hip/hip_cooperative_groups.h>
#include <cstdint>
#include <cstdio>
#include <type_traits>
namespace cg = cooperative_groups;

#define LAS __attribute__((address_space(3)))
typedef unsigned short bf16_t;
typedef short bf16x8 __attribute__((ext_vector_type(8)));
typedef short s16x4 __attribute__((ext_vector_type(4)));
typedef float f32x4 __attribute__((ext_vector_type(4)));
typedef float f32x2 __attribute__((ext_vector_type(2)));
typedef float f32x16 __attribute__((ext_vector_type(16)));
typedef unsigned u32x4 __attribute__((ext_vector_type(4)));
typedef unsigned u32x2 __attribute__((ext_vector_type(2)));
typedef __bf16 bf16x2_t __attribute__((ext_vector_type(2)));

constexpr int NB = 8, S = 4096, T = NB * S, D = 1024, FF = 2816, FF2 = 2 * FF, INP = 5120;
constexpr float EPS = 1e-6f;
constexpr float C2 = 0.125f * 1.4426950408889634f;
constexpr float LAM_INIT = 0.2f;

constexpr size_t MiB = 1u << 20;
constexpr size_t WS_CTL = 0;
constexpr size_t WS_WIN = 1 * MiB, WS_WGU = 11 * MiB, WS_WD = 22 * MiB, WS_WO = 28 * MiB, WS_WA = 30 * MiB, WS_WB = 31 * MiB, WS_W1K = 32 * MiB, WS_W1V = 33 * MiB;
constexpr size_t WS_COS = 34 * MiB, WS_SIN = 38 * MiB;
constexpr size_t WS_RS1 = 42 * MiB, WS_SSQ2 = 43 * MiB, WS_SSQ3 = 45 * MiB, WS_NG = 47 * MiB, WS_BIASP = 50 * MiB;
constexpr size_t WS_GK = 52 * MiB, WS_GV = 60 * MiB, WS_KCMP = 68 * MiB, WS_VCMP = 69 * MiB;
constexpr size_t WS_XB = 70 * MiB;
constexpr size_t WS_DQ = 134 * MiB, WS_DK = 166 * MiB, WS_DV = 198 * MiB, WS_NQ = 230 * MiB;
constexpr size_t WS_KC = 262 * MiB, WS_VC = 270 * MiB, WS_KS = 278 * MiB, WS_VS = 286 * MiB, WS_KW = 294 * MiB, WS_VW = 302 * MiB;
constexpr size_t WS_ACT = 134 * MiB;
constexpr size_t WS_MG = 310 * MiB;
constexpr size_t WS_YA = 438 * MiB, WS_YB = 470 * MiB;
constexpr size_t WS_END = 502 * MiB;
constexpr int LDS_BYTES = 155648;

__device__ __forceinline__ unsigned cvtpk(float lo, float hi) { f32x2 v = {lo, hi}; bf16x2_t b = __builtin_convertvector(v, bf16x2_t); return __builtin_bit_cast(unsigned, b); }
__device__ __forceinline__ float bf2f(unsigned short h) { return __uint_as_float(((unsigned)h) << 16); }
__device__ __forceinline__ float bflo(unsigned w) { return __uint_as_float(w << 16); }
__device__ __forceinline__ float bfhi(unsigned w) { return __uint_as_float(w & 0xffff0000u); }
__device__ __forceinline__ float sigmoidf_(float x) { return 1.f / (1.f + __expf(-x)); }
__device__ __forceinline__ int lane_id() { unsigned z = 0u; asm volatile("" : "+v"(z)); return (int)__builtin_amdgcn_mbcnt_hi(~0u, __builtin_amdgcn_mbcnt_lo(~0u, z)); }
__device__ __forceinline__ float xor32_sum(float v) { auto rr = __builtin_amdgcn_permlane32_swap(__float_as_uint(v), __float_as_uint(v), false, false); return __uint_as_float(rr[0]) + __uint_as_float(rr[1]); }
__device__ __forceinline__ float xor32_max(float v) { auto rr = __builtin_amdgcn_permlane32_swap(__float_as_uint(v), __float_as_uint(v), false, false); return __builtin_fmaxf(__uint_as_float(rr[0]), __uint_as_float(rr[1])); }
__device__ __forceinline__ float wave_sum(float v) {
#pragma unroll
    for (int o = 1; o < 64; o <<= 1) v += __shfl_xor(v, o);
    return v;
}

namespace pg8 {
constexpr int BM = 256, BK = 64, HALF = 128, HTB = HALF * BK * 2, STAGE_BYTES = 8 * HTB, NXCD = 8, WGM = 8;
__host__ __device__ __forceinline__ int lds_byte(int r, int c) { const int st = (r >> 4) * 2 + (c >> 5), rr = r & 15, cc = c & 31, ob = rr * 64 + cc * 2; return st * 1024 + (ob ^ (((ob >> 9) & 1) << 5)); }
__host__ __device__ __forceinline__ void stage_rc(int b, int& R, int& C) { const int st = b / 1024, sb = b % 1024, swz = sb ^ (((sb >> 9) & 1) << 5); R = (st >> 1) * 16 + swz / 64; C = (st & 1) * 32 + (swz % 64) / 2; }
__host__ __device__ __forceinline__ int perm32(int rho) { const int n = rho >> 4, i = rho & 15; return 8 * (i >> 2) + 4 * n + (i & 3); }
struct Unit { int pm, pn; };
struct Gemm { const bf16_t* A; const bf16_t* Bt; int M, N, K; };
struct StaticOrder {
    int nM, nN, nwg, G, c;
    __host__ __device__ void init(int M, int N, int G_, int c_) { nM = M / BM; nN = N / BM; nwg = nM * nN; G = G_; c = c_; }
    __host__ __device__ bool next(int i, Unit& u) const {
        const long L = (long)i * G + c; if (L >= nwg) return false;
        int wgid = (int)L; { const int q = nwg / NXCD, r = nwg % NXCD, xcd = wgid % NXCD, off = wgid / NXCD; wgid = (xcd < r ? xcd * (q + 1) : r * (q + 1) + (xcd - r) * q) + off; }
        const int nig = WGM * nN, gid = wgid / nig, fm = gid * WGM, gsz = (nM - fm) < WGM ? (nM - fm) : WGM;
        u.pm = fm + ((wgid % nig) % gsz); u.pn = (wgid % nig) / gsz; return true;
    }
};
template <class Epi, bool ALIGN_EPI>
__device__ __forceinline__ void gemm_phase(LAS unsigned char* lds, const Gemm g, const StaticOrder& S, const Epi& E, int wv) {
    int tid_ = wv * 64 + lane_id(); asm volatile("" : "+v"(tid_));
    const int tid = tid_, wid = __builtin_amdgcn_readfirstlane(tid >> 6), lane = tid & 63, wr = wid >> 2, wc = wid & 3, fr = lane & 15, fq = lane >> 4;
    const int K = g.K, nt = K / BK;
    unsigned voffA[2], voffB[2];
#pragma unroll
    for (int i = 0; i < 2; ++i) { int R, C; stage_rc(tid * 16 + i * 8192, R, C); const int Rb = (R & ~31) + perm32(R & 31);
        voffA[i] = (unsigned)(R * K + C) * 2u; voffB[i] = (unsigned)(Rb * K + C) * 2u; }
    const size_t kstep = (size_t)(BK * 2);
    const size_t hstep = (size_t)HALF * K * 2;
    const size_t tstep = 2 * hstep;
    const unsigned ldsw = (unsigned)wid * 1024u;
    const int aoff = lds_byte(wr * 64 + fr, fq * 8), boff = lds_byte(wc * 32 + fr, fq * 8);
#define PG8_SA(b, h) (((b) * 2 + (h)) * HTB)
#define PG8_SB(b, h) ((4 + (b) * 2 + (h)) * HTB)
#define PG8_STAGE(bufoff, gbase, voff) do { _Pragma("unroll") for (int _i = 0; _i < 2; ++_i) \
        __builtin_amdgcn_global_load_lds((const unsigned*)((const char*)(gbase) + (voff)[_i]), (LAS unsigned*)(lds + (bufoff) + ldsw + _i * 8192), 16, 0, 0); } while (0)
#define PG8_LDA(dst, b, h) do { _Pragma("unroll") for (int m = 0; m < 4; ++m) _Pragma("unroll") for (int k = 0; k < 2; ++k) dst[m][k] = *(const LAS bf16x8*)(lds + PG8_SA(b, h) + aoff + m * 2048 + k * 1024); } while (0)
#define PG8_LDB(dst, b, h) do { _Pragma("unroll") for (int n = 0; n < 2; ++n) _Pragma("unroll") for (int k = 0; k < 2; ++k) dst[n][k] = *(const LAS bf16x8*)(lds + PG8_SB(b, h) + boff + n * 2048 + k * 1024); } while (0)
#define PG8_MMA(ai, bj, At, Bt) do { __builtin_amdgcn_s_setprio(1); _Pragma("unroll") for (int m = 0; m < 4; ++m) _Pragma("unroll") for (int n = 0; n < 2; ++n) _Pragma("unroll") for (int k = 0; k < 2; ++k) \
        acc[ai][bj][m][n] = __builtin_amdgcn_mfma_f32_16x16x32_bf16(Bt[n][k], At[m][k], acc[ai][bj][m][n], 0, 0, 0); __builtin_amdgcn_s_setprio(0); } while (0)
#define PG8_WAIT_V(n) asm volatile("s_waitcnt vmcnt(" #n ")" ::: "memory")
#define PG8_WAIT_L(n) asm volatile("s_waitcnt lgkmcnt(" #n ")" ::: "memory")
#define PG8_BAR __builtin_amdgcn_s_barrier()
#define PG8_SCHED __builtin_amdgcn_sched_barrier(0)
    Unit cur, nxt; int ui = 0;
    if (!S.next(0, cur)) return;
    f32x4 acc[2][2][4][2];
#pragma unroll
    for (int a = 0; a < 2; ++a)
#pragma unroll
        for (int b = 0; b < 2; ++b)
#pragma unroll
            for (int m = 0; m < 4; ++m)
#pragma unroll
                for (int n = 0; n < 2; ++n) acc[a][b][m][n] = (f32x4){0.f, 0.f, 0.f, 0.f};
    bf16x8 At[4][2], B0[2][2], B1[2][2];
    const char* cA = (const char*)g.A + (size_t)cur.pm * tstep; const char* cB = (const char*)g.Bt + (size_t)cur.pn * tstep;
    PG8_STAGE(PG8_SB(0, 0), cB, voffB); PG8_STAGE(PG8_SB(0, 1), cB + hstep, voffB); PG8_STAGE(PG8_SA(0, 0), cA, voffA); PG8_STAGE(PG8_SA(0, 1), cA + hstep, voffA);
    if (wr == 1) PG8_BAR;
    PG8_WAIT_V(2); PG8_BAR;
    PG8_STAGE(PG8_SB(1, 0), cB + kstep, voffB); PG8_STAGE(PG8_SA(1, 0), cA + kstep, voffA); PG8_STAGE(PG8_SB(1, 1), cB + hstep + kstep, voffB);
    PG8_WAIT_V(6); PG8_BAR;
    for (;;) {
        const bool has_next = S.next(ui + 1, nxt);
        const char* nA = has_next ? (const char*)g.A + (size_t)nxt.pm * tstep : cA; const char* nB = has_next ? (const char*)g.Bt + (size_t)nxt.pn * tstep : cB;
        for (int t = 0; t < nt; t += 2) {
            const bool last = (t == nt - 2);
            const char* a1 = cA + (size_t)(t + 1) * kstep;
            const char* a2 = last ? nA : cA + (size_t)(t + 2) * kstep; const char* b2 = last ? nB : cB + (size_t)(t + 2) * kstep;
            const char* a3 = a2 + kstep; const char* b3 = b2 + kstep;
            PG8_LDB(B0, 0, 0); PG8_LDB(B1, 0, 1); PG8_SCHED; PG8_LDA(At, 0, 0); PG8_STAGE(PG8_SA(1, 1), a1 + hstep, voffA);
            PG8_WAIT_V(8); PG8_WAIT_L(0); PG8_BAR; PG8_MMA(0, 0, At, B0); PG8_MMA(0, 1, At, B1); PG8_BAR; PG8_SCHED;
            PG8_LDA(At, 0, 1); PG8_STAGE(PG8_SB(0, 0), b2, voffB); PG8_STAGE(PG8_SB(0, 1), b2 + hstep, voffB); PG8_STAGE(PG8_SA(0, 0), a2, voffA);
            PG8_WAIT_V(8); PG8_WAIT_L(0); PG8_BAR; PG8_MMA(1, 0, At, B0); PG8_MMA(1, 1, At, B1); PG8_BAR; PG8_SCHED;
            PG8_LDB(B0, 1, 0); PG8_LDB(B1, 1, 1); PG8_SCHED; PG8_LDA(At, 1, 0); PG8_STAGE(PG8_SA(0, 1), a2 + hstep, voffA);
            PG8_WAIT_V(8); PG8_WAIT_L(0); PG8_BAR; PG8_MMA(0, 0, At, B0); PG8_MMA(0, 1, At, B1); PG8_BAR; PG8_SCHED;
            PG8_LDA(At, 1, 1); PG8_STAGE(PG8_SB(1, 0), b3, voffB); PG8_STAGE(PG8_SB(1, 1), b3 + hstep, voffB); PG8_STAGE(PG8_SA(1, 0), a3, voffA);
            PG8_WAIT_V(8); PG8_WAIT_L(0); PG8_BAR; PG8_MMA(1, 0, At, B0); PG8_MMA(1, 1, At, B1); PG8_BAR; PG8_SCHED;
        }
        if constexpr (ALIGN_EPI) { if (wr == 0) PG8_BAR; }
        E(acc, cur, wr, wc, fr, fq);
        if (!has_next) break;
#pragma unroll
        for (int a = 0; a < 2; ++a)
#pragma unroll
            for (int b = 0; b < 2; ++b)
#pragma unroll
                for (int m = 0; m < 4; ++m)
#pragma unroll
                    for (int n = 0; n < 2; ++n) acc[a][b][m][n] = (f32x4){0.f, 0.f, 0.f, 0.f};
        cur = nxt; cA = nA; cB = nB; ++ui;
        if constexpr (ALIGN_EPI) { if (wr == 1) PG8_BAR; }
    }
    PG8_WAIT_V(0);
    if constexpr (!ALIGN_EPI) { if (wr == 0) PG8_BAR; }
    PG8_BAR;
#undef PG8_SA
#undef PG8_SB
#undef PG8_STAGE
#undef PG8_LDA
#undef PG8_LDB
#undef PG8_MMA
#undef PG8_WAIT_V
#undef PG8_WAIT_L
#undef PG8_BAR
#undef PG8_SCHED
}
}

typedef f32x4 AccT[2][2][4][2];

struct EpiProj {
    const float* rs1; const float* cosT; const float* sinT;
    unsigned char* ws;
    __device__ __forceinline__ void operator()(const AccT& acc, const pg8::Unit& u, int wr, int wc, int fr, int fq) const {
        const int row0 = u.pm * 256 + wr * 64 + fr;
#pragma unroll
        for (int bj = 0; bj < 2; ++bj) {
            const int sec = u.pn * 2 + bj;
            if (sec >= 39) continue;
            if (sec == 38) {
                if (wc == 0 && fq < 3) {
                    float* NG = (float*)(ws + WS_NG);
#pragma unroll
                    for (int ai = 0; ai < 2; ++ai)
#pragma unroll
                        for (int m = 0; m < 4; ++m) { const int r = row0 + ai * 128 + m * 16; const float rs = rs1[r];
                            f32x4 v0 = acc[ai][bj][m][0] * rs, v1 = acc[ai][bj][m][1] * rs;
                            f32x4 o0, o1;
#pragma unroll
                            for (int i = 0; i < 4; ++i) { o0[i] = sigmoidf_(v0[i]); o1[i] = sigmoidf_(v1[i]); }
                            *(f32x4*)(NG + (size_t)r * 24 + fq * 8) = o0; *(f32x4*)(NG + (size_t)r * 24 + fq * 8 + 4) = o1; }
                }
                continue;
            }
            if (sec >= 22) {
                bf16_t* MG = (bf16_t*)(ws + WS_MG);
                const int col = (sec - 22) * 128 + wc * 32 + fq * 8;
#pragma unroll
                for (int ai = 0; ai < 2; ++ai)
#pragma unroll
                    for (int m = 0; m < 4; ++m) { const int r = row0 + ai * 128 + m * 16; const float rs = rs1[r];
                        f32x4 v0 = acc[ai][bj][m][0] * rs, v1 = acc[ai][bj][m][1] * rs;
                        u32x4 w; w.x = cvtpk(sigmoidf_(v0[0]), sigmoidf_(v0[1])); w.y = cvtpk(sigmoidf_(v0[2]), sigmoidf_(v0[3]));
                        w.z = cvtpk(sigmoidf_(v1[0]), sigmoidf_(v1[1])); w.w = cvtpk(sigmoidf_(v1[2]), sigmoidf_(v1[3]));
                        *(u32x4*)(MG + (size_t)r * 2048 + col) = w; }
                continue;
            }
            bf16_t* base; int H, head, HD, coff; bool rope; float scale = 1.f;
            if (sec < 4)       { base = (bf16_t*)(ws + WS_DQ); H = 4; head = sec;      HD = 128; coff = (wc >> 1) * 64; rope = true; scale = C2; }
            else if (sec < 8)  { base = (bf16_t*)(ws + WS_DK); H = 8; head = (sec - 4) * 2 + (wc >> 1); HD = 64; coff = 0; rope = true; }
            else if (sec < 12) { base = (bf16_t*)(ws + WS_DV); H = 4; head = sec - 8;  HD = 128; coff = (wc >> 1) * 64; rope = false; }
            else if (sec < 16) { base = (bf16_t*)(ws + WS_NQ); H = 8; head = (sec - 12) * 2 + (wc >> 1); HD = 64; coff = 0; rope = true; scale = C2; }
            else { const int k6 = sec - 16; base = (bf16_t*)(ws + WS_KC + (size_t)k6 * 8 * MiB); H = 2; head = wc >> 1; HD = 64; coff = 0; rope = (k6 & 1) == 0; }
            const int j = 4 * (wc & 1) + fq;
#pragma unroll
            for (int ai = 0; ai < 2; ++ai)
#pragma unroll
                for (int m = 0; m < 4; ++m) { const int r = row0 + ai * 128 + m * 16; const float rs = rs1[r] * scale;
                    const int b = r >> 12, s = r & 4095;
                    bf16_t* p = base + ((size_t)(b * H + head) * S + s) * HD + coff;
                    f32x4 v0 = acc[ai][bj][m][0] * rs, v1 = acc[ai][bj][m][1] * rs;
                    if (rope) {
                        const f32x4 c = *(const f32x4*)(cosT + (size_t)r * 32 + 4 * j), sn = *(const f32x4*)(sinT + (size_t)r * 32 + 4 * j);
                        const f32x4 o1 = v0 * c - v1 * sn, o2 = v1 * c + v0 * sn;
                        u32x2 w1, w2; w1.x = cvtpk(o1[0], o1[1]); w1.y = cvtpk(o1[2], o1[3]); w2.x = cvtpk(o2[0], o2[1]); w2.y = cvtpk(o2[2], o2[3]);
                        *(u32x2*)(p + 4 * j) = w1; *(u32x2*)(p + 32 + 4 * j) = w2;
                    } else {
                        u32x4 w; w.x = cvtpk(v0[0], v0[1]); w.y = cvtpk(v0[2], v0[3]); w.z = cvtpk(v1[0], v1[1]); w.w = cvtpk(v1[2], v1[3]);
                        *(u32x4*)(p + 8 * j) = w;
                    }
                }
        }
    }
};
struct EpiF32 {
    float* O; int ldc;
    __device__ __forceinline__ void operator()(const AccT& acc, const pg8::Unit& u, int wr, int wc, int fr, int fq) const {
        const int row0 = u.pm * 256 + wr * 64 + fr, col0 = u.pn * 256 + wc * 32 + fq * 8;
#pragma unroll
        for (int ai = 0; ai < 2; ++ai)
#pragma unroll
            for (int m = 0; m < 4; ++m)
#pragma unroll
                for (int bj = 0; bj < 2; ++bj) { float* p = O + (size_t)(row0 + ai * 128 + m * 16) * ldc + col0 + bj * 128;
                    *(f32x4*)p = acc[ai][bj][m][0]; *(f32x4*)(p + 4) = acc[ai][bj][m][1]; }
    }
};
template <bool SECOND> struct EpiBranch {
    bf16_t* MERGED; const bf16_t* MG;
    __device__ __forceinline__ void operator()(const AccT& acc, const pg8::Unit& u, int wr, int wc, int fr, int fq) const {
        const int row0 = u.pm * 256 + wr * 64 + fr, col0 = u.pn * 256 + wc * 32 + fq * 8;
#pragma unroll
        for (int ai = 0; ai < 2; ++ai)
#pragma unroll
            for (int m = 0; m < 4; ++m)
#pragma unroll
                for (int bj = 0; bj < 2; ++bj) { const int r = row0 + ai * 128 + m * 16, c = col0 + bj * 128;
                    const u32x4 g = *(const u32x4*)(MG + (size_t)r * 2048 + (SECOND ? 1024 : 0) + c);
                    const f32x4 a0 = acc[ai][bj][m][0], a1 = acc[ai][bj][m][1];
                    float o[8] = {bflo(g.x) * a0[0], bfhi(g.x) * a0[1], bflo(g.y) * a0[2], bfhi(g.y) * a0[3], bflo(g.z) * a1[0], bfhi(g.z) * a1[1], bflo(g.w) * a1[2], bfhi(g.w) * a1[3]};
                    bf16_t* p = MERGED + (size_t)r * 1024 + c;
                    if (SECOND) { const u32x4 pv = *(const u32x4*)p;
                        o[0] += bflo(pv.x); o[1] += bfhi(pv.x); o[2] += bflo(pv.y); o[3] += bfhi(pv.y); o[4] += bflo(pv.z); o[5] += bfhi(pv.z); o[6] += bflo(pv.w); o[7] += bfhi(pv.w); }
                    u32x4 w; w.x = cvtpk(o[0], o[1]); w.y = cvtpk(o[2], o[3]); w.z = cvtpk(o[4], o[5]); w.w = cvtpk(o[6], o[7]);
                    *(u32x4*)p = w; }
    }
};
template <bool BASE_BF> struct EpiResid {
    const void* base; bf16_t* HB; float* SSQ;
    __device__ __forceinline__ void operator()(const AccT& acc, const pg8::Unit& u, int wr, int wc, int fr, int fq) const {
        const int row0 = u.pm * 256 + wr * 64 + fr, col0 = u.pn * 256 + wc * 32 + fq * 8;
#pragma unroll
        for (int ai = 0; ai < 2; ++ai)
#pragma unroll
            for (int m = 0; m < 4; ++m) { const int r = row0 + ai * 128 + m * 16; float ss = 0.f;
#pragma unroll
                for (int bj = 0; bj < 2; ++bj) { const size_t off = (size_t)r * 1024 + col0 + bj * 128;
                    f32x4 b0, b1;
                    if (BASE_BF) { const u32x4 g = *(const u32x4*)((const bf16_t*)base + off); b0 = (f32x4){bflo(g.x), bfhi(g.x), bflo(g.y), bfhi(g.y)}; b1 = (f32x4){bflo(g.z), bfhi(g.z), bflo(g.w), bfhi(g.w)}; }
                    else { b0 = *(const f32x4*)((const float*)base + off); b1 = *(const f32x4*)((const float*)base + off + 4); }
                    const f32x4 h0 = b0 + acc[ai][bj][m][0], h1 = b1 + acc[ai][bj][m][1];
                    ss += (h0[0] * h0[0] + h0[1] * h0[1]) + (h0[2] * h0[2] + h0[3] * h0[3]) + (h1[0] * h1[0] + h1[1] * h1[1]) + (h1[2] * h1[2] + h1[3] * h1[3]);
                    u32x4 w; w.x = cvtpk(h0[0], h0[1]); w.y = cvtpk(h0[2], h0[3]); w.z = cvtpk(h1[0], h1[1]); w.w = cvtpk(h1[2], h1[3]); *(u32x4*)(HB + off) = w; }
                ss += __shfl_xor(ss, 16); ss += __shfl_xor(ss, 32);
                if (fq == 0) SSQ[(size_t)r * 16 + u.pn * 4 + wc] = ss; }
    }
};
struct EpiGU {
    const float* SSQ2; bf16_t* ACT;
    __device__ __forceinline__ void operator()(const AccT& acc, const pg8::Unit& u, int wr, int wc, int fr, int fq) const {
        const int row0 = u.pm * 256 + wr * 64 + fr, col0 = u.pn * 128 + wc * 16 + fq * 4;
#pragma unroll
        for (int ai = 0; ai < 2; ++ai)
#pragma unroll
            for (int m = 0; m < 4; ++m) { const int r = row0 + ai * 128 + m * 16;
                const f32x4* sp = (const f32x4*)(SSQ2 + (size_t)r * 16); const f32x4 s0 = sp[0], s1 = sp[1], s2 = sp[2], s3 = sp[3];
                const float tot = ((s0[0] + s0[1]) + (s0[2] + s0[3])) + ((s1[0] + s1[1]) + (s1[2] + s1[3])) + ((s2[0] + s2[1]) + (s2[2] + s2[3])) + ((s3[0] + s3[1]) + (s3[2] + s3[3]));
                const float rs = rsqrtf(tot * (1.f / 1024.f) + EPS);
#pragma unroll
                for (int bj = 0; bj < 2; ++bj) { const f32x4 gv = acc[ai][bj][m][0] * rs, uv = acc[ai][bj][m][1] * rs; float o[4];
#pragma unroll
                    for (int i = 0; i < 4; ++i) o[i] = gv[i] * sigmoidf_(gv[i]) * uv[i];
                    u32x2 w; w.x = cvtpk(o[0], o[1]); w.y = cvtpk(o[2], o[3]);
                    *(u32x2*)(ACT + (size_t)r * FF + col0 + bj * 64) = w; } }
    }
};

typedef std::integral_constant<bool, true> TrueC; typedef std::integral_constant<bool, false> FalseC;
__device__ __forceinline__ int crow(int r, int hi) { return (r & 3) + 8 * (r >> 2) + 4 * hi; }
__device__ __forceinline__ constexpr int ccol(int r) { return (r & 3) + 8 * (r >> 2); }
__device__ __forceinline__ void glds16(const void* g, LAS unsigned char* l) {
    unsigned keep; const unsigned dst = (unsigned)__builtin_amdgcn_readfirstlane((int)(unsigned)(uintptr_t)l);
    asm volatile("s_mov_b32 %0, m0\n\ts_mov_b32 m0, %2\n\ts_nop 0\n\tglobal_load_lds_dwordx4 %1, off\n\ts_mov_b32 m0, %0" : "=&s"(keep) : "v"(g), "s"(dst) : "memory");
}
#define VM_DRAIN_SYNC() do { asm volatile("s_waitcnt vmcnt(0)" ::: "memory"); __syncthreads(); } while (0)
#define WAIT_BAR(N) asm volatile("s_waitcnt vmcnt(" #N ") lgkmcnt(0)\n\ts_barrier" ::: "memory")
__device__ __forceinline__ void wait_bar_n(int n) { if (n == 4) WAIT_BAR(4); else if (n == 2) WAIT_BAR(2); else if (n == 1) WAIT_BAR(1); else WAIT_BAR(0); }
__device__ __forceinline__ int ksrc_off(int wid, int lane) { const int ip = (lane - 8 * (wid & 1)) & 63, rho = ip >> 3, c = (ip & 7) ^ rho; return (8 * wid + rho) * 64 + c * 8; }
__device__ __forceinline__ void kread_offs(int (&koff)[4], int r32, int hi) {
    const int pc = r32 >> 3, rho = r32 & 7;
#pragma unroll
    for (int d0 = 0; d0 < 4; ++d0) koff[d0] = pc * 1024 + (((rho * 8 + ((2 * d0 + hi) ^ rho) + 8 * (pc & 1)) & 63) << 4);
}
__device__ __forceinline__ void qkt(f32x16& p0, f32x16& p1, const LAS unsigned char* Kslot, const int (&koff)[4], const bf16x8* qr) {
    bf16x8 kf[8];
#pragma unroll
    for (int d0 = 0; d0 < 4; ++d0) { kf[2 * d0] = *(const LAS bf16x8*)(Kslot + koff[d0]); kf[2 * d0 + 1] = *(const LAS bf16x8*)(Kslot + koff[d0] + 4096); }
    const f32x16 zz = f32x16{};
    p0 = __builtin_amdgcn_mfma_f32_32x32x16_bf16(kf[0], qr[0], zz, 0, 0, 0); p1 = __builtin_amdgcn_mfma_f32_32x32x16_bf16(kf[1], qr[0], zz, 0, 0, 0);
#pragma unroll
    for (int d0 = 1; d0 < 4; ++d0) { p0 = __builtin_amdgcn_mfma_f32_32x32x16_bf16(kf[2 * d0], qr[d0], p0, 0, 0, 0); p1 = __builtin_amdgcn_mfma_f32_32x32x16_bf16(kf[2 * d0 + 1], qr[d0], p1, 0, 0, 0); }
}
__device__ __forceinline__ s16x4 vtr(const LAS unsigned char* p) { return __builtin_bit_cast(s16x4, __builtin_amdgcn_ds_read_tr16_b64_v4i16((LAS s16x4*)p)); }
template <int NDB> struct Flash {
    f32x16 o[NDB]; float mhat, l; bool first;
    __device__ __forceinline__ void reset() {
#pragma unroll
        for (int d = 0; d < NDB; ++d) o[d] = f32x16{};
        mhat = 0.f; l = 0.f; first = true; }
    static __device__ __forceinline__ float rowmax_abs(const f32x16& p0, const f32x16& p1) {
        float a = __builtin_fmaxf(__builtin_fmaxf(p0[0], p0[1]), p1[0]), c = __builtin_fmaxf(__builtin_fmaxf(p0[2], p0[3]), p1[1]);
        a = __builtin_fmaxf(__builtin_fmaxf(a, p1[2]), p1[3]);
#pragma unroll
        for (int r = 4; r < 16; r += 4) { a = __builtin_fmaxf(__builtin_fmaxf(a, p0[r]), p0[r + 1]); c = __builtin_fmaxf(__builtin_fmaxf(c, p0[r + 2]), p0[r + 3]);
            a = __builtin_fmaxf(__builtin_fmaxf(a, p1[r]), p1[r + 1]); c = __builtin_fmaxf(__builtin_fmaxf(c, p1[r + 2]), p1[r + 3]); }
        return xor32_max(__builtin_fmaxf(a, c));
    }
    __device__ __forceinline__ void decide(float rmabs, bool rowvalid, LAS float* wsf, int r32, int hi) {
        const float rm = rowvalid ? rmabs - mhat : -INFINITY;
        bool need; float dl;
        if (first) { need = true; dl = (rm > -1e30f) ? rm : 0.f; }
        else { need = __any(rm > 8.0f); dl = fmaxf(rm, 0.f); }
        if (need) {
            mhat += dl;
            if (!first) {
                const float f = __builtin_amdgcn_exp2f(-dl); l *= f;
                if (hi == 0) wsf[r32] = f;
                asm volatile("s_waitcnt lgkmcnt(0)" ::: "memory");
                const f32x4 t0 = *(const LAS f32x4*)(wsf + 4 * hi), t1 = *(const LAS f32x4*)(wsf + 8 + 4 * hi), t2 = *(const LAS f32x4*)(wsf + 16 + 4 * hi), t3 = *(const LAS f32x4*)(wsf + 24 + 4 * hi);
                const f32x16 fv = {t0[0], t0[1], t0[2], t0[3], t1[0], t1[1], t1[2], t1[3], t2[0], t2[1], t2[2], t2[3], t3[0], t3[1], t3[2], t3[3]};
#pragma unroll
                for (int d = 0; d < NDB; ++d) o[d] = o[d] * fv;
                asm volatile("s_waitcnt lgkmcnt(0)" ::: "memory");
            }
        }
        first = false;
    }
    __device__ __forceinline__ void exphalf(f32x16& p, float mm, u32x4& w0, u32x4& w1) {
        p = p - mm;
        float sa = 0.f, sb = 0.f;
#pragma unroll
        for (int r = 0; r < 16; r += 2) { p[r] = __builtin_amdgcn_exp2f(p[r]); p[r + 1] = __builtin_amdgcn_exp2f(p[r + 1]); sa += p[r]; sb += p[r + 1]; }
        l += sa + sb;
        w0 = (u32x4){cvtpk(p[0], p[1]), cvtpk(p[2], p[3]), cvtpk(p[4], p[5]), cvtpk(p[6], p[7])};
        w1 = (u32x4){cvtpk(p[8], p[9]), cvtpk(p[10], p[11]), cvtpk(p[12], p[13]), cvtpk(p[14], p[15])};
    }
    __device__ __forceinline__ void pv_half(const u32x4& w0, const u32x4& w1, const LAS unsigned char* Vslot, int lane, int hi, int kb) {
        const LAS unsigned char* vp = Vslot + ((lane >> 4) & 1) * 32 + (lane & 3) * 8 + (4 * hi + ((lane & 15) >> 2)) * 64;
#pragma unroll
        for (int d = 0; d < NDB; ++d) {
            const s16x4 l0 = vtr(vp + (d * 4 + kb) * 1024), h0 = vtr(vp + (d * 4 + kb) * 1024 + 512), l1 = vtr(vp + (d * 4 + kb + 1) * 1024), h1 = vtr(vp + (d * 4 + kb + 1) * 1024 + 512);
            o[d] = __builtin_amdgcn_mfma_f32_32x32x16_bf16(__builtin_bit_cast(bf16x8, w0), (bf16x8){l0[0], l0[1], l0[2], l0[3], h0[0], h0[1], h0[2], h0[3]}, o[d], 0, 0, 0);
            o[d] = __builtin_amdgcn_mfma_f32_32x32x16_bf16(__builtin_bit_cast(bf16x8, w1), (bf16x8){l1[0], l1[1], l1[2], l1[3], h1[0], h1[1], h1[2], h1[3]}, o[d], 0, 0, 0);
        }
    }
    __device__ __forceinline__ void tile(f32x16& p0, f32x16& p1, const LAS unsigned char* Vslot, LAS float* wsf, int lane, int r32, int hi) {
        decide(rowmax_abs(p0, p1), true, wsf, r32, hi);
        u32x4 w0, w1, w2, w3;
        exphalf(p0, mhat, w0, w1); pv_half(w0, w1, Vslot, lane, hi, 0);
        exphalf(p1, mhat, w2, w3); pv_half(w2, w3, Vslot, lane, hi, 2);
    }
    __device__ __forceinline__ float ltot() const { return xor32_sum(l); }
};
__device__ __forceinline__ void row_bcast(float v, float (&fr_)[16], LAS float* wsf, int r32, int hi) {
    asm volatile("s_waitcnt lgkmcnt(0)" ::: "memory");
    if (hi == 0) wsf[r32] = v;
    asm volatile("s_waitcnt lgkmcnt(0)" ::: "memory");
#pragma unroll
    for (int k = 0; k < 4; ++k) { const f32x4 t = *(const LAS f32x4*)(wsf + 8 * k + 4 * hi); fr_[4 * k] = t[0]; fr_[4 * k + 1] = t[1]; fr_[4 * k + 2] = t[2]; fr_[4 * k + 3] = t[3]; }
    asm volatile("s_waitcnt lgkmcnt(0)" ::: "memory");
}

constexpr int DF_STAGE = 0;
constexpr int DF_WSF = 98304;
__device__ __forceinline__ void diff_unit(LAS unsigned char* L, int b, int h, int qb, const unsigned char* ws, float lam, const float* subg, int wv) {
    int tid_ = wv * 64 + lane_id(); asm volatile("" : "+v"(tid_));
    const int tid = tid_, lane = tid & 63, r32 = lane & 31, hi = lane >> 5, wid = __builtin_amdgcn_readfirstlane(tid >> 6);
    const int comp = wid >> 2, rgi = wid & 3;
    const size_t bh = (size_t)(b * 4 + h) * S;
    const bf16_t* Qp = (const bf16_t*)(ws + WS_DQ) + (bh + qb * 128 + rgi * 32 + r32) * 128 + comp * 64;
    bf16x8 qr[4];
#pragma unroll
    for (int d0 = 0; d0 < 4; ++d0) qr[d0] = *(const bf16x8*)(Qp + d0 * 16 + hi * 8);
    const bf16_t* Kg = (const bf16_t*)(ws + WS_DK) + bh * 128 + ksrc_off(wid, lane);
    int koff[4]; kread_offs(koff, r32, hi);
    const bf16_t* Vg = (const bf16_t*)(ws + WS_DV) + bh * 128 + (size_t)(16 * (wid & 3) + (lane >> 2)) * 128 + (wid >> 2) * 32 + (lane & 3) * 8;
    LAS float* wsf = (LAS float*)(L + DF_WSF) + wid * 32;
    const int NT = 2 * qb + 2;
    Flash<4> F; F.reset();
    auto dmaK = [&](int t, int s) { const bf16_t* src = Kg + (size_t)t * 4096; LAS unsigned char* d = L + s * 16384 + wid * 1024; glds16(src, d); glds16(src + (size_t)S * 64, d + 8192); };
    auto dmaV = [&](int t, int s) { const bf16_t* src = Vg + (size_t)t * 8192; LAS unsigned char* d = L + 49152 + s * 16384 + wid * 1024; glds16(src, d); glds16(src + 64, d + 8192); };
    dmaK(0, 0); dmaV(0, 0); dmaK(1, 1); dmaV(1, 1); if (NT > 2) dmaK(2, 2);
    WAIT_BAR(0);
    f32x16 a0, a1, b0, b1; float ra, rb;
    const int xq = 32 * rgi + r32 - 4 * hi;
    auto cmask = [&](f32x16& c0, f32x16& c1, int t) { const int x = xq - 64 * (t - (NT - 2));
#pragma unroll
        for (int r = 0; r < 16; ++r) { if (ccol(r) > x) c0[r] = -INFINITY; if (ccol(r) + 32 > x) c1[r] = -INFINITY; } };
    qkt(a0, a1, L + comp * 8192, koff, qr);
    if (NT == 2) cmask(a0, a1, 0);
    ra = Flash<4>::rowmax_abs(a0, a1);
    WAIT_BAR(0);
    int s0 = 0, s1 = 1, s2 = 2;
    auto iter = [&](int t, f32x16& c0, f32x16& c1, float& rc, f32x16& n0, f32x16& n1, float& rn, auto next) {
        int nis = 0;
        if (t + 3 < NT) { dmaK(t + 3, s0); nis += 2; }
        if (t + 2 < NT) { dmaV(t + 2, s2); nis += 2; }
        F.decide(rc, true, wsf, r32, hi);
        const LAS unsigned char* Vs = L + 49152 + s0 * 16384;
        u32x4 w0, w1, w2, w3;
        if constexpr (decltype(next)::value) qkt(n0, n1, L + s1 * 16384 + comp * 8192, koff, qr);
        F.exphalf(c0, F.mhat, w0, w1);
        F.pv_half(w0, w1, Vs, lane, hi, 0);
        F.exphalf(c1, F.mhat, w2, w3);
        F.pv_half(w2, w3, Vs, lane, hi, 2);
        if constexpr (decltype(next)::value) { rn = Flash<4>::rowmax_abs(n0, n1); if (t + 1 >= NT - 2) { cmask(n0, n1, t + 1); rn = Flash<4>::rowmax_abs(n0, n1); } }
        wait_bar_n(nis);
        const int tmp = s0; s0 = s1; s1 = s2; s2 = tmp;
    };
    int t = 0;
    for (; t < NT - 2; t += 2) { iter(t, a0, a1, ra, b0, b1, rb, TrueC{}); iter(t + 1, b0, b1, rb, a0, a1, ra, TrueC{}); }
    iter(NT - 2, a0, a1, ra, b0, b1, rb, TrueC{});
    iter(NT - 1, b0, b1, rb, a0, a1, ra, FalseC{});
    const float lt = F.ltot();
    float fr_[16];
    row_bcast((comp ? lam : 1.f) / lt, fr_, wsf, r32, hi);
    LAS float* stg = (LAS float*)(L + DF_STAGE) + rgi * 32 * 132;
    if (comp == 1) {
#pragma unroll
        for (int d = 0; d < 4; ++d)
#pragma unroll
            for (int r = 0; r < 16; ++r) stg[crow(r, hi) * 132 + d * 32 + r32] = F.o[d][r] * fr_[r];
    }
    __syncthreads();
    if (comp == 0) {
#pragma unroll
        for (int d = 0; d < 4; ++d)
#pragma unroll
            for (int r = 0; r < 16; ++r) { const int ix = crow(r, hi) * 132 + d * 32 + r32; stg[ix] = F.o[d][r] * fr_[r] - stg[ix]; }
        asm volatile("s_waitcnt lgkmcnt(0)" ::: "memory");
        const LAS float* rowp = stg + r32 * 132 + 64 * hi;
        float ss = 0.f;
#pragma unroll
        for (int k = 0; k < 16; ++k) { const f32x4 v = *(const LAS f32x4*)(rowp + 4 * k); ss += (v[0] * v[0] + v[1] * v[1]) + (v[2] * v[2] + v[3] * v[3]); }
        ss = xor32_sum(ss);
        const float rstd = rsqrtf(ss * (1.f / 128.f) + EPS) * (1.f - LAM_INIT);
        bf16_t* Yp = (bf16_t*)(ws + WS_YA) + ((size_t)b * S + qb * 128 + rgi * 32 + r32) * 512 + h * 128 + 64 * hi;
#pragma unroll
        for (int k = 0; k < 8; ++k) { const f32x4 v0 = *(const LAS f32x4*)(rowp + 8 * k), v1 = *(const LAS f32x4*)(rowp + 8 * k + 4);
            const f32x4 g0 = *(const f32x4*)(subg + 64 * hi + 8 * k), g1 = *(const f32x4*)(subg + 64 * hi + 8 * k + 4);
            u32x4 w; w.x = cvtpk(v0[0] * rstd * g0[0], v0[1] * rstd * g0[1]); w.y = cvtpk(v0[2] * rstd * g0[2], v0[3] * rstd * g0[3]);
            w.z = cvtpk(v1[0] * rstd * g1[0], v1[1] * rstd * g1[1]); w.w = cvtpk(v1[2] * rstd * g1[2], v1[3] * rstd * g1[3]);
            *(u32x4*)(Yp + 8 * k) = w; }
    }
    __syncthreads();
}

constexpr int NS_CMP = 49152;
constexpr int NS_GL = 114688;
constexpr int NS_WSF = 147456;
template <int MODE>
__device__ __forceinline__ void nsa_kv_pass(LAS unsigned char* L, Flash<2>& F, const bf16x8* qr, const int (&koff)[4], const bf16_t* Kg0, const bf16_t* Vg0, int jlo, int jhi, int qblk, int ql, unsigned long long mymask,
                                            LAS float* wsf, int wid, int lane, int r32, int hi) {
    auto dmaK = [&](int j, int s) { glds16(Kg0 + (size_t)j * 4096, L + s * 8192 + wid * 1024); };
    auto dmaV = [&](int j, int s) { glds16(Vg0 + (size_t)j * 4096, L + 24576 + s * 8192 + wid * 1024); };
    dmaK(jlo, 0); dmaV(jlo, 0); if (jlo + 1 <= jhi) { dmaK(jlo + 1, 1); dmaV(jlo + 1, 1); } if (jlo + 2 <= jhi) dmaK(jlo + 2, 2);
    WAIT_BAR(0);
    f32x16 a0, a1, b0, b1; float ra, rb;
    const int xq = ql - 4 * hi;
    auto masked = [&](int j) { return MODE == 1 ? (j == qblk) : (j == qblk || j == qblk - 8); };
    auto amask = [&](f32x16& c0, f32x16& c1, int j) {
        if (MODE == 1) {
#pragma unroll
            for (int r = 0; r < 16; ++r) { if (ccol(r) > xq) c0[r] = -INFINITY; if (ccol(r) + 32 > xq) c1[r] = -INFINITY; }
        } else { const int base = 64 * (qblk - j) + xq;
#pragma unroll
            for (int r = 0; r < 16; ++r) { if ((unsigned)(base - ccol(r)) >= 512u) c0[r] = -INFINITY; if ((unsigned)(base - ccol(r) - 32) >= 512u) c1[r] = -INFINITY; } } };
    qkt(a0, a1, L, koff, qr);
    if (masked(jlo)) amask(a0, a1, jlo);
    ra = Flash<2>::rowmax_abs(a0, a1);
    WAIT_BAR(0);
    int s0 = 0, s1 = 1, s2 = 2;
    auto iter = [&](int j, f32x16& c0, f32x16& c1, float& rc, f32x16& n0, f32x16& n1, float& rn, auto next) {
        int nis = 0;
        if (j + 3 <= jhi) { dmaK(j + 3, s0); nis += 1; }
        if (j + 2 <= jhi) { dmaV(j + 2, s2); nis += 1; }
        const bool rowvalid = (MODE == 1) ? (bool)((mymask >> j) & 1ull) : true;
        F.decide(rc, rowvalid, wsf, r32, hi);
        const float mm = rowvalid ? F.mhat : INFINITY;
        const LAS unsigned char* Vs = L + 24576 + s0 * 8192;
        u32x4 w0, w1, w2, w3;
        if constexpr (decltype(next)::value) qkt(n0, n1, L + s1 * 8192, koff, qr);
        F.exphalf(c0, mm, w0, w1);
        F.pv_half(w0, w1, Vs, lane, hi, 0);
        F.exphalf(c1, mm, w2, w3);
        F.pv_half(w2, w3, Vs, lane, hi, 2);
        if constexpr (decltype(next)::value) { rn = Flash<2>::rowmax_abs(n0, n1); if (masked(j + 1)) { amask(n0, n1, j + 1); rn = Flash<2>::rowmax_abs(n0, n1); } }
        wait_bar_n(nis);
        const int tmp = s0; s0 = s1; s1 = s2; s2 = tmp;
    };
    int j = jlo;
    for (; j + 2 <= jhi; j += 2) { iter(j, a0, a1, ra, b0, b1, rb, TrueC{}); iter(j + 1, b0, b1, rb, a0, a1, ra, TrueC{}); }
    if (j < jhi) { iter(j, a0, a1, ra, b0, b1, rb, TrueC{}); iter(jhi, b0, b1, rb, a0, a1, ra, FalseC{}); }
    else iter(jhi, a0, a1, ra, b0, b1, rb, FalseC{});
}
__device__ __forceinline__ void nsa_unit(LAS unsigned char* L, int b, int g, int qblk, const unsigned char* ws, int wv) {
    int tid_ = wv * 64 + lane_id(); asm volatile("" : "+v"(tid_));
    const int tid = tid_, lane = tid & 63, r32 = lane & 31, hi = lane >> 5, wid = __builtin_amdgcn_readfirstlane(tid >> 6);
    const int ql = 8 * wid + (r32 & 7), hh = r32 >> 3, head = g * 4 + hh;
    const int qpos = 64 * qblk + ql;
    const size_t tok = (size_t)b * S + qpos;
    const bf16_t* Qp = (const bf16_t*)(ws + WS_NQ) + ((size_t)(b * 8 + head) * S + qpos) * 64;
    bf16x8 qr[4];
#pragma unroll
    for (int d0 = 0; d0 < 4; ++d0) qr[d0] = *(const bf16x8*)(Qp + d0 * 16 + hi * 8);
    const float* NGp = (const float*)(ws + WS_NG) + tok * 24 + head;
    const float g0 = NGp[0], g1 = NGp[8], g2 = NGp[16];
    LAS float* wsf = (LAS float*)(L + NS_WSF) + wid * 32;
    const size_t pg = (size_t)(b * 2 + g);
    LAS float* yst = (LAS float*)(L + NS_CMP) + wid * 2048;
    float fr_[16];
    unsigned long long mymask = 0ull;
    int koff[4]; kread_offs(koff, r32, hi);
    {
        const int ntc = ((4 * qblk + 2) >> 6) + 1;
        const bf16_t* Kc = (const bf16_t*)(ws + WS_KCMP) + pg * 256 * 64 + ksrc_off(wid, lane);
        const bf16_t* Vc = (const bf16_t*)(ws + WS_VCMP) + (pg * 256 + 16 * (wid & 3) + (lane >> 2)) * 64 + (wid >> 2) * 32 + (lane & 3) * 8;
        for (int ct = 0; ct < ntc; ++ct) { glds16(Kc + (size_t)ct * 4096, L + NS_CMP + ct * 8192 + wid * 1024); glds16(Vc + (size_t)ct * 4096, L + NS_CMP + 32768 + ct * 8192 + wid * 1024); }
        VM_DRAIN_SYNC();
        const int cm = (qpos >= 31) ? ((qpos - 31) >> 4) : -1;
        Flash<2> F; F.reset();
        for (int ct = 0; ct < ntc; ++ct) {
            f32x16 p0, p1;
            qkt(p0, p1, L + NS_CMP + ct * 8192, koff, qr);
            const int x = cm - 64 * ct - 4 * hi;
#pragma unroll
            for (int r = 0; r < 16; ++r) { if (ccol(r) > x) p0[r] = -INFINITY; if (ccol(r) + 32 > x) p1[r] = -INFINITY; }
            F.tile(p0, p1, L + NS_CMP + 32768 + ct * 8192, wsf, lane, r32, hi);
        }
        const float lt = F.ltot();
        const float il = lt > 0.f ? 1.f / lt : 0.f;
        LAS float* Gs = (LAS float*)(L + NS_GL) + wid * 1024;
        LAS float* Ls = Gs + 512;
        for (int ct = 0; ct < ntc; ++ct) {
            f32x16 p0, p1;
            qkt(p0, p1, L + NS_CMP + ct * 8192, koff, qr);
            const int x = cm - 64 * ct - 4 * hi;
#pragma unroll
            for (int r = 0; r < 16; ++r) {
                float a = (ccol(r) > x) ? 0.f : __builtin_amdgcn_exp2f(p0[r] - F.mhat) * il, bq = (ccol(r) + 32 > x) ? 0.f : __builtin_amdgcn_exp2f(p1[r] - F.mhat) * il;
                a += __shfl_xor(a, 8); a += __shfl_xor(a, 16); bq += __shfl_xor(bq, 8); bq += __shfl_xor(bq, 16);
                p0[r] = a; p1[r] = bq; }
            if (r32 < 8) {
#pragma unroll
                for (int k = 0; k < 4; ++k) { const int jj = 16 * ct + 2 * k + hi;
                    Gs[r32 * 64 + jj] = (p0[4 * k] + p0[4 * k + 1]) + (p0[4 * k + 2] + p0[4 * k + 3]); Ls[r32 * 64 + jj] = p0[4 * k + 3];
                    Gs[r32 * 64 + jj + 8] = (p1[4 * k] + p1[4 * k + 1]) + (p1[4 * k + 2] + p1[4 * k + 3]); Ls[r32 * 64 + jj + 8] = p1[4 * k + 3]; }
            }
        }
        asm volatile("s_waitcnt lgkmcnt(0)" ::: "memory");
        const int j = lane, jmax = 16 * ntc;
        for (int qi = 0; qi < 8; ++qi) {
            float v = (j < jmax) ? Gs[qi * 64 + j] : 0.f;
            if (j >= 1 && j - 1 < jmax) v += Ls[qi * 64 + j - 1];
            if (j == 0 || j == qblk || j == qblk - 1) v = 1e9f;
            if (j > qblk) v = -1e30f;
            unsigned key = __float_as_uint(v); key = (key & 0x80000000u) ? ~key : (key | 0x80000000u);
            unsigned long long C = ~0ull; int kk = 16;
            for (int bit = 31; bit >= 0; --bit) {
                const unsigned long long bs = __ballot((key >> bit) & 1u) & C;
                const int c1 = __popcll(bs);
                if (c1 >= kk) C = bs; else { kk -= c1; C &= ~bs; }
            }
            const unsigned Tk = (unsigned)__builtin_amdgcn_readlane((int)key, (int)__builtin_ctzll(C));
            unsigned long long selm = __ballot(key > Tk);
            for (int i = 0; i < kk; ++i) { const unsigned long long low = C & (0ull - C); selm |= low; C ^= low; }
            const unsigned long long m = selm & ((qblk >= 63) ? ~0ull : ((1ull << (qblk + 1)) - 1ull));
            if ((r32 & 7) == qi) mymask = m;
        }
        asm volatile("s_waitcnt lgkmcnt(0)" ::: "memory");
        __syncthreads();
        row_bcast(g0 * il, fr_, wsf, r32, hi);
#pragma unroll
        for (int d = 0; d < 2; ++d)
#pragma unroll
            for (int r = 0; r < 16; ++r) yst[crow(r, hi) * 64 + d * 32 + r32] = F.o[d][r] * fr_[r];
    }
    const size_t ksrc = pg * S * 64 + ksrc_off(wid, lane);
    const size_t voff = (pg * S + 16 * (wid & 3) + (lane >> 2)) * 64 + (wid >> 2) * 32 + (lane & 3) * 8;
    {
        Flash<2> F; F.reset();
        nsa_kv_pass<1>(L, F, qr, koff, (const bf16_t*)(ws + WS_KS) + ksrc, (const bf16_t*)(ws + WS_VS) + voff, 0, qblk, qblk, ql, mymask, wsf, wid, lane, r32, hi);
        const float lt = F.ltot();
        row_bcast(g1 / lt, fr_, wsf, r32, hi);
#pragma unroll
        for (int d = 0; d < 2; ++d)
#pragma unroll
            for (int r = 0; r < 16; ++r) yst[crow(r, hi) * 64 + d * 32 + r32] += F.o[d][r] * fr_[r];
    }
    {
        Flash<2> F; F.reset();
        const int jlo = qblk >= 8 ? qblk - 8 : 0;
        nsa_kv_pass<2>(L, F, qr, koff, (const bf16_t*)(ws + WS_KW) + ksrc, (const bf16_t*)(ws + WS_VW) + voff, jlo, qblk, qblk, ql, 0ull, wsf, wid, lane, r32, hi);
        const float lt = F.ltot();
        row_bcast(g2 / lt, fr_, wsf, r32, hi);
        LAS bf16_t* stg = (LAS bf16_t*)(L + NS_GL) + wid * 2048;
#pragma unroll
        for (int r = 0; r < 16; ++r) { const int orow = crow(r, hi);
#pragma unroll
            for (int d = 0; d < 2; ++d) { const float yv = yst[orow * 64 + d * 32 + r32] + F.o[d][r] * fr_[r]; stg[orow * 64 + d * 32 + r32] = (bf16_t)(cvtpk(yv, 0.f) & 0xffffu); } }
        asm volatile("s_waitcnt lgkmcnt(0)" ::: "memory");
        bf16_t* Yb = (bf16_t*)(ws + WS_YB);
#pragma unroll
        for (int i = 0; i < 4; ++i) { const int row = i * 8 + (lane >> 3), ch = lane & 7; const u32x4 v = *(const LAS u32x4*)(stg + row * 64 + ch * 8);
            *(u32x4*)(Yb + ((size_t)b * S + 64 * qblk + 8 * wid + (row & 7)) * 512 + (g * 4 + (row >> 3)) * 64 + ch * 8) = v; }
    }
    __syncthreads();
}

#define XB_TMO      128
#define XB_XCNT(j)  (256  + 64 * (j))
#define XB_XSUB(j)  (1280 + 64 * (j))
#define XB_XGEN(j)  (2304 + 64 * (j))
#define XB_TOP      3328
#define XB_TOPGEN   3392
#define XCD_BAR_WORDS 3456
#define XB_SPIN_CAP (1u << 18)

__device__ __forceinline__ unsigned xb_ld(unsigned* p)              { return __hip_atomic_load(p, __ATOMIC_RELAXED, __HIP_MEMORY_SCOPE_AGENT); }
__device__ __forceinline__ unsigned xb_add(unsigned* p, unsigned v) { return __hip_atomic_fetch_add(p, v, __ATOMIC_RELAXED, __HIP_MEMORY_SCOPE_AGENT); }
__device__ __forceinline__ unsigned xb_xcc_id() { return (unsigned)__builtin_amdgcn_s_getreg((3 << 11) | 20) & 0xFu; }
#define XB_SPIN(cond, bar) do { unsigned _sp = 0; while (cond) { __builtin_amdgcn_s_sleep(1); \
    if ((++_sp & 255u) == 0u) { if (xb_ld(&(bar)[XB_TMO])) break; if (_sp > XB_SPIN_CAP) { atomicAdd(&(bar)[XB_TMO], 1u); break; } } } } while (0)

struct XcdBarrier {
    unsigned* bar; unsigned x;
    volatile LAS unsigned* st;
    bool lead;
};

__device__ __forceinline__ XcdBarrier xcd_barrier_post(unsigned* bar, volatile LAS unsigned* st, bool lead) {
    XcdBarrier b; b.bar = bar; b.x = xb_xcc_id(); b.st = st; b.lead = lead;
    if (b.lead && lane_id() == 0) (void)xb_add(&bar[XB_XCNT(b.x)], 1u);
    return b;
}
__device__ __forceinline__ void xcd_barrier_complete(unsigned* bar, unsigned x, unsigned& nloc, unsigned& nx) {
    const unsigned G = gridDim.x * gridDim.y * gridDim.z;
    unsigned sum, cnt, mine, sp = 0u;
    for (;;) {
        sum = 0u; cnt = 0u; mine = 0u;
#pragma unroll
        for (unsigned j = 0; j < 16; ++j) { const unsigned c = xb_ld(&bar[XB_XCNT(j)]); sum += c; cnt += (c > 0u) ? 1u : 0u; mine = (j == x) ? c : mine; }
        if (sum == G) break;
        __builtin_amdgcn_s_sleep(1);
        if ((++sp & 255u) == 0u) { if (xb_ld(&bar[XB_TMO])) break; if (sp > XB_SPIN_CAP) { atomicAdd(&bar[XB_TMO], 1u); break; } }
    }
    nloc = mine > 0u ? mine : 1u; nx = cnt > 0u ? cnt : 1u;
}

__device__ __forceinline__ void xcd_barrier(const XcdBarrier& b) {
    asm volatile("s_waitcnt vmcnt(0)" ::: "memory");
    __syncthreads();
    if (b.lead && lane_id() == 0) {
        unsigned* bar = b.bar;
        __builtin_amdgcn_s_waitcnt(0);
        unsigned nloc = b.st[0], nx = b.st[1];
        if (nloc == 0u) { xcd_barrier_complete(bar, b.x, nloc, nx); b.st[0] = nloc; b.st[1] = nx; }
        const unsigned old = xb_add(&bar[XB_XSUB(b.x)], 1u);
        const unsigned gen = old / nloc;
        if (old + 1u == (gen + 1u) * nloc) {
            __builtin_amdgcn_fence(__ATOMIC_RELEASE, "agent");
            asm volatile("s_waitcnt vmcnt(0)" ::: "memory");
            const unsigned og = xb_add(&bar[XB_TOP], 1u);
            const unsigned tg = og / nx;
            if (og + 1u == (tg + 1u) * nx) xb_add(&bar[XB_TOPGEN], 1u);
            else XB_SPIN(xb_ld(&bar[XB_TOPGEN]) == tg, bar);
            __builtin_amdgcn_fence(__ATOMIC_ACQUIRE, "agent");
            xb_add(&bar[XB_XGEN(b.x)], 1u);
            asm volatile("s_waitcnt vmcnt(0)" ::: "memory");
        } else {
            XB_SPIN(xb_ld(&bar[XB_XGEN(b.x)]) == gen, bar);
            __builtin_amdgcn_fence(__ATOMIC_ACQUIRE, "agent");
            asm volatile("s_waitcnt vmcnt(0)" ::: "memory");
        }
    }
    __syncthreads();
}


template <class MapF>
__device__ __forceinline__ void tr_item(const float* W, int K, int N, int ldw, bf16_t* WT, const float* kscale, LAS float* scr, int item, int lane, const MapF& map) {
    const int nblk = (N + 31) / 32, kb = item / nblk, nb = item % nblk, k0 = 64 * kb, n0 = 32 * nb;
    const int nn = n0 + (lane & 31);
#pragma unroll 8
    for (int i = 0; i < 32; ++i) { const int kk = 2 * i + (lane >> 5); float v = (nn < N) ? W[(size_t)(k0 + kk) * ldw + nn] : 0.f; if (kscale) v *= kscale[k0 + kk]; scr[kk * 33 + (lane & 31)] = v; }
    asm volatile("s_waitcnt lgkmcnt(0)" ::: "memory");
    const int c = lane & 7;
#pragma unroll
    for (int jx = 0; jx < 4; ++jx) { const int n = (lane >> 3) + 8 * jx; const LAS float* s = scr + (8 * c) * 33 + n;
        u32x4 o; o.x = cvtpk(s[0 * 33], s[1 * 33]); o.y = cvtpk(s[2 * 33], s[3 * 33]); o.z = cvtpk(s[4 * 33], s[5 * 33]); o.w = cvtpk(s[6 * 33], s[7 * 33]);
        if (n0 + n < N) *(u32x4*)(WT + (size_t)map(n0 + n) * K + k0 + 8 * c) = o; }
    asm volatile("s_waitcnt lgkmcnt(0)" ::: "memory");
}
__device__ __forceinline__ int rope_pos(int d) { return d < 32 ? 8 * (d >> 2) + (d & 3) : 8 * ((d - 32) >> 2) + 4 + (d & 3); }
struct MapIn {
    __device__ __forceinline__ int operator()(int n) const {
        if (n >= 2840) return 2816 + (n - 2840);
        if (n >= 2816) return 4864 + (n - 2816);
        bool rope;
        if (n < 1024) rope = true; else if (n < 1536) rope = false; else if (n < 2048) rope = true; else rope = (((n - 2048) >> 7) & 1) == 0;
        return rope ? (n & ~63) + rope_pos(n & 63) : n;
    }
};
struct MapId { int off; __device__ __forceinline__ int operator()(int n) const { return off + n; } };
struct MapGU { int up; __device__ __forceinline__ int operator()(int f) const { return 8 * (f >> 2) + 4 * up + (f & 3); } };

__device__ __forceinline__ int queue_fetch(unsigned* qbase, unsigned x, LAS int* kstate) {
    int k = *kstate;
    while (k < 8) { const unsigned q = (x + (unsigned)k) & 7u; const unsigned li = atomicAdd(qbase + 64 * q, 1u); if (li < 128u) { *kstate = k; return (int)(q * 128u + li); } ++k; }
    *kstate = k; return -1;
}
struct Args { const void* in[20]; float* out; unsigned char* ws; int use_cg; int pad; };

__global__ void __launch_bounds__(512, 2) hybrid_fwd(Args args) {
    extern __shared__ __attribute__((aligned(16))) unsigned char lds_raw[];
    LAS unsigned char* L = (LAS unsigned char*)lds_raw;
    cg::grid_group grid = cg::this_grid();
    const int wave_s = __builtin_amdgcn_readfirstlane((int)(threadIdx.x >> 6));
#define PHASE_IDS() int tid_ = wave_s * 64 + lane_id(); asm volatile("" : "+v"(tid_)); const int tid = tid_, lane = tid & 63, wave = __builtin_amdgcn_readfirstlane(tid >> 6); (void)lane; (void)wave
    const int G = gridDim.x, bx = blockIdx.x;
    unsigned char* ws = args.ws;
    const float* x = (const float*)args.in[0];
    const int* positions = (const int*)args.in[1];
    float* out = args.out;
    unsigned* ctl = (unsigned*)(ws + WS_CTL);
    LAS int* misc = (LAS int*)(L + LDS_BYTES - 64);
    { const int t0 = wave_s * 64 + lane_id(); if (t0 < 16) misc[t0] = 0; }
    __syncthreads();
    const XcdBarrier xbar = xcd_barrier_post(ctl + 4096, (volatile LAS unsigned*)(misc + 8), wave_s == 0);

    {
        PHASE_IDS();
        LAS float* scr = (LAS float*)(L + wave * 16384);
        const int gw = bx * 8 + wave, NGW = G * 8;
        const float* g1 = (const float*)args.in[2]; const float* g2 = (const float*)args.in[15];
        constexpr int I_IN = 16 * 153, I_G = 16 * 88, I_D = 44 * 32, I_O = 16 * 32, I_A = 8 * 32, I_C = 16 * 8;
        constexpr int NIT = I_IN + 2 * I_G + I_D + I_O + 2 * I_A + 4 * I_C;
        for (int it = gw; it < NIT; it += NGW) {
            int r = it;
            if (r < I_IN) { tr_item((const float*)args.in[3], 1024, 4888, 4888, (bf16_t*)(ws + WS_WIN), g1, scr, r, lane, MapIn{}); continue; } r -= I_IN;
            if (r < I_G) { tr_item((const float*)args.in[16], 1024, FF, FF, (bf16_t*)(ws + WS_WGU), g2, scr, r, lane, MapGU{0}); continue; } r -= I_G;
            if (r < I_G) { tr_item((const float*)args.in[17], 1024, FF, FF, (bf16_t*)(ws + WS_WGU), g2, scr, r, lane, MapGU{1}); continue; } r -= I_G;
            if (r < I_D) { tr_item((const float*)args.in[18], FF, 1024, 1024, (bf16_t*)(ws + WS_WD), nullptr, scr, r, lane, MapId{0}); continue; } r -= I_D;
            if (r < I_O) { tr_item((const float*)args.in[14], 1024, 1024, 1024, (bf16_t*)(ws + WS_WO), nullptr, scr, r, lane, MapId{0}); continue; } r -= I_O;
            if (r < I_A) { tr_item((const float*)args.in[12], 512, 1024, 1024, (bf16_t*)(ws + WS_WA), nullptr, scr, r, lane, MapId{0}); continue; } r -= I_A;
            if (r < I_A) { tr_item((const float*)args.in[13], 512, 1024, 1024, (bf16_t*)(ws + WS_WB), nullptr, scr, r, lane, MapId{0}); continue; } r -= I_A;
            if (r < I_C) { tr_item((const float*)args.in[8], 1024, 256, 256, (bf16_t*)(ws + WS_W1K), nullptr, scr, r, lane, MapId{0}); continue; } r -= I_C;
            if (r < I_C) { tr_item((const float*)args.in[8] + 1024 * 256, 1024, 256, 256, (bf16_t*)(ws + WS_W1K), nullptr, scr, r, lane, MapId{256}); continue; } r -= I_C;
            if (r < I_C) { tr_item((const float*)args.in[10], 1024, 256, 256, (bf16_t*)(ws + WS_W1V), nullptr, scr, r, lane, MapId{0}); continue; } r -= I_C;
            tr_item((const float*)args.in[10] + 1024 * 256, 1024, 256, 256, (bf16_t*)(ws + WS_W1V), nullptr, scr, r, lane, MapId{256});
        }
        bf16_t* XB = (bf16_t*)(ws + WS_XB); float* rs1 = (float*)(ws + WS_RS1);
        float* cosT = (float*)(ws + WS_COS); float* sinT = (float*)(ws + WS_SIN);
        const float invf = 1.0f / powf(10000.0f, (float)(2 * (lane & 31)) / 64.0f);
        for (int m = gw; m < T; m += NGW) {
            const f32x4* xr = (const f32x4*)(x + (size_t)m * D) + lane;
            f32x4 v[4]; float s = 0.f;
#pragma unroll
            for (int jx = 0; jx < 4; ++jx) { v[jx] = xr[64 * jx]; s += (v[jx][0] * v[jx][0] + v[jx][1] * v[jx][1]) + (v[jx][2] * v[jx][2] + v[jx][3] * v[jx][3]); }
            s = wave_sum(s);
            if (lane == 0) rs1[m] = rsqrtf(s * (1.f / D) + EPS);
            u32x2* o8 = (u32x2*)(XB + (size_t)m * D) + lane;
#pragma unroll
            for (int jx = 0; jx < 4; ++jx) { u32x2 w; w.x = cvtpk(v[jx][0], v[jx][1]); w.y = cvtpk(v[jx][2], v[jx][3]); o8[64 * jx] = w; }
            const float ang = (float)positions[m] * invf;
            if (lane < 32) cosT[(size_t)m * 32 + lane] = cosf(ang); else sinT[(size_t)m * 32 + (lane - 32)] = sinf(ang);
        }
        if (bx < 32) {
            const int kv = bx >> 4, slab = bx & 15;
            const float* pe = (const float*)args.in[kv ? 7 : 6]; const float* W1 = (const float*)args.in[kv ? 10 : 8];
            const int n = tid & 255, half = tid >> 8; float acc = 0.f;
            for (int k = slab * 128 + half * 64; k < slab * 128 + half * 64 + 64; ++k) acc += pe[k] * W1[(size_t)k * 256 + n];
            __syncthreads();
            LAS float* red = (LAS float*)L;
            if (half) red[n] = acc;
            __syncthreads();
            if (!half) ((float*)(ws + WS_BIASP))[(kv * 16 + slab) * 256 + n] = acc + red[n];
            __syncthreads();
        }
    }
    if (args.use_cg) grid.sync(); else xcd_barrier(xbar);
    {
        pg8::Gemm g{(const bf16_t*)(ws + WS_XB), (const bf16_t*)(ws + WS_WIN), T, INP, D}; pg8::StaticOrder SO; SO.init(T, INP, G, bx);
        EpiProj E{(const float*)(ws + WS_RS1), (const float*)(ws + WS_COS), (const float*)(ws + WS_SIN), ws};
        pg8::gemm_phase<EpiProj, true>(L, g, SO, E, wave_s);
    }
    xcd_barrier(xbar);
    {
        PHASE_IDS();
        { pg8::Gemm g{(const bf16_t*)(ws + WS_KC), (const bf16_t*)(ws + WS_W1K), 4096, 512, 1024}; pg8::StaticOrder SO; SO.init(4096, 512, G, bx);
          EpiF32 E{(float*)(ws + WS_GK), 512}; pg8::gemm_phase<EpiF32, true>(L, g, SO, E, wave_s); }
        { pg8::Gemm g{(const bf16_t*)(ws + WS_VC), (const bf16_t*)(ws + WS_W1V), 4096, 512, 1024}; pg8::StaticOrder SO; SO.init(4096, 512, G, (bx + G - 32) % G);
          EpiF32 E{(float*)(ws + WS_GV), 512}; pg8::gemm_phase<EpiF32, true>(L, g, SO, E, wave_s); }
        __syncthreads();
        const float* lf = (const float*)args.in[4];
        float sa = 0.f, sb = 0.f;
        for (int d = 0; d < 64; ++d) { sa += lf[d] * lf[64 + d]; sb += lf[128 + d] * lf[192 + d]; }
        const float lam = __uint_as_float((unsigned)__builtin_amdgcn_readfirstlane((int)__float_as_uint(expf(sa) - expf(sb) + LAM_INIT)));
        if (wave_s == 0 && lane_id() == 0) misc[1] = 0;
        for (;;) {
            if (wave_s == 0 && lane_id() == 0) misc[0] = queue_fetch(ctl + 512, xbar.x & 7u, misc + 1);
            __syncthreads();
            const int idx = misc[0];
            __syncthreads();
            if (idx < 0) break;
            const int li = idx & 127, qb = 31 - (li >> 2), bh = (idx >> 7) * 4 + (li & 3);
            diff_unit(L, bh >> 2, bh & 3, qb, ws, lam, (const float*)args.in[5], wave_s);
        }
    }
    xcd_barrier(xbar);
    {
        PHASE_IDS();
        LAS float* hid = (LAS float*)L;
        LAS float* bias = hid + 4096;
        for (int un = bx; un < 512; un += G) {
            const int kv = un >> 8, p = (un >> 4) & 15, rb = un & 15;
            const float* Gm = (const float*)(ws + (kv ? WS_GV : WS_GK));
            const float* w2 = (const float*)args.in[kv ? 11 : 9];
            if (tid < 256) { float a = 0.f; const float* bp = (const float*)(ws + WS_BIASP) + kv * 16 * 256 + tid;
#pragma unroll
                for (int s = 0; s < 16; ++s) a += bp[s * 256]; bias[tid] = a; }
            __syncthreads();
#pragma unroll
            for (int i = 0; i < 8; ++i) { const int e = tid + 512 * i, r = e >> 8, k = e & 255, c = 16 * rb + r; const size_t R = (size_t)p * 256 + c;
                float v = Gm[R * 512 + k] + bias[k]; if (c < 255) v += Gm[(R + 1) * 512 + 256 + k];
                hid[r * 256 + k] = v / (1.f + __expf(-v)); }
            __syncthreads();
            const int d = tid & 63, r0 = tid >> 6; float a0 = 0.f, a1 = 0.f;
#pragma unroll 8
            for (int k = 0; k < 256; ++k) { const float w = w2[k * 64 + d]; a0 += hid[r0 * 256 + k] * w; a1 += hid[(r0 + 8) * 256 + k] * w; }
            bf16_t* O = (bf16_t*)(ws + (kv ? WS_VCMP : WS_KCMP)) + ((size_t)p * 256 + 16 * rb) * 64;
            O[r0 * 64 + d] = (bf16_t)(cvtpk(a0, 0.f) & 0xffffu); O[(r0 + 8) * 64 + d] = (bf16_t)(cvtpk(a1, 0.f) & 0xffffu);
            __syncthreads();
        }
    }
    xcd_barrier(xbar);
    {
        PHASE_IDS();
        if (wave_s == 0 && lane_id() == 0) misc[1] = 0;
        for (;;) {
            if (wave_s == 0 && lane_id() == 0) misc[0] = queue_fetch(ctl + 1024, xbar.x & 7u, misc + 1);
            __syncthreads();
            const int idx = misc[0];
            __syncthreads();
            if (idx < 0) break;
            const int li = idx & 127, qblk = 63 - (li >> 1), pgx = (idx >> 7) * 2 + (li & 1);
            nsa_unit(L, pgx >> 1, pgx & 1, qblk, ws, wave_s);
        }
    }
    xcd_barrier(xbar);
    {
        { pg8::Gemm g{(const bf16_t*)(ws + WS_YA), (const bf16_t*)(ws + WS_WA), T, D, 512}; pg8::StaticOrder SO; SO.init(T, D, G, bx);
          EpiBranch<false> E{(bf16_t*)(ws + WS_XB), (const bf16_t*)(ws + WS_MG)}; pg8::gemm_phase<EpiBranch<false>, true>(L, g, SO, E, wave_s); }
        __syncthreads();
        { pg8::Gemm g{(const bf16_t*)(ws + WS_YB), (const bf16_t*)(ws + WS_WB), T, D, 512}; pg8::StaticOrder SO; SO.init(T, D, G, bx);
          EpiBranch<true> E{(bf16_t*)(ws + WS_XB), (const bf16_t*)(ws + WS_MG)}; pg8::gemm_phase<EpiBranch<true>, true>(L, g, SO, E, wave_s); }
    }
    xcd_barrier(xbar);
    {
        pg8::Gemm g{(const bf16_t*)(ws + WS_XB), (const bf16_t*)(ws + WS_WO), T, D, D}; pg8::StaticOrder SO; SO.init(T, D, G, bx);
        EpiResid<false> E{(const void*)x, (bf16_t*)(ws + WS_YA), (float*)(ws + WS_SSQ2)};
        pg8::gemm_phase<EpiResid<false>, true>(L, g, SO, E, wave_s);
    }
    xcd_barrier(xbar);
    {
        pg8::Gemm g{(const bf16_t*)(ws + WS_YA), (const bf16_t*)(ws + WS_WGU), T, FF2, D}; pg8::StaticOrder SO; SO.init(T, FF2, G, bx);
        EpiGU E{(const float*)(ws + WS_SSQ2), (bf16_t*)(ws + WS_ACT)};
        pg8::gemm_phase<EpiGU, true>(L, g, SO, E, wave_s);
    }
    xcd_barrier(xbar);
    {
        pg8::Gemm g{(const bf16_t*)(ws + WS_ACT), (const bf16_t*)(ws + WS_WD), T, D, FF}; pg8::StaticOrder SO; SO.init(T, D, G, bx);
        EpiResid<true> E{(const void*)(ws + WS_YA), (bf16_t*)(ws + WS_XB), (float*)(ws + WS_SSQ3)};
        pg8::gemm_phase<EpiResid<true>, true>(L, g, SO, E, wave_s);
    }
    xcd_barrier(xbar);
    {
        PHASE_IDS();
        const float* gf = (const float*)args.in[19]; const float* SSQ3 = (const float*)(ws + WS_SSQ3);
        const int gw = bx * 8 + wave, NGW = G * 8;
        f32x4 gv[4];
#pragma unroll
        for (int jx = 0; jx < 4; ++jx) gv[jx] = ((const f32x4*)gf)[lane + 64 * jx];
        for (int m = gw; m < T; m += NGW) {
            float s = (lane < 16) ? SSQ3[(size_t)m * 16 + lane] : 0.f;
            s = wave_sum(s);
            const float rs = rsqrtf(s * (1.f / D) + EPS);
            const u32x2* hr = (const u32x2*)((const bf16_t*)(ws + WS_XB) + (size_t)m * D) + lane;
            f32x4* xr = (f32x4*)(out + (size_t)m * D) + lane;
#pragma unroll
            for (int jx = 0; jx < 4; ++jx) { const u32x2 w = hr[64 * jx]; f32x4 v = {bflo(w.x), bfhi(w.x), bflo(w.y), bfhi(w.y)}; v = v * rs * gv[jx]; xr[64 * jx] = v; }
        }
    }
}

extern "C" void kernel_launch(void* const* d_in, const int* in_sizes, int n_in, void* d_out, int out_size, void* d_ws, size_t ws_size, hipStream_t stream) {
    static int grid = 0;
    if (grid == 0) {
        if (n_in != 20 || out_size != T * D || ws_size < WS_END) { fprintf(stderr, "kernel_launch: unexpected shapes (n_in %d out %d ws %zu)\n", n_in, out_size, ws_size); grid = -1; return; }
        int dev = 0, cus = 0, per_cu = 0;
        hipGetDevice(&dev);
        hipDeviceGetAttribute(&cus, hipDeviceAttributeMultiprocessorCount, dev);
        hipFuncSetAttribute((const void*)hybrid_fwd, hipFuncAttributeMaxDynamicSharedMemorySize, LDS_BYTES);
        hipOccupancyMaxActiveBlocksPerMultiprocessor(&per_cu, (const void*)hybrid_fwd, 512, LDS_BYTES);
        if (per_cu < 1) { fprintf(stderr, "kernel_launch: occupancy query says %d blocks per CU\n", per_cu); per_cu = 1; }
        (void)hipGetLastError();
        grid = cus * per_cu;
    }
    if (grid < 0) return;
    hipMemsetAsync((char*)d_ws + WS_CTL, 0, 32768, stream);
    Args a{};
    for (int i = 0; i < 20; ++i) a.in[i] = d_in[i];
    a.out = (float*)d_out; a.ws = (unsigned char*)d_ws;
    void* params[] = {&a};
    hipError_t e = hipLaunchCooperativeKernel((const void*)hybrid_fwd, dim3(grid), dim3(512), params, LDS_BYTES, stream);
    if (e != hipSuccess) fprintf(stderr, "cooperative launch failed: %s (grid %d)\n", hipGetErrorString(e), grid);
}
```

```cpp
#include <hip/hip_runtime.h>
#include <hip/hip_cooperative_groups.h>
#include <cstdint>
#include <cstdio>
#include <type_traits>
namespace cg = cooperative_groups;

#define LAS __attribute__((address_space(3)))
typedef unsigned short bf16_t;
typedef short bf16x8 __attribute__((ext_vector_type(8)));
typedef short s16x4 __attribute__((ext_vector_type(4)));
typedef float f32x4 __attribute__((ext_vector_type(4)));
typedef float f32x2 __attribute__((ext_vector_type(2)));
typedef float f32x16 __attribute__((ext_vector_type(16)));
typedef unsigned u32x4 __attribute__((ext_vector_type(4)));
typedef unsigned u32x2 __attribute__((ext_vector_type(2)));
typedef __bf16 bf16x2_t __attribute__((ext_vector_type(2)));

constexpr int NB = 8, S = 4096, T = NB * S, D = 1024, FF = 2816, FF2 = 2 * FF, INP = 5120;
constexpr float EPS = 1e-6f;
constexpr float C2 = 0.125f * 1.4426950408889634f;
constexpr float LAM_INIT = 0.2f;

constexpr size_t MiB = 1u << 20;
constexpr size_t WS_CTL = 0;
constexpr size_t WS_WIN = 1 * MiB, WS_WGU = 11 * MiB, WS_WD = 22 * MiB, WS_WO = 28 * MiB, WS_WA = 30 * MiB, WS_WB = 31 * MiB, WS_W1K = 32 * MiB, WS_W1V = 33 * MiB;
constexpr size_t WS_COS = 34 * MiB, WS_SIN = 38 * MiB;
constexpr size_t WS_RS1 = 42 * MiB, WS_SSQ2 = 43 * MiB, WS_SSQ3 = 45 * MiB, WS_NG = 47 * MiB, WS_BIASP = 50 * MiB;
constexpr size_t WS_GK = 52 * MiB, WS_GV = 60 * MiB, WS_KCMP = 68 * MiB, WS_VCMP = 69 * MiB;
constexpr size_t WS_XB = 70 * MiB;
constexpr size_t WS_DQ = 134 * MiB, WS_DK = 166 * MiB, WS_DV = 198 * MiB, WS_NQ = 230 * MiB;
constexpr size_t WS_KC = 262 * MiB, WS_VC = 270 * MiB, WS_KS = 278 * MiB, WS_VS = 286 * MiB, WS_KW = 294 * MiB, WS_VW = 302 * MiB;
constexpr size_t WS_ACT = 134 * MiB;
constexpr size_t WS_MG = 310 * MiB;
constexpr size_t WS_YA = 438 * MiB, WS_YB = 470 * MiB;
constexpr size_t WS_END = 502 * MiB;
constexpr int LDS_BYTES = 155648;

__device__ __forceinline__ unsigned cvtpk(float lo, float hi) { f32x2 v = {lo, hi}; bf16x2_t b = __builtin_convertvector(v, bf16x2_t); return __builtin_bit_cast(unsigned, b); }
__device__ __forceinline__ float bf2f(unsigned short h) { return __uint_as_float(((unsigned)h) << 16); }
__device__ __forceinline__ float bflo(unsigned w) { return __uint_as_float(w << 16); }
__device__ __forceinline__ float bfhi(unsigned w) { return __uint_as_float(w & 0xffff0000u); }
__device__ __forceinline__ float sigmoidf_(float x) { return __builtin_amdgcn_rcpf(1.f + __builtin_amdgcn_exp2f(x * -1.4426950408889634f)); }
__device__ __forceinline__ int lane_id() { unsigned z = 0u; asm volatile("" : "+v"(z)); return (int)__builtin_amdgcn_mbcnt_hi(~0u, __builtin_amdgcn_mbcnt_lo(~0u, z)); }
__device__ __forceinline__ float xor32_sum(float v) { auto rr = __builtin_amdgcn_permlane32_swap(__float_as_uint(v), __float_as_uint(v), false, false); return __uint_as_float(rr[0]) + __uint_as_float(rr[1]); }
__device__ __forceinline__ float xor32_max(float v) { auto rr = __builtin_amdgcn_permlane32_swap(__float_as_uint(v), __float_as_uint(v), false, false); return __builtin_fmaxf(__uint_as_float(rr[0]), __uint_as_float(rr[1])); }
__device__ __forceinline__ float wave_sum(float v) {
#pragma unroll
    for (int o = 1; o < 64; o <<= 1) v += __shfl_xor(v, o);
    return v;
}

namespace pg8 {
constexpr int BM = 256, BK = 64, HALF = 128, HTB = HALF * BK * 2, STAGE_BYTES = 8 * HTB, NXCD = 8, WGM = 8;
__host__ __device__ __forceinline__ int lds_byte(int r, int c) { const int st = (r >> 4) * 2 + (c >> 5), rr = r & 15, cc = c & 31, ob = rr * 64 + cc * 2; return st * 1024 + (ob ^ (((ob >> 9) & 1) << 5)); }
__host__ __device__ __forceinline__ void stage_rc(int b, int& R, int& C) { const int st = b / 1024, sb = b % 1024, swz = sb ^ (((sb >> 9) & 1) << 5); R = (st >> 1) * 16 + swz / 64; C = (st & 1) * 32 + (swz % 64) / 2; }
__host__ __device__ __forceinline__ int perm32(int rho) { const int n = rho >> 4, i = rho & 15; return 8 * (i >> 2) + 4 * n + (i & 3); }
struct Unit { int pm, pn; };
struct Gemm { const bf16_t* A; const bf16_t* Bt; int M, N, K; };
struct StaticOrder {
    int nM, nN, nwg, G, c;
    __host__ __device__ void init(int M, int N, int G_, int c_) { nM = M / BM; nN = N / BM; nwg = nM * nN; G = G_; c = c_; }
    __host__ __device__ bool next(int i, Unit& u) const {
        const long L = (long)i * G + c; if (L >= nwg) return false;
        int wgid = (int)L; { const int q = nwg / NXCD, r = nwg % NXCD, xcd = wgid % NXCD, off = wgid / NXCD; wgid = (xcd < r ? xcd * (q + 1) : r * (q + 1) + (xcd - r) * q) + off; }
        const int nig = WGM * nN, gid = wgid / nig, fm = gid * WGM, gsz = (nM - fm) < WGM ? (nM - fm) : WGM;
        u.pm = fm + ((wgid % nig) % gsz); u.pn = (wgid % nig) / gsz; return true;
    }
};
template <class Epi, bool ALIGN_EPI>
__device__ __forceinline__ void gemm_phase(LAS unsigned char* lds, const Gemm g, const StaticOrder& S, const Epi& E, int wv) {
    int tid_ = wv * 64 + lane_id(); asm volatile("" : "+v"(tid_));
    const int tid = tid_, wid = __builtin_amdgcn_readfirstlane(tid >> 6), lane = tid & 63, wr = wid >> 2, wc = wid & 3, fr = lane & 15, fq = lane >> 4;
    const int K = g.K, nt = K / BK;
    unsigned voffA[2], voffB[2];
#pragma unroll
    for (int i = 0; i < 2; ++i) { int R, C; stage_rc(tid * 16 + i * 8192, R, C); const int Rb = (R & ~31) + perm32(R & 31);
        voffA[i] = (unsigned)(R * K + C) * 2u; voffB[i] = (unsigned)(Rb * K + C) * 2u; }
    const size_t kstep = (size_t)(BK * 2);
    const size_t hstep = (size_t)HALF * K * 2;
    const size_t tstep = 2 * hstep;
    const unsigned ldsw = (unsigned)wid * 1024u;
    const int aoff = lds_byte(wr * 64 + fr, fq * 8), boff = lds_byte(wc * 32 + fr, fq * 8);
#define PG8_SA(b, h) (((b) * 2 + (h)) * HTB)
#define PG8_SB(b, h) ((4 + (b) * 2 + (h)) * HTB)
#define PG8_STAGE(bufoff, gbase, voff) do { _Pragma("unroll") for (int _i = 0; _i < 2; ++_i) \
        __builtin_amdgcn_global_load_lds((const unsigned*)((const char*)(gbase) + (voff)[_i]), (LAS unsigned*)(lds + (bufoff) + ldsw + _i * 8192), 16, 0, 0); } while (0)
#define PG8_LDA(dst, b, h) do { _Pragma("unroll") for (int m = 0; m < 4; ++m) _Pragma("unroll") for (int k = 0; k < 2; ++k) dst[m][k] = *(const LAS bf16x8*)(lds + PG8_SA(b, h) + aoff + m * 2048 + k * 1024); } while (0)
#define PG8_LDB(dst, b, h) do { _Pragma("unroll") for (int n = 0; n < 2; ++n) _Pragma("unroll") for (int k = 0; k < 2; ++k) dst[n][k] = *(const LAS bf16x8*)(lds + PG8_SB(b, h) + boff + n * 2048 + k * 1024); } while (0)
#define PG8_MMA(ai, bj, At, Bt) do { __builtin_amdgcn_s_setprio(1); _Pragma("unroll") for (int m = 0; m < 4; ++m) _Pragma("unroll") for (int n = 0; n < 2; ++n) _Pragma("unroll") for (int k = 0; k < 2; ++k) \
        acc[ai][bj][m][n] = __builtin_amdgcn_mfma_f32_16x16x32_bf16(Bt[n][k], At[m][k], acc[ai][bj][m][n], 0, 0, 0); __builtin_amdgcn_s_setprio(0); } while (0)
#define PG8_WAIT_V(n) asm volatile("s_waitcnt vmcnt(" #n ")" ::: "memory")
#define PG8_WAIT_L(n) asm volatile("s_waitcnt lgkmcnt(" #n ")" ::: "memory")
#define PG8_BAR __builtin_amdgcn_s_barrier()
#define PG8_SCHED __builtin_amdgcn_sched_barrier(0)
    Unit cur, nxt; int ui = 0;
    if (!S.next(0, cur)) return;
    f32x4 acc[2][2][4][2];
#pragma unroll
    for (int a = 0; a < 2; ++a)
#pragma unroll
        for (int b = 0; b < 2; ++b)
#pragma unroll
            for (int m = 0; m < 4; ++m)
#pragma unroll
                for (int n = 0; n < 2; ++n) acc[a][b][m][n] = (f32x4){0.f, 0.f, 0.f, 0.f};
    bf16x8 At[4][2], B0[2][2], B1[2][2];
    const char* cA = (const char*)g.A + (size_t)cur.pm * tstep; const char* cB = (const char*)g.Bt + (size_t)cur.pn * tstep;
    PG8_STAGE(PG8_SB(0, 0), cB, voffB); PG8_STAGE(PG8_SB(0, 1), cB + hstep, voffB); PG8_STAGE(PG8_SA(0, 0), cA, voffA); PG8_STAGE(PG8_SA(0, 1), cA + hstep, voffA);
    if (wr == 1) PG8_BAR;
    PG8_WAIT_V(2); PG8_BAR;
    PG8_STAGE(PG8_SB(1, 0), cB + kstep, voffB); PG8_STAGE(PG8_SA(1, 0), cA + kstep, voffA); PG8_STAGE(PG8_SB(1, 1), cB + hstep + kstep, voffB);
    PG8_WAIT_V(6); PG8_BAR;
    for (;;) {
        const bool has_next = S.next(ui + 1, nxt);
        const char* nA = has_next ? (const char*)g.A + (size_t)nxt.pm * tstep : cA; const char* nB = has_next ? (const char*)g.Bt + (size_t)nxt.pn * tstep : cB;
        for (int t = 0; t < nt; t += 2) {
            const bool last = (t == nt - 2);
            const char* a1 = cA + (size_t)(t + 1) * kstep;
            const char* a2 = last ? nA : cA + (size_t)(t + 2) * kstep; const char* b2 = last ? nB : cB + (size_t)(t + 2) * kstep;
            const char* a3 = a2 + kstep; const char* b3 = b2 + kstep;
            PG8_LDB(B0, 0, 0); PG8_LDB(B1, 0, 1); PG8_SCHED; PG8_LDA(At, 0, 0); PG8_STAGE(PG8_SA(1, 1), a1 + hstep, voffA);
            PG8_WAIT_V(8); PG8_WAIT_L(0); PG8_BAR; PG8_MMA(0, 0, At, B0); PG8_MMA(0, 1, At, B1); PG8_BAR; PG8_SCHED;
            PG8_LDA(At, 0, 1); PG8_STAGE(PG8_SB(0, 0), b2, voffB); PG8_STAGE(PG8_SB(0, 1), b2 + hstep, voffB); PG8_STAGE(PG8_SA(0, 0), a2, voffA);
            PG8_WAIT_V(8); PG8_WAIT_L(0); PG8_BAR; PG8_MMA(1, 0, At, B0); PG8_MMA(1, 1, At, B1); PG8_BAR; PG8_SCHED;
            PG8_LDB(B0, 1, 0); PG8_LDB(B1, 1, 1); PG8_SCHED; PG8_LDA(At, 1, 0); PG8_STAGE(PG8_SA(0, 1), a2 + hstep, voffA);
            PG8_WAIT_V(8); PG8_WAIT_L(0); PG8_BAR; PG8_MMA(0, 0, At, B0); PG8_MMA(0, 1, At, B1); PG8_BAR; PG8_SCHED;
            PG8_LDA(At, 1, 1); PG8_STAGE(PG8_SB(1, 0), b3, voffB); PG8_STAGE(PG8_SB(1, 1), b3 + hstep, voffB); PG8_STAGE(PG8_SA(1, 0), a3, voffA);
            PG8_WAIT_V(8); PG8_WAIT_L(0); PG8_BAR; PG8_MMA(1, 0, At, B0); PG8_MMA(1, 1, At, B1); PG8_BAR; PG8_SCHED;
        }
        if constexpr (ALIGN_EPI) { if (wr == 0) PG8_BAR; }
        E(acc, cur, wr, wc, fr, fq);
        if (!has_next) break;
#pragma unroll
        for (int a = 0; a < 2; ++a)
#pragma unroll
            for (int b = 0; b < 2; ++b)
#pragma unroll
                for (int m = 0; m < 4; ++m)
#pragma unroll
                    for (int n = 0; n < 2; ++n) acc[a][b][m][n] = (f32x4){0.f, 0.f, 0.f, 0.f};
        cur = nxt; cA = nA; cB = nB; ++ui;
        if constexpr (ALIGN_EPI) { if (wr == 1) PG8_BAR; }
    }
    PG8_WAIT_V(0);
    if constexpr (!ALIGN_EPI) { if (wr == 0) PG8_BAR; }
    PG8_BAR;
#undef PG8_SA
#undef PG8_SB
#undef PG8_STAGE
#undef PG8_LDA
#undef PG8_LDB
#undef PG8_MMA
#undef PG8_WAIT_V
#undef PG8_WAIT_L
#undef PG8_BAR
#undef PG8_SCHED
}
}

typedef f32x4 AccT[2][2][4][2];

struct EpiProj {
    const float* rs1; const float* cosT; const float* sinT;
    unsigned char* ws;
    __device__ __forceinline__ void operator()(const AccT& acc, const pg8::Unit& u, int wr, int wc, int fr, int fq) const {
        const int row0 = u.pm * 256 + wr * 64 + fr;
#pragma unroll
        for (int bj = 0; bj < 2; ++bj) {
            const int sec = u.pn * 2 + bj;
            if (sec >= 39) continue;
            if (sec == 38) {
                if (wc == 0 && fq < 3) {
                    float* NG = (float*)(ws + WS_NG);
#pragma unroll
                    for (int ai = 0; ai < 2; ++ai)
#pragma unroll
                        for (int m = 0; m < 4; ++m) { const int r = row0 + ai * 128 + m * 16; const float rs = rs1[r];
                            f32x4 v0 = acc[ai][bj][m][0] * rs, v1 = acc[ai][bj][m][1] * rs;
                            f32x4 o0, o1;
#pragma unroll
                            for (int i = 0; i < 4; ++i) { o0[i] = sigmoidf_(v0[i]); o1[i] = sigmoidf_(v1[i]); }
                            *(f32x4*)(NG + (size_t)r * 24 + fq * 8) = o0; *(f32x4*)(NG + (size_t)r * 24 + fq * 8 + 4) = o1; }
                }
                continue;
            }
            if (sec >= 22) {
                bf16_t* MG = (bf16_t*)(ws + WS_MG);
                const int col = (sec - 22) * 128 + wc * 32 + fq * 8;
#pragma unroll
                for (int ai = 0; ai < 2; ++ai)
#pragma unroll
                    for (int m = 0; m < 4; ++m) { const int r = row0 + ai * 128 + m * 16; const float rs = rs1[r];
                        f32x4 v0 = acc[ai][bj][m][0] * rs, v1 = acc[ai][bj][m][1] * rs;
                        u32x4 w; w.x = cvtpk(sigmoidf_(v0[0]), sigmoidf_(v0[1])); w.y = cvtpk(sigmoidf_(v0[2]), sigmoidf_(v0[3]));
                        w.z = cvtpk(sigmoidf_(v1[0]), sigmoidf_(v1[1])); w.w = cvtpk(sigmoidf_(v1[2]), sigmoidf_(v1[3]));
                        *(u32x4*)(MG + (size_t)r * 2048 + col) = w; }
                continue;
            }
            bf16_t* base; int H, head, HD, coff; bool rope; float scale = 1.f;
            if (sec < 4)       { base = (bf16_t*)(ws + WS_DQ); H = 4; head = sec;      HD = 128; coff = (wc >> 1) * 64; rope = true; scale = C2; }
            else if (sec < 8)  { base = (bf16_t*)(ws + WS_DK); H = 8; head = (sec - 4) * 2 + (wc >> 1); HD = 64; coff = 0; rope = true; }
            else if (sec < 12) { base = (bf16_t*)(ws + WS_DV); H = 4; head = sec - 8;  HD = 128; coff = (wc >> 1) * 64; rope = false; }
            else if (sec < 16) { base = (bf16_t*)(ws + WS_NQ); H = 8; head = (sec - 12) * 2 + (wc >> 1); HD = 64; coff = 0; rope = true; scale = C2; }
            else { const int k6 = sec - 16; base = (bf16_t*)(ws + WS_KC + (size_t)k6 * 8 * MiB); H = 2; head = wc >> 1; HD = 64; coff = 0; rope = (k6 & 1) == 0; }
            const int j = 4 * (wc & 1) + fq;
#pragma unroll
            for (int ai = 0; ai < 2; ++ai)
#pragma unroll
                for (int m = 0; m < 4; ++m) { const int r = row0 + ai * 128 + m * 16; const float rs = rs1[r] * scale;
                    const int b = r >> 12, s = r & 4095;
                    bf16_t* p = base + ((size_t)(b * H + head) * S + s) * HD + coff;
                    f32x4 v0 = acc[ai][bj][m][0] * rs, v1 = acc[ai][bj][m][1] * rs;
                    if (rope) {
                        const f32x4 c = *(const f32x4*)(cosT + (size_t)r * 32 + 4 * j), sn = *(const f32x4*)(sinT + (size_t)r * 32 + 4 * j);
                        const f32x4 o1 = v0 * c - v1 * sn, o2 = v1 * c + v0 * sn;
                        u32x2 w1, w2; w1.x = cvtpk(o1[0], o1[1]); w1.y = cvtpk(o1[2], o1[3]); w2.x = cvtpk(o2[0], o2[1]); w2.y = cvtpk(o2[2], o2[3]);
                        *(u32x2*)(p + 4 * j) = w1; *(u32x2*)(p + 32 + 4 * j) = w2;
                    } else {
                        u32x4 w; w.x = cvtpk(v0[0], v0[1]); w.y = cvtpk(v0[2], v0[3]); w.z = cvtpk(v1[0], v1[1]); w.w = cvtpk(v1[2], v1[3]);
                        *(u32x4*)(p + 8 * j) = w;
                    }
                }
        }
    }
};
struct EpiF32 {
    float* O; int ldc;
    __device__ __forceinline__ void operator()(const AccT& acc, const pg8::Unit& u, int wr, int wc, int fr, int fq) const {
        const int row0 = u.pm * 256 + wr * 64 + fr, col0 = u.pn * 256 + wc * 32 + fq * 8;
#pragma unroll
        for (int ai = 0; ai < 2; ++ai)
#pragma unroll
            for (int m = 0; m < 4; ++m)
#pragma unroll
                for (int bj = 0; bj < 2; ++bj) { float* p = O + (size_t)(row0 + ai * 128 + m * 16) * ldc + col0 + bj * 128;
                    *(f32x4*)p = acc[ai][bj][m][0]; *(f32x4*)(p + 4) = acc[ai][bj][m][1]; }
    }
};
template <bool SECOND> struct EpiBranch {
    bf16_t* MERGED; const bf16_t* MG;
    __device__ __forceinline__ void operator()(const AccT& acc, const pg8::Unit& u, int wr, int wc, int fr, int fq) const {
        const int row0 = u.pm * 256 + wr * 64 + fr, col0 = u.pn * 256 + wc * 32 + fq * 8;
#pragma unroll
        for (int ai = 0; ai < 2; ++ai)
#pragma unroll
            for (int m = 0; m < 4; ++m)
#pragma unroll
                for (int bj = 0; bj < 2; ++bj) { const int r = row0 + ai * 128 + m * 16, c = col0 + bj * 128;
                    const u32x4 g = *(const u32x4*)(MG + (size_t)r * 2048 + (SECOND ? 1024 : 0) + c);
                    const f32x4 a0 = acc[ai][bj][m][0], a1 = acc[ai][bj][m][1];
                    float o[8] = {bflo(g.x) * a0[0], bfhi(g.x) * a0[1], bflo(g.y) * a0[2], bfhi(g.y) * a0[3], bflo(g.z) * a1[0], bfhi(g.z) * a1[1], bflo(g.w) * a1[2], bfhi(g.w) * a1[3]};
                    bf16_t* p = MERGED + (size_t)r * 1024 + c;
                    if (SECOND) { const u32x4 pv = *(const u32x4*)p;
                        o[0] += bflo(pv.x); o[1] += bfhi(pv.x); o[2] += bflo(pv.y); o[3] += bfhi(pv.y); o[4] += bflo(pv.z); o[5] += bfhi(pv.z); o[6] += bflo(pv.w); o[7] += bfhi(pv.w); }
                    u32x4 w; w.x = cvtpk(o[0], o[1]); w.y = cvtpk(o[2], o[3]); w.z = cvtpk(o[4], o[5]); w.w = cvtpk(o[6], o[7]);
                    *(u32x4*)p = w; }
    }
};
template <bool BASE_BF> struct EpiResid {
    const void* base; bf16_t* HB; float* SSQ;
    __device__ __forceinline__ void operator()(const AccT& acc, const pg8::Unit& u, int wr, int wc, int fr, int fq) const {
        const int row0 = u.pm * 256 + wr * 64 + fr, col0 = u.pn * 256 + wc * 32 + fq * 8;
#pragma unroll
        for (int ai = 0; ai < 2; ++ai)
#pragma unroll
            for (int m = 0; m < 4; ++m) { const int r = row0 + ai * 128 + m * 16; float ss = 0.f;
#pragma unroll
                for (int bj = 0; bj < 2; ++bj) { const size_t off = (size_t)r * 1024 + col0 + bj * 128;
                    f32x4 b0, b1;
                    if (BASE_BF) { const u32x4 g = *(const u32x4*)((const bf16_t*)base + off); b0 = (f32x4){bflo(g.x), bfhi(g.x), bflo(g.y), bfhi(g.y)}; b1 = (f32x4){bflo(g.z), bfhi(g.z), bflo(g.w), bfhi(g.w)}; }
                    else { b0 = *(const f32x4*)((const float*)base + off); b1 = *(const f32x4*)((const float*)base + off + 4); }
                    const f32x4 h0 = b0 + acc[ai][bj][m][0], h1 = b1 + acc[ai][bj][m][1];
                    ss += (h0[0] * h0[0] + h0[1] * h0[1]) + (h0[2] * h0[2] + h0[3] * h0[3]) + (h1[0] * h1[0] + h1[1] * h1[1]) + (h1[2] * h1[2] + h1[3] * h1[3]);
                    u32x4 w; w.x = cvtpk(h0[0], h0[1]); w.y = cvtpk(h0[2], h0[3]); w.z = cvtpk(h1[0], h1[1]); w.w = cvtpk(h1[2], h1[3]); *(u32x4*)(HB + off) = w; }
                ss += __shfl_xor(ss, 16); ss += __shfl_xor(ss, 32);
                if (fq == 0) SSQ[(size_t)r * 16 + u.pn * 4 + wc] = ss; }
    }
};
struct EpiGU {
    const float* SSQ2; bf16_t* ACT;
    __device__ __forceinline__ void operator()(const AccT& acc, const pg8::Unit& u, int wr, int wc, int fr, int fq) const {
        const int row0 = u.pm * 256 + wr * 64 + fr, col0 = u.pn * 128 + wc * 16 + fq * 4;
#pragma unroll
        for (int ai = 0; ai < 2; ++ai)
#pragma unroll
            for (int m = 0; m < 4; ++m) { const int r = row0 + ai * 128 + m * 16;
                const f32x4* sp = (const f32x4*)(SSQ2 + (size_t)r * 16); const f32x4 s0 = sp[0], s1 = sp[1], s2 = sp[2], s3 = sp[3];
                const float tot = ((s0[0] + s0[1]) + (s0[2] + s0[3])) + ((s1[0] + s1[1]) + (s1[2] + s1[3])) + ((s2[0] + s2[1]) + (s2[2] + s2[3])) + ((s3[0] + s3[1]) + (s3[2] + s3[3]));
                const float rs = rsqrtf(tot * (1.f / 1024.f) + EPS);
#pragma unroll
                for (int bj = 0; bj < 2; ++bj) { const f32x4 gv = acc[ai][bj][m][0] * rs, uv = acc[ai][bj][m][1] * rs; float o[4];
#pragma unroll
                    for (int i = 0; i < 4; ++i) o[i] = gv[i] * sigmoidf_(gv[i]) * uv[i];
                    u32x2 w; w.x = cvtpk(o[0], o[1]); w.y = cvtpk(o[2], o[3]);
                    *(u32x2*)(ACT + (size_t)r * FF + col0 + bj * 64) = w; } }
    }
};

typedef std::integral_constant<bool, true> TrueC; typedef std::integral_constant<bool, false> FalseC;
__device__ __forceinline__ int crow(int r, int hi) { return (r & 3) + 8 * (r >> 2) + 4 * hi; }
__device__ __forceinline__ constexpr int ccol(int r) { return (r & 3) + 8 * (r >> 2); }
__device__ __forceinline__ void glds16(const void* g, LAS unsigned char* l) {
    unsigned keep; const unsigned dst = (unsigned)__builtin_amdgcn_readfirstlane((int)(unsigned)(uintptr_t)l);
    asm volatile("s_mov_b32 %0, m0\n\ts_mov_b32 m0, %2\n\ts_nop 0\n\tglobal_load_lds_dwordx4 %1, off\n\ts_mov_b32 m0, %0" : "=&s"(keep) : "v"(g), "s"(dst) : "memory");
}
#define VM_DRAIN_SYNC() do { asm volatile("s_waitcnt vmcnt(0)" ::: "memory"); __syncthreads(); } while (0)
#define WAIT_BAR(N) asm volatile("s_waitcnt vmcnt(" #N ") lgkmcnt(0)\n\ts_barrier" ::: "memory")
__device__ __forceinline__ void wait_bar_n(int n) { if (n == 4) WAIT_BAR(4); else if (n == 2) WAIT_BAR(2); else if (n == 1) WAIT_BAR(1); else WAIT_BAR(0); }
__device__ __forceinline__ int ksrc_off(int wid, int lane) { const int ip = (lane - 8 * (wid & 1)) & 63, rho = ip >> 3, c = (ip & 7) ^ rho; return (8 * wid + rho) * 64 + c * 8; }
__device__ __forceinline__ void kread_offs(int (&koff)[4], int r32, int hi) {
    const int pc = r32 >> 3, rho = r32 & 7;
#pragma unroll
    for (int d0 = 0; d0 < 4; ++d0) koff[d0] = pc * 1024 + (((rho * 8 + ((2 * d0 + hi) ^ rho) + 8 * (pc & 1)) & 63) << 4);
}
__device__ __forceinline__ void qkt(f32x16& p0, f32x16& p1, const LAS unsigned char* Kslot, const int (&koff)[4], const bf16x8* qr) {
    bf16x8 kf[8];
#pragma unroll
    for (int d0 = 0; d0 < 4; ++d0) { kf[2 * d0] = *(const LAS bf16x8*)(Kslot + koff[d0]); kf[2 * d0 + 1] = *(const LAS bf16x8*)(Kslot + koff[d0] + 4096); }
    const f32x16 zz = f32x16{};
    p0 = __builtin_amdgcn_mfma_f32_32x32x16_bf16(kf[0], qr[0], zz, 0, 0, 0); p1 = __builtin_amdgcn_mfma_f32_32x32x16_bf16(kf[1], qr[0], zz, 0, 0, 0);
#pragma unroll
    for (int d0 = 1; d0 < 4; ++d0) { p0 = __builtin_amdgcn_mfma_f32_32x32x16_bf16(kf[2 * d0], qr[d0], p0, 0, 0, 0); p1 = __builtin_amdgcn_mfma_f32_32x32x16_bf16(kf[2 * d0 + 1], qr[d0], p1, 0, 0, 0); }
}
__device__ __forceinline__ s16x4 vtr(const LAS unsigned char* p) { return __builtin_bit_cast(s16x4, __builtin_amdgcn_ds_read_tr16_b64_v4i16((LAS s16x4*)p)); }
template <int NDB> struct Flash {
    f32x16 o[NDB]; float mhat, l; bool first;
    __device__ __forceinline__ void reset() {
#pragma unroll
        for (int d = 0; d < NDB; ++d) o[d] = f32x16{};
        mhat = 0.f; l = 0.f; first = true; }
    static __device__ __forceinline__ float rowmax_abs(const f32x16& p0, const f32x16& p1) {
        float a = __builtin_fmaxf(__builtin_fmaxf(p0[0], p0[1]), p1[0]), c = __builtin_fmaxf(__builtin_fmaxf(p0[2], p0[3]), p1[1]);
        a = __builtin_fmaxf(__builtin_fmaxf(a, p1[2]), p1[3]);
#pragma unroll
        for (int r = 4; r < 16; r += 4) { a = __builtin_fmaxf(__builtin_fmaxf(a, p0[r]), p0[r + 1]); c = __builtin_fmaxf(__builtin_fmaxf(c, p0[r + 2]), p0[r + 3]);
            a = __builtin_fmaxf(__builtin_fmaxf(a, p1[r]), p1[r + 1]); c = __builtin_fmaxf(__builtin_fmaxf(c, p1[r + 2]), p1[r + 3]); }
        return xor32_max(__builtin_fmaxf(a, c));
    }
    __device__ __forceinline__ void decide(float rmabs, bool rowvalid, LAS float* wsf, int r32, int hi) {
        const float rm = rowvalid ? rmabs - mhat : -INFINITY;
        bool need; float dl;
        if (first) { need = true; dl = (rm > -1e30f) ? rm : 0.f; }
        else { need = __any(rm > 8.0f); dl = fmaxf(rm, 0.f); }
        if (need) {
            mhat += dl;
            if (!first) {
                const float f = __builtin_amdgcn_exp2f(-dl); l *= f;
                if (hi == 0) wsf[r32] = f;
                asm volatile("s_waitcnt lgkmcnt(0)" ::: "memory");
                const f32x4 t0 = *(const LAS f32x4*)(wsf + 4 * hi), t1 = *(const LAS f32x4*)(wsf + 8 + 4 * hi), t2 = *(const LAS f32x4*)(wsf + 16 + 4 * hi), t3 = *(const LAS f32x4*)(wsf + 24 + 4 * hi);
                const f32x16 fv = {t0[0], t0[1], t0[2], t0[3], t1[0], t1[1], t1[2], t1[3], t2[0], t2[1], t2[2], t2[3], t3[0], t3[1], t3[2], t3[3]};
#pragma unroll
                for (int d = 0; d < NDB; ++d) o[d] = o[d] * fv;
                asm volatile("s_waitcnt lgkmcnt(0)" ::: "memory");
            }
        }
        first = false;
    }
    __device__ __forceinline__ void exphalf(f32x16& p, float mm, u32x4& w0, u32x4& w1) {
        p = p - mm;
        float sa = 0.f, sb = 0.f;
#pragma unroll
        for (int r = 0; r < 16; r += 2) { p[r] = __builtin_amdgcn_exp2f(p[r]); p[r + 1] = __builtin_amdgcn_exp2f(p[r + 1]); sa += p[r]; sb += p[r + 1]; }
        l += sa + sb;
        w0 = (u32x4){cvtpk(p[0], p[1]), cvtpk(p[2], p[3]), cvtpk(p[4], p[5]), cvtpk(p[6], p[7])};
        w1 = (u32x4){cvtpk(p[8], p[9]), cvtpk(p[10], p[11]), cvtpk(p[12], p[13]), cvtpk(p[14], p[15])};
    }
    __device__ __forceinline__ void pv_half(const u32x4& w0, const u32x4& w1, const LAS unsigned char* Vslot, int lane, int hi, int kb) {
        const LAS unsigned char* vp = Vslot + ((lane >> 4) & 1) * 32 + (lane & 3) * 8 + (4 * hi + ((lane & 15) >> 2)) * 64;
#pragma unroll
        for (int d = 0; d < NDB; ++d) {
            const s16x4 l0 = vtr(vp + (d * 4 + kb) * 1024), h0 = vtr(vp + (d * 4 + kb) * 1024 + 512), l1 = vtr(vp + (d * 4 + kb + 1) * 1024), h1 = vtr(vp + (d * 4 + kb + 1) * 1024 + 512);
            o[d] = __builtin_amdgcn_mfma_f32_32x32x16_bf16(__builtin_bit_cast(bf16x8, w0), (bf16x8){l0[0], l0[1], l0[2], l0[3], h0[0], h0[1], h0[2], h0[3]}, o[d], 0, 0, 0);
            o[d] = __builtin_amdgcn_mfma_f32_32x32x16_bf16(__builtin_bit_cast(bf16x8, w1), (bf16x8){l1[0], l1[1], l1[2], l1[3], h1[0], h1[1], h1[2], h1[3]}, o[d], 0, 0, 0);
        }
    }
    __device__ __forceinline__ void tile(f32x16& p0, f32x16& p1, const LAS unsigned char* Vslot, LAS float* wsf, int lane, int r32, int hi) {
        decide(rowmax_abs(p0, p1), true, wsf, r32, hi);
        u32x4 w0, w1, w2, w3;
        exphalf(p0, mhat, w0, w1); pv_half(w0, w1, Vslot, lane, hi, 0);
        exphalf(p1, mhat, w2, w3); pv_half(w2, w3, Vslot, lane, hi, 2);
    }
    __device__ __forceinline__ float ltot() const { return xor32_sum(l); }
};
__device__ __forceinline__ void row_bcast(float v, float (&fr_)[16], LAS float* wsf, int r32, int hi) {
    asm volatile("s_waitcnt lgkmcnt(0)" ::: "memory");
    if (hi == 0) wsf[r32] = v;
    asm volatile("s_waitcnt lgkmcnt(0)" ::: "memory");
#pragma unroll
    for (int k = 0; k < 4; ++k) { const f32x4 t = *(const LAS f32x4*)(wsf + 8 * k + 4 * hi); fr_[4 * k] = t[0]; fr_[4 * k + 1] = t[1]; fr_[4 * k + 2] = t[2]; fr_[4 * k + 3] = t[3]; }
    asm volatile("s_waitcnt lgkmcnt(0)" ::: "memory");
}

constexpr int DF_STAGE = 0;
constexpr int DF_WSF = 98304;
__device__ __forceinline__ void diff_unit(LAS unsigned char* L, int b, int h, int qb, const unsigned char* ws, float lam, const float* subg, int wv) {
    int tid_ = wv * 64 + lane_id(); asm volatile("" : "+v"(tid_));
    const int tid = tid_, lane = tid & 63, r32 = lane & 31, hi = lane >> 5, wid = __builtin_amdgcn_readfirstlane(tid >> 6);
    const int comp = wid >> 2, rgi = wid & 3;
    const size_t bh = (size_t)(b * 4 + h) * S;
    const bf16_t* Qp = (const bf16_t*)(ws + WS_DQ) + (bh + qb * 128 + rgi * 32 + r32) * 128 + comp * 64;
    bf16x8 qr[4];
#pragma unroll
    for (int d0 = 0; d0 < 4; ++d0) qr[d0] = *(const bf16x8*)(Qp + d0 * 16 + hi * 8);
    const bf16_t* Kg = (const bf16_t*)(ws + WS_DK) + bh * 128 + ksrc_off(wid, lane);
    int koff[4]; kread_offs(koff, r32, hi);
    const bf16_t* Vg = (const bf16_t*)(ws + WS_DV) + bh * 128 + (size_t)(16 * (wid & 3) + (lane >> 2)) * 128 + (wid >> 2) * 32 + (lane & 3) * 8;
    LAS float* wsf = (LAS float*)(L + DF_WSF) + wid * 32;
    const int NT = 2 * qb + 2;
    Flash<4> F; F.reset();
    auto dmaK = [&](int t, int s) { const bf16_t* src = Kg + (size_t)t * 4096; LAS unsigned char* d = L + s * 16384 + wid * 1024; glds16(src, d); glds16(src + (size_t)S * 64, d + 8192); };
    auto dmaV = [&](int t, int s) { const bf16_t* src = Vg + (size_t)t * 8192; LAS unsigned char* d = L + 49152 + s * 16384 + wid * 1024; glds16(src, d); glds16(src + 64, d + 8192); };
    dmaK(0, 0); dmaV(0, 0); dmaK(1, 1); dmaV(1, 1); if (NT > 2) dmaK(2, 2);
    WAIT_BAR(0);
    f32x16 a0, a1, b0, b1; float ra, rb;
    const int xq = 32 * rgi + r32 - 4 * hi;
    auto cmask = [&](f32x16& c0, f32x16& c1, int t) { const int x = xq - 64 * (t - (NT - 2));
#pragma unroll
        for (int r = 0; r < 16; ++r) { if (ccol(r) > x) c0[r] = -INFINITY; if (ccol(r) + 32 > x) c1[r] = -INFINITY; } };
    qkt(a0, a1, L + comp * 8192, koff, qr);
    if (NT == 2) cmask(a0, a1, 0);
    ra = Flash<4>::rowmax_abs(a0, a1);
    WAIT_BAR(0);
    int s0 = 0, s1 = 1, s2 = 2;
    auto iter = [&](int t, f32x16& c0, f32x16& c1, float& rc, f32x16& n0, f32x16& n1, float& rn, auto next) {
        int nis = 0;
        if (t + 3 < NT) { dmaK(t + 3, s0); nis += 2; }
        if (t + 2 < NT) { dmaV(t + 2, s2); nis += 2; }
        F.decide(rc, true, wsf, r32, hi);
        const LAS unsigned char* Vs = L + 49152 + s0 * 16384;
        u32x4 w0, w1, w2, w3;
        if constexpr (decltype(next)::value) qkt(n0, n1, L + s1 * 16384 + comp * 8192, koff, qr);
        F.exphalf(c0, F.mhat, w0, w1);
        F.pv_half(w0, w1, Vs, lane, hi, 0);
        F.exphalf(c1, F.mhat, w2, w3);
        F.pv_half(w2, w3, Vs, lane, hi, 2);
        if constexpr (decltype(next)::value) { rn = Flash<4>::rowmax_abs(n0, n1); if (t + 1 >= NT - 2) { cmask(n0, n1, t + 1); rn = Flash<4>::rowmax_abs(n0, n1); } }
        wait_bar_n(nis);
        const int tmp = s0; s0 = s1; s1 = s2; s2 = tmp;
    };
    int t = 0;
    for (; t < NT - 2; t += 2) { iter(t, a0, a1, ra, b0, b1, rb, TrueC{}); iter(t + 1, b0, b1, rb, a0, a1, ra, TrueC{}); }
    iter(NT - 2, a0, a1, ra, b0, b1, rb, TrueC{});
    iter(NT - 1, b0, b1, rb, a0, a1, ra, FalseC{});
    const float lt = F.ltot();
    float fr_[16];
    row_bcast((comp ? lam : 1.f) / lt, fr_, wsf, r32, hi);
    LAS float* stg = (LAS float*)(L + DF_STAGE) + rgi * 32 * 132;
    if (comp == 1) {
#pragma unroll
        for (int d = 0; d < 4; ++d)
#pragma unroll
            for (int r = 0; r < 16; ++r) stg[crow(r, hi) * 132 + d * 32 + r32] = F.o[d][r] * fr_[r];
    }
    __syncthreads();
    if (comp == 0) {
#pragma unroll
        for (int d = 0; d < 4; ++d)
#pragma unroll
            for (int r = 0; r < 16; ++r) { const int ix = crow(r, hi) * 132 + d * 32 + r32; stg[ix] = F.o[d][r] * fr_[r] - stg[ix]; }
        asm volatile("s_waitcnt lgkmcnt(0)" ::: "memory");
        const LAS float* rowp = stg + r32 * 132 + 64 * hi;
        float ss = 0.f;
#pragma unroll
        for (int k = 0; k < 16; ++k) { const f32x4 v = *(const LAS f32x4*)(rowp + 4 * k); ss += (v[0] * v[0] + v[1] * v[1]) + (v[2] * v[2] + v[3] * v[3]); }
        ss = xor32_sum(ss);
        const float rstd = rsqrtf(ss * (1.f / 128.f) + EPS) * (1.f - LAM_INIT);
        bf16_t* Yp = (bf16_t*)(ws + WS_YA) + ((size_t)b * S + qb * 128 + rgi * 32 + r32) * 512 + h * 128 + 64 * hi;
#pragma unroll
        for (int k = 0; k < 8; ++k) { const f32x4 v0 = *(const LAS f32x4*)(rowp + 8 * k), v1 = *(const LAS f32x4*)(rowp + 8 * k + 4);
            const f32x4 g0 = *(const f32x4*)(subg + 64 * hi + 8 * k), g1 = *(const f32x4*)(subg + 64 * hi + 8 * k + 4);
            u32x4 w; w.x = cvtpk(v0[0] * rstd * g0[0], v0[1] * rstd * g0[1]); w.y = cvtpk(v0[2] * rstd * g0[2], v0[3] * rstd * g0[3]);
            w.z = cvtpk(v1[0] * rstd * g1[0], v1[1] * rstd * g1[1]); w.w = cvtpk(v1[2] * rstd * g1[2], v1[3] * rstd * g1[3]);
            *(u32x4*)(Yp + 8 * k) = w; }
    }
    __syncthreads();
}

constexpr int NS_CMP = 49152;
constexpr int NS_GL = 114688;
constexpr int NS_WSF = 147456;
template <int MODE>
__device__ __forceinline__ void nsa_kv_pass(LAS unsigned char* L, Flash<2>& F, const bf16x8* qr, const int (&koff)[4], const bf16_t* Kg0, const bf16_t* Vg0, int jlo, int jhi, int qblk, int ql, unsigned long long mymask,
                                            LAS float* wsf, int wid, int lane, int r32, int hi) {
    auto dmaK = [&](int j, int s) { glds16(Kg0 + (size_t)j * 4096, L + s * 8192 + wid * 1024); };
    auto dmaV = [&](int j, int s) { glds16(Vg0 + (size_t)j * 4096, L + 24576 + s * 8192 + wid * 1024); };
    dmaK(jlo, 0); dmaV(jlo, 0); if (jlo + 1 <= jhi) { dmaK(jlo + 1, 1); dmaV(jlo + 1, 1); } if (jlo + 2 <= jhi) dmaK(jlo + 2, 2);
    WAIT_BAR(0);
    f32x16 a0, a1, b0, b1; float ra, rb;
    const int xq = ql - 4 * hi;
    auto masked = [&](int j) { return MODE == 1 ? (j == qblk) : (j == qblk || j == qblk - 8); };
    auto amask = [&](f32x16& c0, f32x16& c1, int j) {
        if (MODE == 1) {
#pragma unroll
            for (int r = 0; r < 16; ++r) { if (ccol(r) > xq) c0[r] = -INFINITY; if (ccol(r) + 32 > xq) c1[r] = -INFINITY; }
        } else { const int base = 64 * (qblk - j) + xq;
#pragma unroll
            for (int r = 0; r < 16; ++r) { if ((unsigned)(base - ccol(r)) >= 512u) c0[r] = -INFINITY; if ((unsigned)(base - ccol(r) - 32) >= 512u) c1[r] = -INFINITY; } } };
    qkt(a0, a1, L, koff, qr);
    if (masked(jlo)) amask(a0, a1, jlo);
    ra = Flash<2>::rowmax_abs(a0, a1);
    WAIT_BAR(0);
    int s0 = 0, s1 = 1, s2 = 2;
    auto iter = [&](int j, f32x16& c0, f32x16& c1, float& rc, f32x16& n0, f32x16& n1, float& rn, auto next) {
        int nis = 0;
        if (j + 3 <= jhi) { dmaK(j + 3, s0); nis += 1; }
        if (j + 2 <= jhi) { dmaV(j + 2, s2); nis += 1; }
        const bool rowvalid = (MODE == 1) ? (bool)((mymask >> j) & 1ull) : true;
        F.decide(rc, rowvalid, wsf, r32, hi);
        const float mm = rowvalid ? F.mhat : INFINITY;
        const LAS unsigned char* Vs = L + 24576 + s0 * 8192;
        u32x4 w0, w1, w2, w3;
        if constexpr (decltype(next)::value) qkt(n0, n1, L + s1 * 8192, koff, qr);
        F.exphalf(c0, mm, w0, w1);
        F.pv_half(w0, w1, Vs, lane, hi, 0);
        F.exphalf(c1, mm, w2, w3);
        F.pv_half(w2, w3, Vs, lane, hi, 2);
        if constexpr (decltype(next)::value) { rn = Flash<2>::rowmax_abs(n0, n1); if (masked(j + 1)) { amask(n0, n1, j + 1); rn = Flash<2>::rowmax_abs(n0, n1); } }
        wait_bar_n(nis);
        const int tmp = s0; s0 = s1; s1 = s2; s2 = tmp;
    };
    int j = jlo;
    for (; j + 2 <= jhi; j += 2) { iter(j, a0, a1, ra, b0, b1, rb, TrueC{}); iter(j + 1, b0, b1, rb, a0, a1, ra, TrueC{}); }
    if (j < jhi) { iter(j, a0, a1, ra, b0, b1, rb, TrueC{}); iter(jhi, b0, b1, rb, a0, a1, ra, FalseC{}); }
    else iter(jhi, a0, a1, ra, b0, b1, rb, FalseC{});
}
__device__ __forceinline__ void nsa_unit(LAS unsigned char* L, int b, int g, int qblk, const unsigned char* ws, int wv) {
    int tid_ = wv * 64 + lane_id(); asm volatile("" : "+v"(tid_));
    const int tid = tid_, lane = tid & 63, r32 = lane & 31, hi = lane >> 5, wid = __builtin_amdgcn_readfirstlane(tid >> 6);
    const int ql = 8 * wid + (r32 & 7), hh = r32 >> 3, head = g * 4 + hh;
    const int qpos = 64 * qblk + ql;
    const size_t tok = (size_t)b * S + qpos;
    const bf16_t* Qp = (const bf16_t*)(ws + WS_NQ) + ((size_t)(b * 8 + head) * S + qpos) * 64;
    bf16x8 qr[4];
#pragma unroll
    for (int d0 = 0; d0 < 4; ++d0) qr[d0] = *(const bf16x8*)(Qp + d0 * 16 + hi * 8);
    const float* NGp = (const float*)(ws + WS_NG) + tok * 24 + head;
    const float g0 = NGp[0], g1 = NGp[8], g2 = NGp[16];
    LAS float* wsf = (LAS float*)(L + NS_WSF) + wid * 32;
    const size_t pg = (size_t)(b * 2 + g);
    LAS float* yst = (LAS float*)(L + NS_CMP) + wid * 2048;
    float fr_[16];
    unsigned long long mymask = 0ull;
    int koff[4]; kread_offs(koff, r32, hi);
    {
        const int ntc = ((4 * qblk + 2) >> 6) + 1;
        const bf16_t* Kc = (const bf16_t*)(ws + WS_KCMP) + pg * 256 * 64 + ksrc_off(wid, lane);
        const bf16_t* Vc = (const bf16_t*)(ws + WS_VCMP) + (pg * 256 + 16 * (wid & 3) + (lane >> 2)) * 64 + (wid >> 2) * 32 + (lane & 3) * 8;
        for (int ct = 0; ct < ntc; ++ct) { glds16(Kc + (size_t)ct * 4096, L + NS_CMP + ct * 8192 + wid * 1024); glds16(Vc + (size_t)ct * 4096, L + NS_CMP + 32768 + ct * 8192 + wid * 1024); }
        VM_DRAIN_SYNC();
        const int cm = (qpos >= 31) ? ((qpos - 31) >> 4) : -1;
        Flash<2> F; F.reset();
        for (int ct = 0; ct < ntc; ++ct) {
            f32x16 p0, p1;
            qkt(p0, p1, L + NS_CMP + ct * 8192, koff, qr);
            const int x = cm - 64 * ct - 4 * hi;
#pragma unroll
            for (int r = 0; r < 16; ++r) { if (ccol(r) > x) p0[r] = -INFINITY; if (ccol(r) + 32 > x) p1[r] = -INFINITY; }
            F.tile(p0, p1, L + NS_CMP + 32768 + ct * 8192, wsf, lane, r32, hi);
        }
        const float lt = F.ltot();
        const float il = lt > 0.f ? 1.f / lt : 0.f;
        LAS float* Gs = (LAS float*)(L + NS_GL) + wid * 1024;
        LAS float* Ls = Gs + 512;
        for (int ct = 0; ct < ntc; ++ct) {
            f32x16 p0, p1;
            qkt(p0, p1, L + NS_CMP + ct * 8192, koff, qr);
            const int x = cm - 64 * ct - 4 * hi;
#pragma unroll
            for (int r = 0; r < 16; ++r) {
                float a = (ccol(r) > x) ? 0.f : __builtin_amdgcn_exp2f(p0[r] - F.mhat) * il, bq = (ccol(r) + 32 > x) ? 0.f : __builtin_amdgcn_exp2f(p1[r] - F.mhat) * il;
                a += __shfl_xor(a, 8); a += __shfl_xor(a, 16); bq += __shfl_xor(bq, 8); bq += __shfl_xor(bq, 16);
                p0[r] = a; p1[r] = bq; }
            if (r32 < 8) {
#pragma unroll
                for (int k = 0; k < 4; ++k) { const int jj = 16 * ct + 2 * k + hi;
                    Gs[r32 * 64 + jj] = (p0[4 * k] + p0[4 * k + 1]) + (p0[4 * k + 2] + p0[4 * k + 3]); Ls[r32 * 64 + jj] = p0[4 * k + 3];
                    Gs[r32 * 64 + jj + 8] = (p1[4 * k] + p1[4 * k + 1]) + (p1[4 * k + 2] + p1[4 * k + 3]); Ls[r32 * 64 + jj + 8] = p1[4 * k + 3]; }
            }
        }
        asm volatile("s_waitcnt lgkmcnt(0)" ::: "memory");
        const int j = lane, jmax = 16 * ntc;
        for (int qi = 0; qi < 8; ++qi) {
            float v = (j < jmax) ? Gs[qi * 64 + j] : 0.f;
            if (j >= 1 && j - 1 < jmax) v += Ls[qi * 64 + j - 1];
            if (j == 0 || j == qblk || j == qblk - 1) v = 1e9f;
            if (j > qblk) v = -1e30f;
            unsigned key = __float_as_uint(v); key = (key & 0x80000000u) ? ~key : (key | 0x80000000u);
            unsigned long long C = ~0ull; int kk = 16;
            for (int bit = 31; bit >= 0; --bit) {
                const unsigned long long bs = __ballot((key >> bit) & 1u) & C;
                const int c1 = __popcll(bs);
                if (c1 >= kk) C = bs; else { kk -= c1; C &= ~bs; }
            }
            const unsigned Tk = (unsigned)__builtin_amdgcn_readlane((int)key, (int)__builtin_ctzll(C));
            unsigned long long selm = __ballot(key > Tk);
            for (int i = 0; i < kk; ++i) { const unsigned long long low = C & (0ull - C); selm |= low; C ^= low; }
            const unsigned long long m = selm & ((qblk >= 63) ? ~0ull : ((1ull << (qblk + 1)) - 1ull));
            if ((r32 & 7) == qi) mymask = m;
        }
        asm volatile("s_waitcnt lgkmcnt(0)" ::: "memory");
        __syncthreads();
        row_bcast(g0 * il, fr_, wsf, r32, hi);
#pragma unroll
        for (int d = 0; d < 2; ++d)
#pragma unroll
            for (int r = 0; r < 16; ++r) yst[crow(r, hi) * 64 + d * 32 + r32] = F.o[d][r] * fr_[r];
    }
    const size_t ksrc = pg * S * 64 + ksrc_off(wid, lane);
    const size_t voff = (pg * S + 16 * (wid & 3) + (lane >> 2)) * 64 + (wid >> 2) * 32 + (lane & 3) * 8;
    {
        Flash<2> F; F.reset();
        nsa_kv_pass<1>(L, F, qr, koff, (const bf16_t*)(ws + WS_KS) + ksrc, (const bf16_t*)(ws + WS_VS) + voff, 0, qblk, qblk, ql, mymask, wsf, wid, lane, r32, hi);
        const float lt = F.ltot();
        row_bcast(g1 / lt, fr_, wsf, r32, hi);
#pragma unroll
        for (int d = 0; d < 2; ++d)
#pragma unroll
            for (int r = 0; r < 16; ++r) yst[crow(r, hi) * 64 + d * 32 + r32] += F.o[d][r] * fr_[r];
    }
    {
        Flash<2> F; F.reset();
        const int jlo = qblk >= 8 ? qblk - 8 : 0;
        nsa_kv_pass<2>(L, F, qr, koff, (const bf16_t*)(ws + WS_KW) + ksrc, (const bf16_t*)(ws + WS_VW) + voff, jlo, qblk, qblk, ql, 0ull, wsf, wid, lane, r32, hi);
        const float lt = F.ltot();
        row_bcast(g2 / lt, fr_, wsf, r32, hi);
        LAS bf16_t* stg = (LAS bf16_t*)(L + NS_GL) + wid * 2048;
#pragma unroll
        for (int r = 0; r < 16; ++r) { const int orow = crow(r, hi);
#pragma unroll
            for (int d = 0; d < 2; ++d) { const float yv = yst[orow * 64 + d * 32 + r32] + F.o[d][r] * fr_[r]; stg[orow * 64 + d * 32 + r32] = (bf16_t)(cvtpk(yv, 0.f) & 0xffffu); } }
        asm volatile("s_waitcnt lgkmcnt(0)" ::: "memory");
        bf16_t* Yb = (bf16_t*)(ws + WS_YB);
#pragma unroll
        for (int i = 0; i < 4; ++i) { const int row = i * 8 + (lane >> 3), ch = lane & 7; const u32x4 v = *(const LAS u32x4*)(stg + row * 64 + ch * 8);
            *(u32x4*)(Yb + ((size_t)b * S + 64 * qblk + 8 * wid + (row & 7)) * 512 + (g * 4 + (row >> 3)) * 64 + ch * 8) = v; }
    }
    __syncthreads();
}

#define XB_TMO      128
#define XB_XCNT(j)  (256  + 64 * (j))
#define XB_XSUB(j)  (1280 + 64 * (j))
#define XB_XGEN(j)  (2304 + 64 * (j))
#define XB_TOP      3328
#define XB_TOPGEN   3392
#define XCD_BAR_WORDS 3456
#define XB_SPIN_CAP (1u << 18)

__device__ __forceinline__ unsigned xb_ld(unsigned* p)              { return __hip_atomic_load(p, __ATOMIC_RELAXED, __HIP_MEMORY_SCOPE_AGENT); }
__device__ __forceinline__ unsigned xb_add(unsigned* p, unsigned v) { return __hip_atomic_fetch_add(p, v, __ATOMIC_RELAXED, __HIP_MEMORY_SCOPE_AGENT); }
__device__ __forceinline__ unsigned xb_xcc_id() { return (unsigned)__builtin_amdgcn_s_getreg((3 << 11) | 20) & 0xFu; }
#define XB_SPIN(cond, bar) do { unsigned _sp = 0; while (cond) { __builtin_amdgcn_s_sleep(1); \
    if ((++_sp & 255u) == 0u) { if (xb_ld(&(bar)[XB_TMO])) break; if (_sp > XB_SPIN_CAP) { atomicAdd(&(bar)[XB_TMO], 1u); break; } } } } while (0)

struct XcdBarrier {
    unsigned* bar; unsigned x;
    volatile LAS unsigned* st;
    bool lead;
};

__device__ __forceinline__ XcdBarrier xcd_barrier_post(unsigned* bar, volatile LAS unsigned* st, bool lead) {
    XcdBarrier b; b.bar = bar; b.x = xb_xcc_id(); b.st = st; b.lead = lead;
    if (b.lead && lane_id() == 0) (void)xb_add(&bar[XB_XCNT(b.x)], 1u);
    return b;
}
__device__ __forceinline__ void xcd_barrier_complete(unsigned* bar, unsigned x, unsigned& nloc, unsigned& nx) {
    const unsigned G = gridDim.x * gridDim.y * gridDim.z;
    unsigned sum, cnt, mine, sp = 0u;
    for (;;) {
        sum = 0u; cnt = 0u; mine = 0u;
#pragma unroll
        for (unsigned j = 0; j < 16; ++j) { const unsigned c = xb_ld(&bar[XB_XCNT(j)]); sum += c; cnt += (c > 0u) ? 1u : 0u; mine = (j == x) ? c : mine; }
        if (sum == G) break;
        __builtin_amdgcn_s_sleep(1);
        if ((++sp & 255u) == 0u) { if (xb_ld(&bar[XB_TMO])) break; if (sp > XB_SPIN_CAP) { atomicAdd(&bar[XB_TMO], 1u); break; } }
    }
    nloc = mine > 0u ? mine : 1u; nx = cnt > 0u ? cnt : 1u;
}

__device__ __forceinline__ void xcd_barrier(const XcdBarrier& b) {
    asm volatile("s_waitcnt vmcnt(0)" ::: "memory");
    __syncthreads();
    if (b.lead && lane_id() == 0) {
        unsigned* bar = b.bar;
        __builtin_amdgcn_s_waitcnt(0);
        unsigned nloc = b.st[0], nx = b.st[1];
        if (nloc == 0u) { xcd_barrier_complete(bar, b.x, nloc, nx); b.st[0] = nloc; b.st[1] = nx; }
        const unsigned old = xb_add(&bar[XB_XSUB(b.x)], 1u);
        const unsigned gen = old / nloc;
        if (old + 1u == (gen + 1u) * nloc) {
            __builtin_amdgcn_fence(__ATOMIC_RELEASE, "agent");
            asm volatile("s_waitcnt vmcnt(0)" ::: "memory");
            const unsigned og = xb_add(&bar[XB_TOP], 1u);
            const unsigned tg = og / nx;
            if (og + 1u == (tg + 1u) * nx) xb_add(&bar[XB_TOPGEN], 1u);
            else XB_SPIN(xb_ld(&bar[XB_TOPGEN]) == tg, bar);
            __builtin_amdgcn_fence(__ATOMIC_ACQUIRE, "agent");
            xb_add(&bar[XB_XGEN(b.x)], 1u);
            asm volatile("s_waitcnt vmcnt(0)" ::: "memory");
        } else {
            XB_SPIN(xb_ld(&bar[XB_XGEN(b.x)]) == gen, bar);
            __builtin_amdgcn_fence(__ATOMIC_ACQUIRE, "agent");
            asm volatile("s_waitcnt vmcnt(0)" ::: "memory");
        }
    }
    __syncthreads();
}


template <class MapF>
__device__ __forceinline__ void tr_item(const float* W, int K, int N, int ldw, bf16_t* WT, const float* kscale, LAS float* scr, int item, int lane, const MapF& map) {
    const int nblk = (N + 31) / 32, kb = item / nblk, nb = item % nblk, k0 = 64 * kb, n0 = 32 * nb;
    const int nn = n0 + (lane & 31);
#pragma unroll 8
    for (int i = 0; i < 32; ++i) { const int kk = 2 * i + (lane >> 5); float v = (nn < N) ? W[(size_t)(k0 + kk) * ldw + nn] : 0.f; if (kscale) v *= kscale[k0 + kk]; scr[kk * 33 + (lane & 31)] = v; }
    asm volatile("s_waitcnt lgkmcnt(0)" ::: "memory");
    const int c = lane & 7;
#pragma unroll
    for (int jx = 0; jx < 4; ++jx) { const int n = (lane >> 3) + 8 * jx; const LAS float* s = scr + (8 * c) * 33 + n;
        u32x4 o; o.x = cvtpk(s[0 * 33], s[1 * 33]); o.y = cvtpk(s[2 * 33], s[3 * 33]); o.z = cvtpk(s[4 * 33], s[5 * 33]); o.w = cvtpk(s[6 * 33], s[7 * 33]);
        if (n0 + n < N) *(u32x4*)(WT + (size_t)map(n0 + n) * K + k0 + 8 * c) = o; }
    asm volatile("s_waitcnt lgkmcnt(0)" ::: "memory");
}
__device__ __forceinline__ int rope_pos(int d) { return d < 32 ? 8 * (d >> 2) + (d & 3) : 8 * ((d - 32) >> 2) + 4 + (d & 3); }
struct MapIn {
    __device__ __forceinline__ int operator()(int n) const {
        if (n >= 2840) return 2816 + (n - 2840);
        if (n >= 2816) return 4864 + (n - 2816);
        bool rope;
        if (n < 1024) rope = true; else if (n < 1536) rope = false; else if (n < 2048) rope = true; else rope = (((n - 2048) >> 7) & 1) == 0;
        return rope ? (n & ~63) + rope_pos(n & 63) : n;
    }
};
struct MapId { int off; __device__ __forceinline__ int operator()(int n) const { return off + n; } };
struct MapGU { int up; __device__ __forceinline__ int operator()(int f) const { return 8 * (f >> 2) + 4 * up + (f & 3); } };

__device__ __forceinline__ int queue_fetch(unsigned* qbase, unsigned x, LAS int* kstate) {
    int k = *kstate;
    while (k < 8) { const unsigned q = (x + (unsigned)k) & 7u; const unsigned li = atomicAdd(qbase + 64 * q, 1u); if (li < 128u) { *kstate = k; return (int)(q * 128u + li); } ++k; }
    *kstate = k; return -1;
}
struct Args { const void* in[20]; float* out; unsigned char* ws; int use_cg; int pad; };

__global__ void __launch_bounds__(512, 2) hybrid_fwd(Args args) {
    extern __shared__ __attribute__((aligned(16))) unsigned char lds_raw[];
    LAS unsigned char* L = (LAS unsigned char*)lds_raw;
    cg::grid_group grid = cg::this_grid();
    const int wave_s = __builtin_amdgcn_readfirstlane((int)(threadIdx.x >> 6));
#define PHASE_IDS() int tid_ = wave_s * 64 + lane_id(); asm volatile("" : "+v"(tid_)); const int tid = tid_, lane = tid & 63, wave = __builtin_amdgcn_readfirstlane(tid >> 6); (void)lane; (void)wave
    const int G = gridDim.x, bx = blockIdx.x;
    unsigned char* ws = args.ws;
    const float* x = (const float*)args.in[0];
    const int* positions = (const int*)args.in[1];
    float* out = args.out;
    unsigned* ctl = (unsigned*)(ws + WS_CTL);
    LAS int* misc = (LAS int*)(L + LDS_BYTES - 64);
    { const int t0 = wave_s * 64 + lane_id(); if (t0 < 16) misc[t0] = 0; }
    __syncthreads();
    const XcdBarrier xbar = xcd_barrier_post(ctl + 4096, (volatile LAS unsigned*)(misc + 8), wave_s == 0);

    {
        PHASE_IDS();
        LAS float* scr = (LAS float*)(L + wave * 16384);
        const int gw = bx * 8 + wave, NGW = G * 8;
        const float* g1 = (const float*)args.in[2]; const float* g2 = (const float*)args.in[15];
        constexpr int I_IN = 16 * 153, I_G = 16 * 88, I_D = 44 * 32, I_O = 16 * 32, I_A = 8 * 32, I_C = 16 * 8;
        constexpr int NIT = I_IN + 2 * I_G + I_D + I_O + 2 * I_A + 4 * I_C;
        for (int it = gw; it < NIT; it += NGW) {
            int r = it;
            if (r < I_IN) { tr_item((const float*)args.in[3], 1024, 4888, 4888, (bf16_t*)(ws + WS_WIN), g1, scr, r, lane, MapIn{}); continue; } r -= I_IN;
            if (r < I_G) { tr_item((const float*)args.in[16], 1024, FF, FF, (bf16_t*)(ws + WS_WGU), g2, scr, r, lane, MapGU{0}); continue; } r -= I_G;
            if (r < I_G) { tr_item((const float*)args.in[17], 1024, FF, FF, (bf16_t*)(ws + WS_WGU), g2, scr, r, lane, MapGU{1}); continue; } r -= I_G;
            if (r < I_D) { tr_item((const float*)args.in[18], FF, 1024, 1024, (bf16_t*)(ws + WS_WD), nullptr, scr, r, lane, MapId{0}); continue; } r -= I_D;
            if (r < I_O) { tr_item((const float*)args.in[14], 1024, 1024, 1024, (bf16_t*)(ws + WS_WO), nullptr, scr, r, lane, MapId{0}); continue; } r -= I_O;
            if (r < I_A) { tr_item((const float*)args.in[12], 512, 1024, 1024, (bf16_t*)(ws + WS_WA), nullptr, scr, r, lane, MapId{0}); continue; } r -= I_A;
            if (r < I_A) { tr_item((const float*)args.in[13], 512, 1024, 1024, (bf16_t*)(ws + WS_WB), nullptr, scr, r, lane, MapId{0}); continue; } r -= I_A;
            if (r < I_C) { tr_item((const float*)args.in[8], 1024, 256, 256, (bf16_t*)(ws + WS_W1K), nullptr, scr, r, lane, MapId{0}); continue; } r -= I_C;
            if (r < I_C) { tr_item((const float*)args.in[8] + 1024 * 256, 1024, 256, 256, (bf16_t*)(ws + WS_W1K), nullptr, scr, r, lane, MapId{256}); continue; } r -= I_C;
            if (r < I_C) { tr_item((const float*)args.in[10], 1024, 256, 256, (bf16_t*)(ws + WS_W1V), nullptr, scr, r, lane, MapId{0}); continue; } r -= I_C;
            tr_item((const float*)args.in[10] + 1024 * 256, 1024, 256, 256, (bf16_t*)(ws + WS_W1V), nullptr, scr, r, lane, MapId{256});
        }
        bf16_t* XB = (bf16_t*)(ws + WS_XB); float* rs1 = (float*)(ws + WS_RS1);
        float* cosT = (float*)(ws + WS_COS); float* sinT = (float*)(ws + WS_SIN);
        const float invf = 1.0f / powf(10000.0f, (float)(2 * (lane & 31)) / 64.0f);
        for (int m = gw; m < T; m += NGW) {
            const f32x4* xr = (const f32x4*)(x + (size_t)m * D) + lane;
            f32x4 v[4]; float s = 0.f;
#pragma unroll
            for (int jx = 0; jx < 4; ++jx) { v[jx] = xr[64 * jx]; s += (v[jx][0] * v[jx][0] + v[jx][1] * v[jx][1]) + (v[jx][2] * v[jx][2] + v[jx][3] * v[jx][3]); }
            s = wave_sum(s);
            if (lane == 0) rs1[m] = rsqrtf(s * (1.f / D) + EPS);
            u32x2* o8 = (u32x2*)(XB + (size_t)m * D) + lane;
#pragma unroll
            for (int jx = 0; jx < 4; ++jx) { u32x2 w; w.x = cvtpk(v[jx][0], v[jx][1]); w.y = cvtpk(v[jx][2], v[jx][3]); o8[64 * jx] = w; }
            const float ang = (float)positions[m] * invf;
            if (lane < 32) cosT[(size_t)m * 32 + lane] = cosf(ang); else sinT[(size_t)m * 32 + (lane - 32)] = sinf(ang);
        }
        if (bx < 32) {
            const int kv = bx >> 4, slab = bx & 15;
            const float* pe = (const float*)args.in[kv ? 7 : 6]; const float* W1 = (const float*)args.in[kv ? 10 : 8];
            const int n = tid & 255, half = tid >> 8; float acc = 0.f;
            for (int k = slab * 128 + half * 64; k < slab * 128 + half * 64 + 64; ++k) acc += pe[k] * W1[(size_t)k * 256 + n];
            __syncthreads();
            LAS float* red = (LAS float*)L;
            if (half) red[n] = acc;
            __syncthreads();
            if (!half) ((float*)(ws + WS_BIASP))[(kv * 16 + slab) * 256 + n] = acc + red[n];
            __syncthreads();
        }
    }
    if (args.use_cg) grid.sync(); else xcd_barrier(xbar);
    {
        pg8::Gemm g{(const bf16_t*)(ws + WS_XB), (const bf16_t*)(ws + WS_WIN), T, INP, D}; pg8::StaticOrder SO; SO.init(T, INP, G, bx);
        EpiProj E{(const float*)(ws + WS_RS1), (const float*)(ws + WS_COS), (const float*)(ws + WS_SIN), ws};
        pg8::gemm_phase<EpiProj, true>(L, g, SO, E, wave_s);
    }
    xcd_barrier(xbar);
    {
        PHASE_IDS();
        { pg8::Gemm g{(const bf16_t*)(ws + WS_KC), (const bf16_t*)(ws + WS_W1K), 4096, 512, 1024}; pg8::StaticOrder SO; SO.init(4096, 512, G, bx);
          EpiF32 E{(float*)(ws + WS_GK), 512}; pg8::gemm_phase<EpiF32, true>(L, g, SO, E, wave_s); }
        { pg8::Gemm g{(const bf16_t*)(ws + WS_VC), (const bf16_t*)(ws + WS_W1V), 4096, 512, 1024}; pg8::StaticOrder SO; SO.init(4096, 512, G, (bx + G - 32) % G);
          EpiF32 E{(float*)(ws + WS_GV), 512}; pg8::gemm_phase<EpiF32, true>(L, g, SO, E, wave_s); }
        __syncthreads();
        const float* lf = (const float*)args.in[4];
        float sa = 0.f, sb = 0.f;
        for (int d = 0; d < 64; ++d) { sa += lf[d] * lf[64 + d]; sb += lf[128 + d] * lf[192 + d]; }
        const float lam = __uint_as_float((unsigned)__builtin_amdgcn_readfirstlane((int)__float_as_uint(expf(sa) - expf(sb) + LAM_INIT)));
        if (wave_s == 0 && lane_id() == 0) misc[1] = 0;
        for (;;) {
            if (wave_s == 0 && lane_id() == 0) misc[0] = queue_fetch(ctl + 512, xbar.x & 7u, misc + 1);
            __syncthreads();
            const int idx = misc[0];
            __syncthreads();
            if (idx < 0) break;
            const int li = idx & 127, qb = 31 - (li >> 2), bh = (idx >> 7) * 4 + (li & 3);
            diff_unit(L, bh >> 2, bh & 3, qb, ws, lam, (const float*)args.in[5], wave_s);
        }
    }
    xcd_barrier(xbar);
    {
        PHASE_IDS();
        LAS float* hid = (LAS float*)L;
        LAS float* bias = hid + 4096;
        for (int un = bx; un < 512; un += G) {
            const int kv = un >> 8, p = (un >> 4) & 15, rb = un & 15;
            const float* Gm = (const float*)(ws + (kv ? WS_GV : WS_GK));
            const float* w2 = (const float*)args.in[kv ? 11 : 9];
            if (tid < 256) { float a = 0.f; const float* bp = (const float*)(ws + WS_BIASP) + kv * 16 * 256 + tid;
#pragma unroll
                for (int s = 0; s < 16; ++s) a += bp[s * 256]; bias[tid] = a; }
            __syncthreads();
#pragma unroll
            for (int i = 0; i < 8; ++i) { const int e = tid + 512 * i, r = e >> 8, k = e & 255, c = 16 * rb + r; const size_t R = (size_t)p * 256 + c;
                float v = Gm[R * 512 + k] + bias[k]; if (c < 255) v += Gm[(R + 1) * 512 + 256 + k];
                hid[r * 256 + k] = v / (1.f + __expf(-v)); }
            __syncthreads();
            const int d = tid & 63, r0 = tid >> 6; float a0 = 0.f, a1 = 0.f;
#pragma unroll 8
            for (int k = 0; k < 256; ++k) { const float w = w2[k * 64 + d]; a0 += hid[r0 * 256 + k] * w; a1 += hid[(r0 + 8) * 256 + k] * w; }
            bf16_t* O = (bf16_t*)(ws + (kv ? WS_VCMP : WS_KCMP)) + ((size_t)p * 256 + 16 * rb) * 64;
            O[r0 * 64 + d] = (bf16_t)(cvtpk(a0, 0.f) & 0xffffu); O[(r0 + 8) * 64 + d] = (bf16_t)(cvtpk(a1, 0.f) & 0xffffu);
            __syncthreads();
        }
    }
    xcd_barrier(xbar);
    {
        PHASE_IDS();
        if (wave_s == 0 && lane_id() == 0) misc[1] = 0;
        for (;;) {
            if (wave_s == 0 && lane_id() == 0) misc[0] = queue_fetch(ctl + 1024, xbar.x & 7u, misc + 1);
            __syncthreads();
            const int idx = misc[0];
            __syncthreads();
            if (idx < 0) break;
            const int li = idx & 127, qblk = 63 - (li >> 1), pgx = (idx >> 7) * 2 + (li & 1);
            nsa_unit(L, pgx >> 1, pgx & 1, qblk, ws, wave_s);
        }
    }
    xcd_barrier(xbar);
    {
        { pg8::Gemm g{(const bf16_t*)(ws + WS_YA), (const bf16_t*)(ws + WS_WA), T, D, 512}; pg8::StaticOrder SO; SO.init(T, D, G, bx);
          EpiBranch<false> E{(bf16_t*)(ws + WS_XB), (const bf16_t*)(ws + WS_MG)}; pg8::gemm_phase<EpiBranch<false>, true>(L, g, SO, E, wave_s); }
        __syncthreads();
        { pg8::Gemm g{(const bf16_t*)(ws + WS_YB), (const bf16_t*)(ws + WS_WB), T, D, 512}; pg8::StaticOrder SO; SO.init(T, D, G, bx);
          EpiBranch<true> E{(bf16_t*)(ws + WS_XB), (const bf16_t*)(ws + WS_MG)}; pg8::gemm_phase<EpiBranch<true>, true>(L, g, SO, E, wave_s); }
    }
    xcd_barrier(xbar);
    {
        pg8::Gemm g{(const bf16_t*)(ws + WS_XB), (const bf16_t*)(ws + WS_WO), T, D, D}; pg8::StaticOrder SO; SO.init(T, D, G, bx);
        EpiResid<false> E{(const void*)x, (bf16_t*)(ws + WS_YA), (float*)(ws + WS_SSQ2)};
        pg8::gemm_phase<EpiResid<false>, true>(L, g, SO, E, wave_s);
    }
    xcd_barrier(xbar);
    {
        pg8::Gemm g{(const bf16_t*)(ws + WS_YA), (const bf16_t*)(ws + WS_WGU), T, FF2, D}; pg8::StaticOrder SO; SO.init(T, FF2, G, bx);
        EpiGU E{(const float*)(ws + WS_SSQ2), (bf16_t*)(ws + WS_ACT)};
        pg8::gemm_phase<EpiGU, true>(L, g, SO, E, wave_s);
    }
    xcd_barrier(xbar);
    {
        pg8::Gemm g{(const bf16_t*)(ws + WS_ACT), (const bf16_t*)(ws + WS_WD), T, D, FF}; pg8::StaticOrder SO; SO.init(T, D, G, bx);
        EpiResid<true> E{(const void*)(ws + WS_YA), (bf16_t*)(ws + WS_XB), (float*)(ws + WS_SSQ3)};
        pg8::gemm_phase<EpiResid<true>, true>(L, g, SO, E, wave_s);
    }
    xcd_barrier(xbar);
    {
        PHASE_IDS();
        const float* gf = (const float*)args.in[19]; const float* SSQ3 = (const float*)(ws + WS_SSQ3);
        const int gw = bx * 8 + wave, NGW = G * 8;
        f32x4 gv[4];
#pragma unroll
        for (int jx = 0; jx < 4; ++jx) gv[jx] = ((const f32x4*)gf)[lane + 64 * jx];
        for (int m = gw; m < T; m += NGW) {
            float s = (lane < 16) ? SSQ3[(size_t)m * 16 + lane] : 0.f;
            s = wave_sum(s);
            const float rs = rsqrtf(s * (1.f / D) + EPS);
            const u32x2* hr = (const u32x2*)((const bf16_t*)(ws + WS_XB) + (size_t)m * D) + lane;
            f32x4* xr = (f32x4*)(out + (size_t)m * D) + lane;
#pragma unroll
            for (int jx = 0; jx < 4; ++jx) { const u32x2 w = hr[64 * jx]; f32x4 v = {bflo(w.x), bfhi(w.x), bflo(w.y), bfhi(w.y)}; v = v * rs * gv[jx]; xr[64 * jx] = v; }
        }
    }
}

extern "C" void kernel_launch(void* const* d_in, const int* in_sizes, int n_in, void* d_out, int out_size, void* d_ws, size_t ws_size, hipStream_t stream) {
    static int grid = 0;
    if (grid == 0) {
        if (n_in != 20 || out_size != T * D || ws_size < WS_END) { fprintf(stderr, "kernel_launch: unexpected shapes (n_in %d out %d ws %zu)\n", n_in, out_size, ws_size); grid = -1; return; }
        int dev = 0, cus = 0, per_cu = 0;
        hipGetDevice(&dev);
        hipDeviceGetAttribute(&cus, hipDeviceAttributeMultiprocessorCount, dev);
        hipFuncSetAttribute((const void*)hybrid_fwd, hipFuncAttributeMaxDynamicSharedMemorySize, LDS_BYTES);
        hipOccupancyMaxActiveBlocksPerMultiprocessor(&per_cu, (const void*)hybrid_fwd, 512, LDS_BYTES);
        if (per_cu < 1) { fprintf(stderr, "kernel_launch: occupancy query says %d blocks per CU\n", per_cu); per_cu = 1; }
        (void)hipGetLastError();
        grid = cus * per_cu;
    }
    if (grid < 0) return;
    hipMemsetAsync((char*)d_ws + WS_CTL, 0, 32768, stream);
    Args a{};
    for (int i = 0; i < 20; ++i) a.in[i] = d_in[i];
    a.out = (float*)d_out; a.ws = (unsigned char*)d_ws;
    void* params[] = {&a};
    hipError_t e = hipLaunchCooperativeKernel((const void*)hybrid_fwd, dim3(grid), dim3(512), params, LDS_BYTES, stream);
    if (e != hipSuccess) fprintf(stderr, "cooperative launch failed: %s (grid %d)\n", hipGetErrorString(e), grid);
}
```

```cpp
#include <hip/hip_runtime.h>
#include <hip/hip_cooperative_groups.h>
#include <cstdint>
#include <cstdio>
#include <type_traits>
namespace cg = cooperative_groups;

#define LAS __attribute__((address_space(3)))
typedef unsigned short bf16_t;
typedef short bf16x8 __attribute__((ext_vector_type(8)));
typedef short s16x4 __attribute__((ext_vector_type(4)));
typedef float f32x4 __attribute__((ext_vector_type(4)));
typedef float f32x2 __attribute__((ext_vector_type(2)));
typedef float f32x16 __attribute__((ext_vector_type(16)));
typedef unsigned u32x4 __attribute__((ext_vector_type(4)));
typedef unsigned u32x2 __attribute__((ext_vector_type(2)));
typedef __bf16 bf16x2_t __attribute__((ext_vector_type(2)));

constexpr int NB = 8, S = 4096, T = NB * S, D = 1024, FF = 2816, FF2 = 2 * FF, INP = 5120;
constexpr float EPS = 1e-6f;
constexpr float C2 = 0.125f * 1.4426950408889634f;
constexpr float LAM_INIT = 0.2f;

constexpr size_t MiB = 1u << 20;
constexpr size_t WS_CTL = 0;
constexpr size_t WS_WIN = 1 * MiB, WS_WGU = 11 * MiB, WS_WD = 22 * MiB, WS_WO = 28 * MiB, WS_WA = 30 * MiB, WS_WB = 31 * MiB, WS_W1K = 32 * MiB, WS_W1V = 33 * MiB;
constexpr size_t WS_COS = 34 * MiB, WS_SIN = 38 * MiB;
constexpr size_t WS_RS1 = 42 * MiB, WS_SSQ2 = 43 * MiB, WS_SSQ3 = 45 * MiB, WS_NG = 47 * MiB, WS_BIASP = 50 * MiB;
constexpr size_t WS_GK = 52 * MiB, WS_GV = 60 * MiB, WS_KCMP = 68 * MiB, WS_VCMP = 69 * MiB;
constexpr size_t WS_XB = 70 * MiB;
constexpr size_t WS_DQ = 134 * MiB, WS_DK = 166 * MiB, WS_DV = 198 * MiB, WS_NQ = 230 * MiB;
constexpr size_t WS_KC = 262 * MiB, WS_VC = 270 * MiB, WS_KS = 278 * MiB, WS_VS = 286 * MiB, WS_KW = 294 * MiB, WS_VW = 302 * MiB;
constexpr size_t WS_ACT = 134 * MiB;
constexpr size_t WS_MG = 310 * MiB;
constexpr size_t WS_YA = 438 * MiB, WS_YB = 470 * MiB;
constexpr size_t WS_END = 502 * MiB;
constexpr int LDS_BYTES = 155648;

__device__ __forceinline__ unsigned cvtpk(float lo, float hi) { f32x2 v = {lo, hi}; bf16x2_t b = __builtin_convertvector(v, bf16x2_t); return __builtin_bit_cast(unsigned, b); }
__device__ __forceinline__ float bf2f(unsigned short h) { return __uint_as_float(((unsigned)h) << 16); }
__device__ __forceinline__ float bflo(unsigned w) { return __uint_as_float(w << 16); }
__device__ __forceinline__ float bfhi(unsigned w) { return __uint_as_float(w & 0xffff0000u); }
__device__ __forceinline__ float sigmoidf_(float x) { return __builtin_amdgcn_rcpf(1.f + __builtin_amdgcn_exp2f(x * -1.4426950408889634f)); }
__device__ __forceinline__ int lane_id() { unsigned z = 0u; asm volatile("" : "+v"(z)); return (int)__builtin_amdgcn_mbcnt_hi(~0u, __builtin_amdgcn_mbcnt_lo(~0u, z)); }
__device__ __forceinline__ float xor32_sum(float v) { auto rr = __builtin_amdgcn_permlane32_swap(__float_as_uint(v), __float_as_uint(v), false, false); return __uint_as_float(rr[0]) + __uint_as_float(rr[1]); }
__device__ __forceinline__ float xor32_max(float v) { auto rr = __builtin_amdgcn_permlane32_swap(__float_as_uint(v), __float_as_uint(v), false, false); return __builtin_fmaxf(__uint_as_float(rr[0]), __uint_as_float(rr[1])); }
__device__ __forceinline__ float wave_sum(float v) {
#pragma unroll
    for (int o = 1; o < 64; o <<= 1) v += __shfl_xor(v, o);
    return v;
}

namespace pg8 {
constexpr int BM = 256, BK = 64, HALF = 128, HTB = HALF * BK * 2, STAGE_BYTES = 8 * HTB, NXCD = 8, WGM = 8;
__host__ __device__ __forceinline__ int lds_byte(int r, int c) { const int st = (r >> 4) * 2 + (c >> 5), rr = r & 15, cc = c & 31, ob = rr * 64 + cc * 2; return st * 1024 + (ob ^ (((ob >> 9) & 1) << 5)); }
__host__ __device__ __forceinline__ void stage_rc(int b, int& R, int& C) { const int st = b / 1024, sb = b % 1024, swz = sb ^ (((sb >> 9) & 1) << 5); R = (st >> 1) * 16 + swz / 64; C = (st & 1) * 32 + (swz % 64) / 2; }
__host__ __device__ __forceinline__ int perm32(int rho) { const int n = rho >> 4, i = rho & 15; return 8 * (i >> 2) + 4 * n + (i & 3); }
struct Unit { int pm, pn; };
struct Gemm { const bf16_t* A; const bf16_t* Bt; int M, N, K; };
struct StaticOrder {
    int nM, nN, nwg, G, c;
    __host__ __device__ void init(int M, int N, int G_, int c_) { nM = M / BM; nN = N / BM; nwg = nM * nN; G = G_; c = c_; }
    __host__ __device__ bool next(int i, Unit& u) const {
        const long L = (long)i * G + c; if (L >= nwg) return false;
        int wgid = (int)L; { const int q = nwg / NXCD, r = nwg % NXCD, xcd = wgid % NXCD, off = wgid / NXCD; wgid = (xcd < r ? xcd * (q + 1) : r * (q + 1) + (xcd - r) * q) + off; }
        const int nig = WGM * nN, gid = wgid / nig, fm = gid * WGM, gsz = (nM - fm) < WGM ? (nM - fm) : WGM;
        u.pm = fm + ((wgid % nig) % gsz); u.pn = (wgid % nig) / gsz; return true;
    }
};
template <class Epi, bool ALIGN_EPI>
__device__ __forceinline__ void gemm_phase(LAS unsigned char* lds, const Gemm g, const StaticOrder& S, const Epi& E, int wv) {
    int tid_ = wv * 64 + lane_id(); asm volatile("" : "+v"(tid_));
    const int tid = tid_, wid = __builtin_amdgcn_readfirstlane(tid >> 6), lane = tid & 63, wr = wid >> 2, wc = wid & 3, fr = lane & 15, fq = lane >> 4;
    const int K = g.K, nt = K / BK;
    unsigned voffA[2], voffB[2];
#pragma unroll
    for (int i = 0; i < 2; ++i) { int R, C; stage_rc(tid * 16 + i * 8192, R, C); const int Rb = (R & ~31) + perm32(R & 31);
        voffA[i] = (unsigned)(R * K + C) * 2u; voffB[i] = (unsigned)(Rb * K + C) * 2u; }
    const size_t kstep = (size_t)(BK * 2);
    const size_t hstep = (size_t)HALF * K * 2;
    const size_t tstep = 2 * hstep;
    const unsigned ldsw = (unsigned)wid * 1024u;
    const int aoff = lds_byte(wr * 64 + fr, fq * 8), boff = lds_byte(wc * 32 + fr, fq * 8);
#define PG8_SA(b, h) (((b) * 2 + (h)) * HTB)
#define PG8_SB(b, h) ((4 + (b) * 2 + (h)) * HTB)
#define PG8_STAGE(bufoff, gbase, voff) do { _Pragma("unroll") for (int _i = 0; _i < 2; ++_i) \
        __builtin_amdgcn_global_load_lds((const unsigned*)((const char*)(gbase) + (voff)[_i]), (LAS unsigned*)(lds + (bufoff) + ldsw + _i * 8192), 16, 0, 0); } while (0)
#define PG8_LDA(dst, b, h) do { _Pragma("unroll") for (int m = 0; m < 4; ++m) _Pragma("unroll") for (int k = 0; k < 2; ++k) dst[m][k] = *(const LAS bf16x8*)(lds + PG8_SA(b, h) + aoff + m * 2048 + k * 1024); } while (0)
#define PG8_LDB(dst, b, h) do { _Pragma("unroll") for (int n = 0; n < 2; ++n) _Pragma("unroll") for (int k = 0; k < 2; ++k) dst[n][k] = *(const LAS bf16x8*)(lds + PG8_SB(b, h) + boff + n * 2048 + k * 1024); } while (0)
#define PG8_MMA(ai, bj, At, Bt) do { __builtin_amdgcn_s_setprio(1); _Pragma("unroll") for (int m = 0; m < 4; ++m) _Pragma("unroll") for (int n = 0; n < 2; ++n) _Pragma("unroll") for (int k = 0; k < 2; ++k) \
        acc[ai][bj][m][n] = __builtin_amdgcn_mfma_f32_16x16x32_bf16(Bt[n][k], At[m][k], acc[ai][bj][m][n], 0, 0, 0); __builtin_amdgcn_s_setprio(0); } while (0)
#define PG8_WAIT_V(n) asm volatile("s_waitcnt vmcnt(" #n ")" ::: "memory")
#define PG8_WAIT_L(n) asm volatile("s_waitcnt lgkmcnt(" #n ")" ::: "memory")
#define PG8_BAR __builtin_amdgcn_s_barrier()
#define PG8_SCHED __builtin_amdgcn_sched_barrier(0)
    Unit cur, nxt; int ui = 0;
    if (!S.next(0, cur)) return;
    f32x4 acc[2][2][4][2];
#pragma unroll
    for (int a = 0; a < 2; ++a)
#pragma unroll
        for (int b = 0; b < 2; ++b)
#pragma unroll
            for (int m = 0; m < 4; ++m)
#pragma unroll
                for (int n = 0; n < 2; ++n) acc[a][b][m][n] = (f32x4){0.f, 0.f, 0.f, 0.f};
    bf16x8 At[4][2], B0[2][2], B1[2][2];
    const char* cA = (const char*)g.A + (size_t)cur.pm * tstep; const char* cB = (const char*)g.Bt + (size_t)cur.pn * tstep;
    PG8_STAGE(PG8_SB(0, 0), cB, voffB); PG8_STAGE(PG8_SB(0, 1), cB + hstep, voffB); PG8_STAGE(PG8_SA(0, 0), cA, voffA); PG8_STAGE(PG8_SA(0, 1), cA + hstep, voffA);
    if (wr == 1) PG8_BAR;
    PG8_WAIT_V(2); PG8_BAR;
    PG8_STAGE(PG8_SB(1, 0), cB + kstep, voffB); PG8_STAGE(PG8_SA(1, 0), cA + kstep, voffA); PG8_STAGE(PG8_SB(1, 1), cB + hstep + kstep, voffB);
    PG8_WAIT_V(6); PG8_BAR;
    for (;;) {
        const bool has_next = S.next(ui + 1, nxt);
        const char* nA = has_next ? (const char*)g.A + (size_t)nxt.pm * tstep : cA; const char* nB = has_next ? (const char*)g.Bt + (size_t)nxt.pn * tstep : cB;
        for (int t = 0; t < nt; t += 2) {
            const bool last = (t == nt - 2);
            const char* a1 = cA + (size_t)(t + 1) * kstep;
            const char* a2 = last ? nA : cA + (size_t)(t + 2) * kstep; const char* b2 = last ? nB : cB + (size_t)(t + 2) * kstep;
            const char* a3 = a2 + kstep; const char* b3 = b2 + kstep;
            PG8_LDB(B0, 0, 0); PG8_LDB(B1, 0, 1); PG8_SCHED; PG8_LDA(At, 0, 0); PG8_STAGE(PG8_SA(1, 1), a1 + hstep, voffA);
            PG8_WAIT_V(8); PG8_WAIT_L(0); PG8_BAR; PG8_MMA(0, 0, At, B0); PG8_MMA(0, 1, At, B1); PG8_BAR; PG8_SCHED;
            PG8_LDA(At, 0, 1); PG8_STAGE(PG8_SB(0, 0), b2, voffB); PG8_STAGE(PG8_SB(0, 1), b2 + hstep, voffB); PG8_STAGE(PG8_SA(0, 0), a2, voffA);
            PG8_WAIT_V(8); PG8_WAIT_L(0); PG8_BAR; PG8_MMA(1, 0, At, B0); PG8_MMA(1, 1, At, B1); PG8_BAR; PG8_SCHED;
            PG8_LDB(B0, 1, 0); PG8_LDB(B1, 1, 1); PG8_SCHED; PG8_LDA(At, 1, 0); PG8_STAGE(PG8_SA(0, 1), a2 + hstep, voffA);
            PG8_WAIT_V(8); PG8_WAIT_L(0); PG8_BAR; PG8_MMA(0, 0, At, B0); PG8_MMA(0, 1, At, B1); PG8_BAR; PG8_SCHED;
            PG8_LDA(At, 1, 1); PG8_STAGE(PG8_SB(1, 0), b3, voffB); PG8_STAGE(PG8_SB(1, 1), b3 + hstep, voffB); PG8_STAGE(PG8_SA(1, 0), a3, voffA);
            PG8_WAIT_V(8); PG8_WAIT_L(0); PG8_BAR; PG8_MMA(1, 0, At, B0); PG8_MMA(1, 1, At, B1); PG8_BAR; PG8_SCHED;
        }
        if constexpr (ALIGN_EPI) { if (wr == 0) PG8_BAR; }
        E(acc, cur, wr, wc, fr, fq);
        if (!has_next) break;
#pragma unroll
        for (int a = 0; a < 2; ++a)
#pragma unroll
            for (int b = 0; b < 2; ++b)
#pragma unroll
                for (int m = 0; m < 4; ++m)
#pragma unroll
                    for (int n = 0; n < 2; ++n) acc[a][b][m][n] = (f32x4){0.f, 0.f, 0.f, 0.f};
        cur = nxt; cA = nA; cB = nB; ++ui;
        if constexpr (ALIGN_EPI) { if (wr == 1) PG8_BAR; }
    }
    PG8_WAIT_V(0);
    if constexpr (!ALIGN_EPI) { if (wr == 0) PG8_BAR; }
    PG8_BAR;
#undef PG8_SA
#undef PG8_SB
#undef PG8_STAGE
#undef PG8_LDA
#undef PG8_LDB
#undef PG8_MMA
#undef PG8_WAIT_V
#undef PG8_WAIT_L
#undef PG8_BAR
#undef PG8_SCHED
}
}

typedef f32x4 AccT[2][2][4][2];

struct EpiProj {
    const float* rs1; const float* cosT; const float* sinT;
    unsigned char* ws;
    __device__ __forceinline__ void operator()(const AccT& acc, const pg8::Unit& u, int wr, int wc, int fr, int fq) const {
        const int row0 = u.pm * 256 + wr * 64 + fr;
        if (u.pn < 4 || u.pn == 6 || u.pn == 7) {
            const int pn = u.pn; bf16_t* base; int hd; float scale; size_t hoff;
            const int head64 = ((pn < 4) ? (pn & 1) : (pn - 6)) * 4 + wc;
            if (pn < 2)      { base = (bf16_t*)(ws + WS_DQ); hd = 128; scale = C2;  hoff = (size_t)(head64 >> 1) * S * 128 + (head64 & 1) * 64; }
            else if (pn < 4) { base = (bf16_t*)(ws + WS_DK); hd = 64;  scale = 1.f; hoff = (size_t)head64 * S * 64; }
            else             { base = (bf16_t*)(ws + WS_NQ); hd = 64;  scale = C2;  hoff = (size_t)head64 * S * 64; }
            const int d0 = 8 * fq;
#pragma unroll
            for (int ai = 0; ai < 2; ++ai)
#pragma unroll
                for (int m = 0; m < 4; ++m) { const int r = row0 + ai * 128 + m * 16; const float rs = rs1[r] * scale;
                    const int b = r >> 12, s = r & 4095;
                    bf16_t* p = base + (size_t)b * 8 * S * 64 + hoff + (size_t)s * hd + d0;
                    const f32x4 c0 = *(const f32x4*)(cosT + (size_t)r * 32 + d0), c1 = *(const f32x4*)(cosT + (size_t)r * 32 + d0 + 4), s0 = *(const f32x4*)(sinT + (size_t)r * 32 + d0), s1 = *(const f32x4*)(sinT + (size_t)r * 32 + d0 + 4);
                    const f32x4 xa = acc[ai][0][m][0] * rs, xb = acc[ai][0][m][1] * rs, ya = acc[ai][1][m][0] * rs, yb = acc[ai][1][m][1] * rs;
                    const f32x4 oa = xa * c0 - ya * s0, ob = xb * c1 - yb * s1, pa = ya * c0 + xa * s0, pb = yb * c1 + xb * s1;
                    u32x4 w1, w2; w1.x = cvtpk(oa[0], oa[1]); w1.y = cvtpk(oa[2], oa[3]); w1.z = cvtpk(ob[0], ob[1]); w1.w = cvtpk(ob[2], ob[3]);
                    w2.x = cvtpk(pa[0], pa[1]); w2.y = cvtpk(pa[2], pa[3]); w2.z = cvtpk(pb[0], pb[1]); w2.w = cvtpk(pb[2], pb[3]);
                    *(u32x4*)p = w1; *(u32x4*)(p + 32) = w2; }
            return;
        }
#pragma unroll
        for (int bj = 0; bj < 2; ++bj) {
            const int sec = u.pn * 2 + bj;
            if (sec >= 39) continue;
            if (sec == 38) {
                if (wc == 0 && fq < 3) {
                    float* NG = (float*)(ws + WS_NG);
#pragma unroll
                    for (int ai = 0; ai < 2; ++ai)
#pragma unroll
                        for (int m = 0; m < 4; ++m) { const int r = row0 + ai * 128 + m * 16; const float rs = rs1[r];
                            f32x4 v0 = acc[ai][bj][m][0] * rs, v1 = acc[ai][bj][m][1] * rs;
                            f32x4 o0, o1;
#pragma unroll
                            for (int i = 0; i < 4; ++i) { o0[i] = sigmoidf_(v0[i]); o1[i] = sigmoidf_(v1[i]); }
                            *(f32x4*)(NG + (size_t)r * 24 + fq * 8) = o0; *(f32x4*)(NG + (size_t)r * 24 + fq * 8 + 4) = o1; }
                }
                continue;
            }
            if (sec >= 22) {
                bf16_t* MG = (bf16_t*)(ws + WS_MG);
                const int col = (sec - 22) * 128 + wc * 32 + fq * 8;
#pragma unroll
                for (int ai = 0; ai < 2; ++ai)
#pragma unroll
                    for (int m = 0; m < 4; ++m) { const int r = row0 + ai * 128 + m * 16; const float rs = rs1[r];
                        f32x4 v0 = acc[ai][bj][m][0] * rs, v1 = acc[ai][bj][m][1] * rs;
                        u32x4 w; w.x = cvtpk(sigmoidf_(v0[0]), sigmoidf_(v0[1])); w.y = cvtpk(sigmoidf_(v0[2]), sigmoidf_(v0[3]));
                        w.z = cvtpk(sigmoidf_(v1[0]), sigmoidf_(v1[1])); w.w = cvtpk(sigmoidf_(v1[2]), sigmoidf_(v1[3]));
                        *(u32x4*)(MG + (size_t)r * 2048 + col) = w; }
                continue;
            }
            bf16_t* base; int H, head, HD, coff; bool rope; float scale = 1.f;
            if (sec < 4)       { base = (bf16_t*)(ws + WS_DQ); H = 4; head = sec;      HD = 128; coff = (wc >> 1) * 64; rope = true; scale = C2; }
            else if (sec < 8)  { base = (bf16_t*)(ws + WS_DK); H = 8; head = (sec - 4) * 2 + (wc >> 1); HD = 64; coff = 0; rope = true; }
            else if (sec < 12) { base = (bf16_t*)(ws + WS_DV); H = 4; head = sec - 8;  HD = 128; coff = (wc >> 1) * 64; rope = false; }
            else if (sec < 16) { base = (bf16_t*)(ws + WS_NQ); H = 8; head = (sec - 12) * 2 + (wc >> 1); HD = 64; coff = 0; rope = true; scale = C2; }
            else { const int k6 = sec - 16; base = (bf16_t*)(ws + WS_KC + (size_t)k6 * 8 * MiB); H = 2; head = wc >> 1; HD = 64; coff = 0; rope = (k6 & 1) == 0; }
            const int j = 4 * (wc & 1) + fq;
#pragma unroll
            for (int ai = 0; ai < 2; ++ai)
#pragma unroll
                for (int m = 0; m < 4; ++m) { const int r = row0 + ai * 128 + m * 16; const float rs = rs1[r] * scale;
                    const int b = r >> 12, s = r & 4095;
                    bf16_t* p = base + ((size_t)(b * H + head) * S + s) * HD + coff;
                    f32x4 v0 = acc[ai][bj][m][0] * rs, v1 = acc[ai][bj][m][1] * rs;
                    if (rope) {
                        const f32x4 c = *(const f32x4*)(cosT + (size_t)r * 32 + 4 * j), sn = *(const f32x4*)(sinT + (size_t)r * 32 + 4 * j);
                        const f32x4 o1 = v0 * c - v1 * sn, o2 = v1 * c + v0 * sn;
                        u32x2 w1, w2; w1.x = cvtpk(o1[0], o1[1]); w1.y = cvtpk(o1[2], o1[3]); w2.x = cvtpk(o2[0], o2[1]); w2.y = cvtpk(o2[2], o2[3]);
                        *(u32x2*)(p + 4 * j) = w1; *(u32x2*)(p + 32 + 4 * j) = w2;
                    } else {
                        u32x4 w; w.x = cvtpk(v0[0], v0[1]); w.y = cvtpk(v0[2], v0[3]); w.z = cvtpk(v1[0], v1[1]); w.w = cvtpk(v1[2], v1[3]);
                        *(u32x4*)(p + 8 * j) = w;
                    }
                }
        }
    }
};
struct EpiF32 {
    float* O; int ldc;
    __device__ __forceinline__ void operator()(const AccT& acc, const pg8::Unit& u, int wr, int wc, int fr, int fq) const {
        const int row0 = u.pm * 256 + wr * 64 + fr, col0 = u.pn * 256 + wc * 32 + fq * 8;
#pragma unroll
        for (int ai = 0; ai < 2; ++ai)
#pragma unroll
            for (int m = 0; m < 4; ++m)
#pragma unroll
                for (int bj = 0; bj < 2; ++bj) { float* p = O + (size_t)(row0 + ai * 128 + m * 16) * ldc + col0 + bj * 128;
                    *(f32x4*)p = acc[ai][bj][m][0]; *(f32x4*)(p + 4) = acc[ai][bj][m][1]; }
    }
};
template <bool SECOND> struct EpiBranch {
    bf16_t* MERGED; const bf16_t* MG;
    __device__ __forceinline__ void operator()(const AccT& acc, const pg8::Unit& u, int wr, int wc, int fr, int fq) const {
        const int row0 = u.pm * 256 + wr * 64 + fr, col0 = u.pn * 256 + wc * 32 + fq * 8;
#pragma unroll
        for (int ai = 0; ai < 2; ++ai)
#pragma unroll
            for (int m = 0; m < 4; ++m)
#pragma unroll
                for (int bj = 0; bj < 2; ++bj) { const int r = row0 + ai * 128 + m * 16, c = col0 + bj * 128;
                    const u32x4 g = *(const u32x4*)(MG + (size_t)r * 2048 + (SECOND ? 1024 : 0) + c);
                    const f32x4 a0 = acc[ai][bj][m][0], a1 = acc[ai][bj][m][1];
                    float o[8] = {bflo(g.x) * a0[0], bfhi(g.x) * a0[1], bflo(g.y) * a0[2], bfhi(g.y) * a0[3], bflo(g.z) * a1[0], bfhi(g.z) * a1[1], bflo(g.w) * a1[2], bfhi(g.w) * a1[3]};
                    bf16_t* p = MERGED + (size_t)r * 1024 + c;
                    if (SECOND) { const u32x4 pv = *(const u32x4*)p;
                        o[0] += bflo(pv.x); o[1] += bfhi(pv.x); o[2] += bflo(pv.y); o[3] += bfhi(pv.y); o[4] += bflo(pv.z); o[5] += bfhi(pv.z); o[6] += bflo(pv.w); o[7] += bfhi(pv.w); }
                    u32x4 w; w.x = cvtpk(o[0], o[1]); w.y = cvtpk(o[2], o[3]); w.z = cvtpk(o[4], o[5]); w.w = cvtpk(o[6], o[7]);
                    *(u32x4*)p = w; }
    }
};
template <bool BASE_BF> struct EpiResid {
    const void* base; bf16_t* HB; float* SSQ;
    __device__ __forceinline__ void operator()(const AccT& acc, const pg8::Unit& u, int wr, int wc, int fr, int fq) const {
        const int row0 = u.pm * 256 + wr * 64 + fr, col0 = u.pn * 256 + wc * 32 + fq * 8;
#pragma unroll
        for (int ai = 0; ai < 2; ++ai)
#pragma unroll
            for (int m = 0; m < 4; ++m) { const int r = row0 + ai * 128 + m * 16; float ss = 0.f;
#pragma unroll
                for (int bj = 0; bj < 2; ++bj) { const size_t off = (size_t)r * 1024 + col0 + bj * 128;
                    f32x4 b0, b1;
                    if (BASE_BF) { const u32x4 g = *(const u32x4*)((const bf16_t*)base + off); b0 = (f32x4){bflo(g.x), bfhi(g.x), bflo(g.y), bfhi(g.y)}; b1 = (f32x4){bflo(g.z), bfhi(g.z), bflo(g.w), bfhi(g.w)}; }
                    else { b0 = *(const f32x4*)((const float*)base + off); b1 = *(const f32x4*)((const float*)base + off + 4); }
                    const f32x4 h0 = b0 + acc[ai][bj][m][0], h1 = b1 + acc[ai][bj][m][1];
                    ss += (h0[0] * h0[0] + h0[1] * h0[1]) + (h0[2] * h0[2] + h0[3] * h0[3]) + (h1[0] * h1[0] + h1[1] * h1[1]) + (h1[2] * h1[2] + h1[3] * h1[3]);
                    u32x4 w; w.x = cvtpk(h0[0], h0[1]); w.y = cvtpk(h0[2], h0[3]); w.z = cvtpk(h1[0], h1[1]); w.w = cvtpk(h1[2], h1[3]); *(u32x4*)(HB + off) = w; }
                ss += __shfl_xor(ss, 16); ss += __shfl_xor(ss, 32);
                if (fq == 0) SSQ[(size_t)r * 16 + u.pn * 4 + wc] = ss; }
    }
};
struct EpiGU {
    const float* SSQ2; bf16_t* ACT;
    __device__ __forceinline__ void operator()(const AccT& acc, const pg8::Unit& u, int wr, int wc, int fr, int fq) const {
        const int row0 = u.pm * 256 + wr * 64 + fr, col0 = u.pn * 128 + wc * 32 + fq * 8;
#pragma unroll
        for (int ai = 0; ai < 2; ++ai)
#pragma unroll
            for (int m = 0; m < 4; ++m) { const int r = row0 + ai * 128 + m * 16;
                const f32x4* sp = (const f32x4*)(SSQ2 + (size_t)r * 16); const f32x4 s0 = sp[0], s1 = sp[1], s2 = sp[2], s3 = sp[3];
                const float tot = ((s0[0] + s0[1]) + (s0[2] + s0[3])) + ((s1[0] + s1[1]) + (s1[2] + s1[3])) + ((s2[0] + s2[1]) + (s2[2] + s2[3])) + ((s3[0] + s3[1]) + (s3[2] + s3[3]));
                const float rs = rsqrtf(tot * (1.f / 1024.f) + EPS);
                float o[8];
#pragma unroll
                for (int n = 0; n < 2; ++n) { const f32x4 gv = acc[ai][0][m][n] * rs, uv = acc[ai][1][m][n] * rs;
#pragma unroll
                    for (int i = 0; i < 4; ++i) o[4 * n + i] = gv[i] * sigmoidf_(gv[i]) * uv[i]; }
                u32x4 w; w.x = cvtpk(o[0], o[1]); w.y = cvtpk(o[2], o[3]); w.z = cvtpk(o[4], o[5]); w.w = cvtpk(o[6], o[7]);
                *(u32x4*)(ACT + (size_t)r * FF + col0) = w; }
    }
};

typedef std::integral_constant<bool, true> TrueC; typedef std::integral_constant<bool, false> FalseC;
__device__ __forceinline__ int crow(int r, int hi) { return (r & 3) + 8 * (r >> 2) + 4 * hi; }
__device__ __forceinline__ constexpr int ccol(int r) { return (r & 3) + 8 * (r >> 2); }
__device__ __forceinline__ void glds16(const void* g, LAS unsigned char* l) {
    unsigned keep; const unsigned dst = (unsigned)__builtin_amdgcn_readfirstlane((int)(unsigned)(uintptr_t)l);
    asm volatile("s_mov_b32 %0, m0\n\ts_mov_b32 m0, %2\n\ts_nop 0\n\tglobal_load_lds_dwordx4 %1, off\n\ts_mov_b32 m0, %0" : "=&s"(keep) : "v"(g), "s"(dst) : "memory");
}
#define VM_DRAIN_SYNC() do { asm volatile("s_waitcnt vmcnt(0)" ::: "memory"); __syncthreads(); } while (0)
#define WAIT_BAR(N) asm volatile("s_waitcnt vmcnt(" #N ") lgkmcnt(0)\n\ts_barrier" ::: "memory")
__device__ __forceinline__ void wait_bar_n(int n) { if (n == 4) WAIT_BAR(4); else if (n == 2) WAIT_BAR(2); else if (n == 1) WAIT_BAR(1); else WAIT_BAR(0); }
__device__ __forceinline__ int ksrc_off(int wid, int lane) { const int ip = (lane - 8 * (wid & 1)) & 63, rho = ip >> 3, c = (ip & 7) ^ rho; return (8 * wid + rho) * 64 + c * 8; }
__device__ __forceinline__ void kread_offs(int (&koff)[4], int r32, int hi) {
    const int pc = r32 >> 3, rho = r32 & 7;
#pragma unroll
    for (int d0 = 0; d0 < 4; ++d0) koff[d0] = pc * 1024 + (((rho * 8 + ((2 * d0 + hi) ^ rho) + 8 * (pc & 1)) & 63) << 4);
}
__device__ __forceinline__ void qkt(f32x16& p0, f32x16& p1, const LAS unsigned char* Kslot, const int (&koff)[4], const bf16x8* qr) {
    bf16x8 kf[8];
#pragma unroll
    for (int d0 = 0; d0 < 4; ++d0) { kf[2 * d0] = *(const LAS bf16x8*)(Kslot + koff[d0]); kf[2 * d0 + 1] = *(const LAS bf16x8*)(Kslot + koff[d0] + 4096); }
    const f32x16 zz = f32x16{};
    p0 = __builtin_amdgcn_mfma_f32_32x32x16_bf16(kf[0], qr[0], zz, 0, 0, 0); p1 = __builtin_amdgcn_mfma_f32_32x32x16_bf16(kf[1], qr[0], zz, 0, 0, 0);
#pragma unroll
    for (int d0 = 1; d0 < 4; ++d0) { p0 = __builtin_amdgcn_mfma_f32_32x32x16_bf16(kf[2 * d0], qr[d0], p0, 0, 0, 0); p1 = __builtin_amdgcn_mfma_f32_32x32x16_bf16(kf[2 * d0 + 1], qr[d0], p1, 0, 0, 0); }
}
__device__ __forceinline__ s16x4 vtr(const LAS unsigned char* p) { return __builtin_bit_cast(s16x4, __builtin_amdgcn_ds_read_tr16_b64_v4i16((LAS s16x4*)p)); }
template <int NDB> struct Flash {
    f32x16 o[NDB]; float mhat, l; bool first;
    __device__ __forceinline__ void reset() {
#pragma unroll
        for (int d = 0; d < NDB; ++d) o[d] = f32x16{};
        mhat = 0.f; l = 0.f; first = true; }
    static __device__ __forceinline__ float rowmax_abs(const f32x16& p0, const f32x16& p1) {
        float a = __builtin_fmaxf(__builtin_fmaxf(p0[0], p0[1]), p1[0]), c = __builtin_fmaxf(__builtin_fmaxf(p0[2], p0[3]), p1[1]);
        a = __builtin_fmaxf(__builtin_fmaxf(a, p1[2]), p1[3]);
#pragma unroll
        for (int r = 4; r < 16; r += 4) { a = __builtin_fmaxf(__builtin_fmaxf(a, p0[r]), p0[r + 1]); c = __builtin_fmaxf(__builtin_fmaxf(c, p0[r + 2]), p0[r + 3]);
            a = __builtin_fmaxf(__builtin_fmaxf(a, p1[r]), p1[r + 1]); c = __builtin_fmaxf(__builtin_fmaxf(c, p1[r + 2]), p1[r + 3]); }
        return xor32_max(__builtin_fmaxf(a, c));
    }
    __device__ __forceinline__ void decide(float rmabs, bool rowvalid, LAS float* wsf, int r32, int hi) {
        const float rm = rowvalid ? rmabs - mhat : -INFINITY;
        bool need; float dl;
        if (first) { need = true; dl = (rm > -1e30f) ? rm : 0.f; }
        else { need = __any(rm > 8.0f); dl = fmaxf(rm, 0.f); }
        if (need) {
            mhat += dl;
            if (!first) {
                const float f = __builtin_amdgcn_exp2f(-dl); l *= f;
                if (hi == 0) wsf[r32] = f;
                asm volatile("s_waitcnt lgkmcnt(0)" ::: "memory");
                const f32x4 t0 = *(const LAS f32x4*)(wsf + 4 * hi), t1 = *(const LAS f32x4*)(wsf + 8 + 4 * hi), t2 = *(const LAS f32x4*)(wsf + 16 + 4 * hi), t3 = *(const LAS f32x4*)(wsf + 24 + 4 * hi);
                const f32x16 fv = {t0[0], t0[1], t0[2], t0[3], t1[0], t1[1], t1[2], t1[3], t2[0], t2[1], t2[2], t2[3], t3[0], t3[1], t3[2], t3[3]};
#pragma unroll
                for (int d = 0; d < NDB; ++d) o[d] = o[d] * fv;
                asm volatile("s_waitcnt lgkmcnt(0)" ::: "memory");
            }
        }
        first = false;
    }
    __device__ __forceinline__ void exphalf(f32x16& p, float mm, u32x4& w0, u32x4& w1) {
        p = p - mm;
        float sa = 0.f, sb = 0.f;
#pragma unroll
        for (int r = 0; r < 16; r += 2) { p[r] = __builtin_amdgcn_exp2f(p[r]); p[r + 1] = __builtin_amdgcn_exp2f(p[r + 1]); sa += p[r]; sb += p[r + 1]; }
        l += sa + sb;
        w0 = (u32x4){cvtpk(p[0], p[1]), cvtpk(p[2], p[3]), cvtpk(p[4], p[5]), cvtpk(p[6], p[7])};
        w1 = (u32x4){cvtpk(p[8], p[9]), cvtpk(p[10], p[11]), cvtpk(p[12], p[13]), cvtpk(p[14], p[15])};
    }
    __device__ __forceinline__ void pv_half(const u32x4& w0, const u32x4& w1, const LAS unsigned char* Vslot, int lane, int hi, int kb) {
        const LAS unsigned char* vp = Vslot + ((lane >> 4) & 1) * 32 + (lane & 3) * 8 + (4 * hi + ((lane & 15) >> 2)) * 64;
#pragma unroll
        for (int d = 0; d < NDB; ++d) {
            const s16x4 l0 = vtr(vp + (d * 4 + kb) * 1024), h0 = vtr(vp + (d * 4 + kb) * 1024 + 512), l1 = vtr(vp + (d * 4 + kb + 1) * 1024), h1 = vtr(vp + (d * 4 + kb + 1) * 1024 + 512);
            o[d] = __builtin_amdgcn_mfma_f32_32x32x16_bf16(__builtin_bit_cast(bf16x8, w0), (bf16x8){l0[0], l0[1], l0[2], l0[3], h0[0], h0[1], h0[2], h0[3]}, o[d], 0, 0, 0);
            o[d] = __builtin_amdgcn_mfma_f32_32x32x16_bf16(__builtin_bit_cast(bf16x8, w1), (bf16x8){l1[0], l1[1], l1[2], l1[3], h1[0], h1[1], h1[2], h1[3]}, o[d], 0, 0, 0);
        }
    }
    __device__ __forceinline__ void tile(f32x16& p0, f32x16& p1, const LAS unsigned char* Vslot, LAS float* wsf, int lane, int r32, int hi) {
        decide(rowmax_abs(p0, p1), true, wsf, r32, hi);
        u32x4 w0, w1, w2, w3;
        exphalf(p0, mhat, w0, w1); pv_half(w0, w1, Vslot, lane, hi, 0);
        exphalf(p1, mhat, w2, w3); pv_half(w2, w3, Vslot, lane, hi, 2);
    }
    __device__ __forceinline__ float ltot() const { return xor32_sum(l); }
};
__device__ __forceinline__ void row_bcast(float v, float (&fr_)[16], LAS float* wsf, int r32, int hi) {
    asm volatile("s_waitcnt lgkmcnt(0)" ::: "memory");
    if (hi == 0) wsf[r32] = v;
    asm volatile("s_waitcnt lgkmcnt(0)" ::: "memory");
#pragma unroll
    for (int k = 0; k < 4; ++k) { const f32x4 t = *(const LAS f32x4*)(wsf + 8 * k + 4 * hi); fr_[4 * k] = t[0]; fr_[4 * k + 1] = t[1]; fr_[4 * k + 2] = t[2]; fr_[4 * k + 3] = t[3]; }
    asm volatile("s_waitcnt lgkmcnt(0)" ::: "memory");
}

constexpr int DF_STAGE = 0;
constexpr int DF_WSF = 98304;
__device__ __forceinline__ void diff_unit(LAS unsigned char* L, int b, int h, int qb, const unsigned char* ws, float lam, const float* subg, int wv) {
    int tid_ = wv * 64 + lane_id(); asm volatile("" : "+v"(tid_));
    const int tid = tid_, lane = tid & 63, r32 = lane & 31, hi = lane >> 5, wid = __builtin_amdgcn_readfirstlane(tid >> 6);
    const int comp = wid >> 2, rgi = wid & 3;
    const size_t bh = (size_t)(b * 4 + h) * S;
    const bf16_t* Qp = (const bf16_t*)(ws + WS_DQ) + (bh + qb * 128 + rgi * 32 + r32) * 128 + comp * 64;
    bf16x8 qr[4];
#pragma unroll
    for (int d0 = 0; d0 < 4; ++d0) qr[d0] = *(const bf16x8*)(Qp + d0 * 16 + hi * 8);
    const bf16_t* Kg = (const bf16_t*)(ws + WS_DK) + bh * 128 + ksrc_off(wid, lane);
    int koff[4]; kread_offs(koff, r32, hi);
    const bf16_t* Vg = (const bf16_t*)(ws + WS_DV) + bh * 128 + (size_t)(16 * (wid & 3) + (lane >> 2)) * 128 + (wid >> 2) * 32 + (lane & 3) * 8;
    LAS float* wsf = (LAS float*)(L + DF_WSF) + wid * 32;
    const int NT = 2 * qb + 2;
    Flash<4> F; F.reset();
    auto dmaK = [&](int t, int s) { const bf16_t* src = Kg + (size_t)t * 4096; LAS unsigned char* d = L + s * 16384 + wid * 1024; glds16(src, d); glds16(src + (size_t)S * 64, d + 8192); };
    auto dmaV = [&](int t, int s) { const bf16_t* src = Vg + (size_t)t * 8192; LAS unsigned char* d = L + 49152 + s * 16384 + wid * 1024; glds16(src, d); glds16(src + 64, d + 8192); };
    dmaK(0, 0); dmaV(0, 0); dmaK(1, 1); dmaV(1, 1); if (NT > 2) dmaK(2, 2);
    WAIT_BAR(0);
    f32x16 a0, a1, b0, b1; float ra, rb;
    const int xq = 32 * rgi + r32 - 4 * hi;
    auto cmask = [&](f32x16& c0, f32x16& c1, int t) { const int x = xq - 64 * (t - (NT - 2));
#pragma unroll
        for (int r = 0; r < 16; ++r) { if (ccol(r) > x) c0[r] = -INFINITY; if (ccol(r) + 32 > x) c1[r] = -INFINITY; } };
    qkt(a0, a1, L + comp * 8192, koff, qr);
    if (NT == 2) cmask(a0, a1, 0);
    ra = Flash<4>::rowmax_abs(a0, a1);
    WAIT_BAR(0);
    int s0 = 0, s1 = 1, s2 = 2;
    auto iter = [&](int t, f32x16& c0, f32x16& c1, float& rc, f32x16& n0, f32x16& n1, float& rn, auto next) {
        int nis = 0;
        if (t + 3 < NT) { dmaK(t + 3, s0); nis += 2; }
        if (t + 2 < NT) { dmaV(t + 2, s2); nis += 2; }
        F.decide(rc, true, wsf, r32, hi);
        const LAS unsigned char* Vs = L + 49152 + s0 * 16384;
        u32x4 w0, w1, w2, w3;
        if constexpr (decltype(next)::value) qkt(n0, n1, L + s1 * 16384 + comp * 8192, koff, qr);
        F.exphalf(c0, F.mhat, w0, w1);
        F.pv_half(w0, w1, Vs, lane, hi, 0);
        F.exphalf(c1, F.mhat, w2, w3);
        F.pv_half(w2, w3, Vs, lane, hi, 2);
        if constexpr (decltype(next)::value) { rn = Flash<4>::rowmax_abs(n0, n1); if (t + 1 >= NT - 2) { cmask(n0, n1, t + 1); rn = Flash<4>::rowmax_abs(n0, n1); } }
        wait_bar_n(nis);
        const int tmp = s0; s0 = s1; s1 = s2; s2 = tmp;
    };
    int t = 0;
    for (; t < NT - 2; t += 2) { iter(t, a0, a1, ra, b0, b1, rb, TrueC{}); iter(t + 1, b0, b1, rb, a0, a1, ra, TrueC{}); }
    iter(NT - 2, a0, a1, ra, b0, b1, rb, TrueC{});
    iter(NT - 1, b0, b1, rb, a0, a1, ra, FalseC{});
    const float lt = F.ltot();
    float fr_[16];
    row_bcast((comp ? lam : 1.f) / lt, fr_, wsf, r32, hi);
    LAS float* stg = (LAS float*)(L + DF_STAGE) + rgi * 32 * 132;
    if (comp == 1) {
#pragma unroll
        for (int d = 0; d < 4; ++d)
#pragma unroll
            for (int r = 0; r < 16; ++r) stg[crow(r, hi) * 132 + d * 32 + r32] = F.o[d][r] * fr_[r];
    }
    __syncthreads();
    if (comp == 0) {
#pragma unroll
        for (int d = 0; d < 4; ++d)
#pragma unroll
            for (int r = 0; r < 16; ++r) { const int ix = crow(r, hi) * 132 + d * 32 + r32; stg[ix] = F.o[d][r] * fr_[r] - stg[ix]; }
        asm volatile("s_waitcnt lgkmcnt(0)" ::: "memory");
        const LAS float* rowp = stg + r32 * 132 + 64 * hi;
        float ss = 0.f;
#pragma unroll
        for (int k = 0; k < 16; ++k) { const f32x4 v = *(const LAS f32x4*)(rowp + 4 * k); ss += (v[0] * v[0] + v[1] * v[1]) + (v[2] * v[2] + v[3] * v[3]); }
        ss = xor32_sum(ss);
        const float rstd = rsqrtf(ss * (1.f / 128.f) + EPS) * (1.f - LAM_INIT);
        bf16_t* Yp = (bf16_t*)(ws + WS_YA) + ((size_t)b * S + qb * 128 + rgi * 32 + r32) * 512 + h * 128 + 64 * hi;
#pragma unroll
        for (int k = 0; k < 8; ++k) { const f32x4 v0 = *(const LAS f32x4*)(rowp + 8 * k), v1 = *(const LAS f32x4*)(rowp + 8 * k + 4);
            const f32x4 g0 = *(const f32x4*)(subg + 64 * hi + 8 * k), g1 = *(const f32x4*)(subg + 64 * hi + 8 * k + 4);
            u32x4 w; w.x = cvtpk(v0[0] * rstd * g0[0], v0[1] * rstd * g0[1]); w.y = cvtpk(v0[2] * rstd * g0[2], v0[3] * rstd * g0[3]);
            w.z = cvtpk(v1[0] * rstd * g1[0], v1[1] * rstd * g1[1]); w.w = cvtpk(v1[2] * rstd * g1[2], v1[3] * rstd * g1[3]);
            *(u32x4*)(Yp + 8 * k) = w; }
    }
    __syncthreads();
}

constexpr int NS_CMP = 49152;
constexpr int NS_GL = 114688;
constexpr int NS_WSF = 147456;
template <int MODE>
__device__ __forceinline__ void nsa_kv_pass(LAS unsigned char* L, Flash<2>& F, const bf16x8* qr, const int (&koff)[4], const bf16_t* Kg0, const bf16_t* Vg0, int jlo, int jhi, int qblk, int ql, unsigned long long mymask,
                                            LAS float* wsf, int wid, int lane, int r32, int hi) {
    auto dmaK = [&](int j, int s) { glds16(Kg0 + (size_t)j * 4096, L + s * 8192 + wid * 1024); };
    auto dmaV = [&](int j, int s) { glds16(Vg0 + (size_t)j * 4096, L + 24576 + s * 8192 + wid * 1024); };
    dmaK(jlo, 0); dmaV(jlo, 0); if (jlo + 1 <= jhi) { dmaK(jlo + 1, 1); dmaV(jlo + 1, 1); } if (jlo + 2 <= jhi) dmaK(jlo + 2, 2);
    WAIT_BAR(0);
    f32x16 a0, a1, b0, b1; float ra, rb;
    const int xq = ql - 4 * hi;
    auto masked = [&](int j) { return MODE == 1 ? (j == qblk) : (j == qblk || j == qblk - 8); };
    auto amask = [&](f32x16& c0, f32x16& c1, int j) {
        if (MODE == 1) {
#pragma unroll
            for (int r = 0; r < 16; ++r) { if (ccol(r) > xq) c0[r] = -INFINITY; if (ccol(r) + 32 > xq) c1[r] = -INFINITY; }
        } else { const int base = 64 * (qblk - j) + xq;
#pragma unroll
            for (int r = 0; r < 16; ++r) { if ((unsigned)(base - ccol(r)) >= 512u) c0[r] = -INFINITY; if ((unsigned)(base - ccol(r) - 32) >= 512u) c1[r] = -INFINITY; } } };
    qkt(a0, a1, L, koff, qr);
    if (masked(jlo)) amask(a0, a1, jlo);
    ra = Flash<2>::rowmax_abs(a0, a1);
    WAIT_BAR(0);
    int s0 = 0, s1 = 1, s2 = 2;
    auto iter = [&](int j, f32x16& c0, f32x16& c1, float& rc, f32x16& n0, f32x16& n1, float& rn, auto next) {
        int nis = 0;
        if (j + 3 <= jhi) { dmaK(j + 3, s0); nis += 1; }
        if (j + 2 <= jhi) { dmaV(j + 2, s2); nis += 1; }
        const bool rowvalid = (MODE == 1) ? (bool)((mymask >> j) & 1ull) : true;
        F.decide(rc, rowvalid, wsf, r32, hi);
        const float mm = rowvalid ? F.mhat : INFINITY;
        const LAS unsigned char* Vs = L + 24576 + s0 * 8192;
        u32x4 w0, w1, w2, w3;
        if constexpr (decltype(next)::value) qkt(n0, n1, L + s1 * 8192, koff, qr);
        F.exphalf(c0, mm, w0, w1);
        F.pv_half(w0, w1, Vs, lane, hi, 0);
        F.exphalf(c1, mm, w2, w3);
        F.pv_half(w2, w3, Vs, lane, hi, 2);
        if constexpr (decltype(next)::value) { rn = Flash<2>::rowmax_abs(n0, n1); if (masked(j + 1)) { amask(n0, n1, j + 1); rn = Flash<2>::rowmax_abs(n0, n1); } }
        wait_bar_n(nis);
        const int tmp = s0; s0 = s1; s1 = s2; s2 = tmp;
    };
    int j = jlo;
    for (; j + 2 <= jhi; j += 2) { iter(j, a0, a1, ra, b0, b1, rb, TrueC{}); iter(j + 1, b0, b1, rb, a0, a1, ra, TrueC{}); }
    if (j < jhi) { iter(j, a0, a1, ra, b0, b1, rb, TrueC{}); iter(jhi, b0, b1, rb, a0, a1, ra, FalseC{}); }
    else iter(jhi, a0, a1, ra, b0, b1, rb, FalseC{});
}
__device__ __forceinline__ void nsa_unit(LAS unsigned char* L, int b, int g, int qblk, const unsigned char* ws, int wv) {
    int tid_ = wv * 64 + lane_id(); asm volatile("" : "+v"(tid_));
    const int tid = tid_, lane = tid & 63, r32 = lane & 31, hi = lane >> 5, wid = __builtin_amdgcn_readfirstlane(tid >> 6);
    const int ql = 8 * wid + (r32 & 7), hh = r32 >> 3, head = g * 4 + hh;
    const int qpos = 64 * qblk + ql;
    const size_t tok = (size_t)b * S + qpos;
    const bf16_t* Qp = (const bf16_t*)(ws + WS_NQ) + ((size_t)(b * 8 + head) * S + qpos) * 64;
    bf16x8 qr[4];
#pragma unroll
    for (int d0 = 0; d0 < 4; ++d0) qr[d0] = *(const bf16x8*)(Qp + d0 * 16 + hi * 8);
    const float* NGp = (const float*)(ws + WS_NG) + tok * 24 + head;
    const float g0 = NGp[0], g1 = NGp[8], g2 = NGp[16];
    LAS float* wsf = (LAS float*)(L + NS_WSF) + wid * 32;
    const size_t pg = (size_t)(b * 2 + g);
    LAS float* yst = (LAS float*)(L + NS_CMP) + wid * 2048;
    float fr_[16];
    unsigned long long mymask = 0ull;
    int koff[4]; kread_offs(koff, r32, hi);
    {
        const int ntc = ((4 * qblk + 2) >> 6) + 1;
        const bf16_t* Kc = (const bf16_t*)(ws + WS_KCMP) + pg * 256 * 64 + ksrc_off(wid, lane);
        const bf16_t* Vc = (const bf16_t*)(ws + WS_VCMP) + (pg * 256 + 16 * (wid & 3) + (lane >> 2)) * 64 + (wid >> 2) * 32 + (lane & 3) * 8;
        for (int ct = 0; ct < ntc; ++ct) { glds16(Kc + (size_t)ct * 4096, L + NS_CMP + ct * 8192 + wid * 1024); glds16(Vc + (size_t)ct * 4096, L + NS_CMP + 32768 + ct * 8192 + wid * 1024); }
        VM_DRAIN_SYNC();
        const int cm = (qpos >= 31) ? ((qpos - 31) >> 4) : -1;
        Flash<2> F; F.reset();
        for (int ct = 0; ct < ntc; ++ct) {
            f32x16 p0, p1;
            qkt(p0, p1, L + NS_CMP + ct * 8192, koff, qr);
            const int x = cm - 64 * ct - 4 * hi;
#pragma unroll
            for (int r = 0; r < 16; ++r) { if (ccol(r) > x) p0[r] = -INFINITY; if (ccol(r) + 32 > x) p1[r] = -INFINITY; }
            F.tile(p0, p1, L + NS_CMP + 32768 + ct * 8192, wsf, lane, r32, hi);
        }
        const float lt = F.ltot();
        const float il = lt > 0.f ? 1.f / lt : 0.f;
        LAS float* Gs = (LAS float*)(L + NS_GL) + wid * 1024;
        LAS float* Ls = Gs + 512;
        for (int ct = 0; ct < ntc; ++ct) {
            f32x16 p0, p1;
            qkt(p0, p1, L + NS_CMP + ct * 8192, koff, qr);
            const int x = cm - 64 * ct - 4 * hi;
#pragma unroll
            for (int r = 0; r < 16; ++r) {
                float a = (ccol(r) > x) ? 0.f : __builtin_amdgcn_exp2f(p0[r] - F.mhat) * il, bq = (ccol(r) + 32 > x) ? 0.f : __builtin_amdgcn_exp2f(p1[r] - F.mhat) * il;
                a += __shfl_xor(a, 8); a += __shfl_xor(a, 16); bq += __shfl_xor(bq, 8); bq += __shfl_xor(bq, 16);
                p0[r] = a; p1[r] = bq; }
            if (r32 < 8) {
#pragma unroll
                for (int k = 0; k < 4; ++k) { const int jj = 16 * ct + 2 * k + hi;
                    Gs[r32 * 64 + jj] = (p0[4 * k] + p0[4 * k + 1]) + (p0[4 * k + 2] + p0[4 * k + 3]); Ls[r32 * 64 + jj] = p0[4 * k + 3];
                    Gs[r32 * 64 + jj + 8] = (p1[4 * k] + p1[4 * k + 1]) + (p1[4 * k + 2] + p1[4 * k + 3]); Ls[r32 * 64 + jj + 8] = p1[4 * k + 3]; }
            }
        }
        asm volatile("s_waitcnt lgkmcnt(0)" ::: "memory");
        const int j = lane, jmax = 16 * ntc;
        for (int qi = 0; qi < 8; ++qi) {
            float v = (j < jmax) ? Gs[qi * 64 + j] : 0.f;
            if (j >= 1 && j - 1 < jmax) v += Ls[qi * 64 + j - 1];
            if (j == 0 || j == qblk || j == qblk - 1) v = 1e9f;
            if (j > qblk) v = -1e30f;
            unsigned key = __float_as_uint(v); key = (key & 0x80000000u) ? ~key : (key | 0x80000000u);
            unsigned long long C = ~0ull; int kk = 16;
            for (int bit = 31; bit >= 0; --bit) {
                const unsigned long long bs = __ballot((key >> bit) & 1u) & C;
                const int c1 = __popcll(bs);
                if (c1 >= kk) C = bs; else { kk -= c1; C &= ~bs; }
            }
            const unsigned Tk = (unsigned)__builtin_amdgcn_readlane((int)key, (int)__builtin_ctzll(C));
            unsigned long long selm = __ballot(key > Tk);
            for (int i = 0; i < kk; ++i) { const unsigned long long low = C & (0ull - C); selm |= low; C ^= low; }
            const unsigned long long m = selm & ((qblk >= 63) ? ~0ull : ((1ull << (qblk + 1)) - 1ull));
            if ((r32 & 7) == qi) mymask = m;
        }
        asm volatile("s_waitcnt lgkmcnt(0)" ::: "memory");
        __syncthreads();
        row_bcast(g0 * il, fr_, wsf, r32, hi);
#pragma unroll
        for (int d = 0; d < 2; ++d)
#pragma unroll
            for (int r = 0; r < 16; ++r) yst[crow(r, hi) * 64 + d * 32 + r32] = F.o[d][r] * fr_[r];
    }
    const size_t ksrc = pg * S * 64 + ksrc_off(wid, lane);
    const size_t voff = (pg * S + 16 * (wid & 3) + (lane >> 2)) * 64 + (wid >> 2) * 32 + (lane & 3) * 8;
    {
        Flash<2> F; F.reset();
        nsa_kv_pass<1>(L, F, qr, koff, (const bf16_t*)(ws + WS_KS) + ksrc, (const bf16_t*)(ws + WS_VS) + voff, 0, qblk, qblk, ql, mymask, wsf, wid, lane, r32, hi);
        const float lt = F.ltot();
        row_bcast(g1 / lt, fr_, wsf, r32, hi);
#pragma unroll
        for (int d = 0; d < 2; ++d)
#pragma unroll
            for (int r = 0; r < 16; ++r) yst[crow(r, hi) * 64 + d * 32 + r32] += F.o[d][r] * fr_[r];
    }
    {
        Flash<2> F; F.reset();
        const int jlo = qblk >= 8 ? qblk - 8 : 0;
        nsa_kv_pass<2>(L, F, qr, koff, (const bf16_t*)(ws + WS_KW) + ksrc, (const bf16_t*)(ws + WS_VW) + voff, jlo, qblk, qblk, ql, 0ull, wsf, wid, lane, r32, hi);
        const float lt = F.ltot();
        row_bcast(g2 / lt, fr_, wsf, r32, hi);
        LAS bf16_t* stg = (LAS bf16_t*)(L + NS_GL) + wid * 2048;
#pragma unroll
        for (int r = 0; r < 16; ++r) { const int orow = crow(r, hi);
#pragma unroll
            for (int d = 0; d < 2; ++d) { const float yv = yst[orow * 64 + d * 32 + r32] + F.o[d][r] * fr_[r]; stg[orow * 64 + d * 32 + r32] = (bf16_t)(cvtpk(yv, 0.f) & 0xffffu); } }
        asm volatile("s_waitcnt lgkmcnt(0)" ::: "memory");
        bf16_t* Yb = (bf16_t*)(ws + WS_YB);
#pragma unroll
        for (int i = 0; i < 4; ++i) { const int row = i * 8 + (lane >> 3), ch = lane & 7; const u32x4 v = *(const LAS u32x4*)(stg + row * 64 + ch * 8);
            *(u32x4*)(Yb + ((size_t)b * S + 64 * qblk + 8 * wid + (row & 7)) * 512 + (g * 4 + (row >> 3)) * 64 + ch * 8) = v; }
    }
    __syncthreads();
}

#define XB_TMO      128
#define XB_XCNT(j)  (256  + 64 * (j))
#define XB_XSUB(j)  (1280 + 64 * (j))
#define XB_XGEN(j)  (2304 + 64 * (j))
#define XB_TOP      3328
#define XB_TOPGEN   3392
#define XCD_BAR_WORDS 3456
#define XB_SPIN_CAP (1u << 18)

__device__ __forceinline__ unsigned xb_ld(unsigned* p)              { return __hip_atomic_load(p, __ATOMIC_RELAXED, __HIP_MEMORY_SCOPE_AGENT); }
__device__ __forceinline__ unsigned xb_add(unsigned* p, unsigned v) { return __hip_atomic_fetch_add(p, v, __ATOMIC_RELAXED, __HIP_MEMORY_SCOPE_AGENT); }
__device__ __forceinline__ unsigned xb_xcc_id() { return (unsigned)__builtin_amdgcn_s_getreg((3 << 11) | 20) & 0xFu; }
#define XB_SPIN(cond, bar) do { unsigned _sp = 0; while (cond) { __builtin_amdgcn_s_sleep(1); \
    if ((++_sp & 255u) == 0u) { if (xb_ld(&(bar)[XB_TMO])) break; if (_sp > XB_SPIN_CAP) { atomicAdd(&(bar)[XB_TMO], 1u); break; } } } } while (0)

struct XcdBarrier {
    unsigned* bar; unsigned x;
    volatile LAS unsigned* st;
    bool lead;
};

__device__ __forceinline__ XcdBarrier xcd_barrier_post(unsigned* bar, volatile LAS unsigned* st, bool lead) {
    XcdBarrier b; b.bar = bar; b.x = xb_xcc_id(); b.st = st; b.lead = lead;
    if (b.lead && lane_id() == 0) (void)xb_add(&bar[XB_XCNT(b.x)], 1u);
    return b;
}
__device__ __forceinline__ void xcd_barrier_complete(unsigned* bar, unsigned x, unsigned& nloc, unsigned& nx) {
    const unsigned G = gridDim.x * gridDim.y * gridDim.z;
    unsigned sum, cnt, mine, sp = 0u;
    for (;;) {
        sum = 0u; cnt = 0u; mine = 0u;
#pragma unroll
        for (unsigned j = 0; j < 16; ++j) { const unsigned c = xb_ld(&bar[XB_XCNT(j)]); sum += c; cnt += (c > 0u) ? 1u : 0u; mine = (j == x) ? c : mine; }
        if (sum == G) break;
        __builtin_amdgcn_s_sleep(1);
        if ((++sp & 255u) == 0u) { if (xb_ld(&bar[XB_TMO])) break; if (sp > XB_SPIN_CAP) { atomicAdd(&bar[XB_TMO], 1u); break; } }
    }
    nloc = mine > 0u ? mine : 1u; nx = cnt > 0u ? cnt : 1u;
}

__device__ __forceinline__ void xcd_barrier(const XcdBarrier& b) {
    asm volatile("s_waitcnt vmcnt(0)" ::: "memory");
    __syncthreads();
    if (b.lead && lane_id() == 0) {
        unsigned* bar = b.bar;
        __builtin_amdgcn_s_waitcnt(0);
        unsigned nloc = b.st[0], nx = b.st[1];
        if (nloc == 0u) { xcd_barrier_complete(bar, b.x, nloc, nx); b.st[0] = nloc; b.st[1] = nx; }
        const unsigned old = xb_add(&bar[XB_XSUB(b.x)], 1u);
        const unsigned gen = old / nloc;
        if (old + 1u == (gen + 1u) * nloc) {
            __builtin_amdgcn_fence(__ATOMIC_RELEASE, "agent");
            asm volatile("s_waitcnt vmcnt(0)" ::: "memory");
            const unsigned og = xb_add(&bar[XB_TOP], 1u);
            const unsigned tg = og / nx;
            if (og + 1u == (tg + 1u) * nx) xb_add(&bar[XB_TOPGEN], 1u);
            else XB_SPIN(xb_ld(&bar[XB_TOPGEN]) == tg, bar);
            __builtin_amdgcn_fence(__ATOMIC_ACQUIRE, "agent");
            xb_add(&bar[XB_XGEN(b.x)], 1u);
            asm volatile("s_waitcnt vmcnt(0)" ::: "memory");
        } else {
            XB_SPIN(xb_ld(&bar[XB_XGEN(b.x)]) == gen, bar);
            __builtin_amdgcn_fence(__ATOMIC_ACQUIRE, "agent");
            asm volatile("s_waitcnt vmcnt(0)" ::: "memory");
        }
    }
    __syncthreads();
}


template <class MapF>
__device__ __forceinline__ void tr_item(const float* W, int K, int N, int ldw, bf16_t* WT, const float* kscale, LAS float* scr, int item, int lane, const MapF& map) {
    const int nblk = (N + 31) / 32, kb = item / nblk, nb = item % nblk, k0 = 64 * kb, n0 = 32 * nb;
    const int nn = n0 + (lane & 31);
#pragma unroll 8
    for (int i = 0; i < 32; ++i) { const int kk = 2 * i + (lane >> 5); float v = (nn < N) ? W[(size_t)(k0 + kk) * ldw + nn] : 0.f; if (kscale) v *= kscale[k0 + kk]; scr[kk * 33 + (lane & 31)] = v; }
    asm volatile("s_waitcnt lgkmcnt(0)" ::: "memory");
    const int c = lane & 7;
#pragma unroll
    for (int jx = 0; jx < 4; ++jx) { const int n = (lane >> 3) + 8 * jx; const LAS float* s = scr + (8 * c) * 33 + n;
        u32x4 o; o.x = cvtpk(s[0 * 33], s[1 * 33]); o.y = cvtpk(s[2 * 33], s[3 * 33]); o.z = cvtpk(s[4 * 33], s[5 * 33]); o.w = cvtpk(s[6 * 33], s[7 * 33]);
        if (n0 + n < N) *(u32x4*)(WT + (size_t)map(n0 + n) * K + k0 + 8 * c) = o; }
    asm volatile("s_waitcnt lgkmcnt(0)" ::: "memory");
}
__device__ __forceinline__ int rope_pos(int d) { return d < 32 ? 8 * (d >> 2) + (d & 3) : 8 * ((d - 32) >> 2) + 4 + (d & 3); }
struct MapIn {
    __device__ __forceinline__ int operator()(int n) const {
        if (n >= 2840) return 2816 + (n - 2840);
        if (n >= 2816) return 4864 + (n - 2816);
        if (n < 1024 || (n >= 1536 && n < 2048)) {
            const int tile = (n < 1024) ? (n >> 8) : 6 + ((n - 1536) >> 8), hq = (n >> 6) & 3, d = n & 63;
            return tile * 256 + (d >= 32 ? 128 : 0) + hq * 32 + (d & 31); }
        if (n < 1536) return n;
        const bool rope = (((n - 2048) >> 7) & 1) == 0;
        return rope ? (n & ~63) + rope_pos(n & 63) : n;
    }
};
struct MapId { int off; __device__ __forceinline__ int operator()(int n) const { return off + n; } };
struct MapGU { int up; __device__ __forceinline__ int operator()(int f) const { return 256 * (f >> 7) + 128 * up + (f & 127); } };

__device__ __forceinline__ int queue_fetch(unsigned* qbase, unsigned x, LAS int* kstate) {
    int k = *kstate;
    while (k < 8) { const unsigned q = (x + (unsigned)k) & 7u; const unsigned li = atomicAdd(qbase + 64 * q, 1u); if (li < 128u) { *kstate = k; return (int)(q * 128u + li); } ++k; }
    *kstate = k; return -1;
}
struct Args { const void* in[20]; float* out; unsigned char* ws; int use_cg; int pad; };

__global__ void __launch_bounds__(512, 2) hybrid_fwd(Args args) {
    extern __shared__ __attribute__((aligned(16))) unsigned char lds_raw[];
    LAS unsigned char* L = (LAS unsigned char*)lds_raw;
    cg::grid_group grid = cg::this_grid();
    const int wave_s = __builtin_amdgcn_readfirstlane((int)(threadIdx.x >> 6));
#define PHASE_IDS() int tid_ = wave_s * 64 + lane_id(); asm volatile("" : "+v"(tid_)); const int tid = tid_, lane = tid & 63, wave = __builtin_amdgcn_readfirstlane(tid >> 6); (void)lane; (void)wave
    const int G = gridDim.x, bx = blockIdx.x;
    unsigned char* ws = args.ws;
    const float* x = (const float*)args.in[0];
    const int* positions = (const int*)args.in[1];
    float* out = args.out;
    unsigned* ctl = (unsigned*)(ws + WS_CTL);
    LAS int* misc = (LAS int*)(L + LDS_BYTES - 64);
    { const int t0 = wave_s * 64 + lane_id(); if (t0 < 16) misc[t0] = 0; }
    __syncthreads();
    const XcdBarrier xbar = xcd_barrier_post(ctl + 4096, (volatile LAS unsigned*)(misc + 8), wave_s == 0);

    {
        PHASE_IDS();
        LAS float* scr = (LAS float*)(L + wave * 16384);
        const int gw = bx * 8 + wave, NGW = G * 8;
        const float* g1 = (const float*)args.in[2]; const float* g2 = (const float*)args.in[15];
        constexpr int I_IN = 16 * 153, I_G = 16 * 88, I_D = 44 * 32, I_O = 16 * 32, I_A = 8 * 32, I_C = 16 * 8;
        constexpr int NIT = I_IN + 2 * I_G + I_D + I_O + 2 * I_A + 4 * I_C;
        for (int it = gw; it < NIT; it += NGW) {
            int r = it;
            if (r < I_IN) { tr_item((const float*)args.in[3], 1024, 4888, 4888, (bf16_t*)(ws + WS_WIN), g1, scr, r, lane, MapIn{}); continue; } r -= I_IN;
            if (r < I_G) { tr_item((const float*)args.in[16], 1024, FF, FF, (bf16_t*)(ws + WS_WGU), g2, scr, r, lane, MapGU{0}); continue; } r -= I_G;
            if (r < I_G) { tr_item((const float*)args.in[17], 1024, FF, FF, (bf16_t*)(ws + WS_WGU), g2, scr, r, lane, MapGU{1}); continue; } r -= I_G;
            if (r < I_D) { tr_item((const float*)args.in[18], FF, 1024, 1024, (bf16_t*)(ws + WS_WD), nullptr, scr, r, lane, MapId{0}); continue; } r -= I_D;
            if (r < I_O) { tr_item((const float*)args.in[14], 1024, 1024, 1024, (bf16_t*)(ws + WS_WO), nullptr, scr, r, lane, MapId{0}); continue; } r -= I_O;
            if (r < I_A) { tr_item((const float*)args.in[12], 512, 1024, 1024, (bf16_t*)(ws + WS_WA), nullptr, scr, r, lane, MapId{0}); continue; } r -= I_A;
            if (r < I_A) { tr_item((const float*)args.in[13], 512, 1024, 1024, (bf16_t*)(ws + WS_WB), nullptr, scr, r, lane, MapId{0}); continue; } r -= I_A;
            if (r < I_C) { tr_item((const float*)args.in[8], 1024, 256, 256, (bf16_t*)(ws + WS_W1K), nullptr, scr, r, lane, MapId{0}); continue; } r -= I_C;
            if (r < I_C) { tr_item((const float*)args.in[8] + 1024 * 256, 1024, 256, 256, (bf16_t*)(ws + WS_W1K), nullptr, scr, r, lane, MapId{256}); continue; } r -= I_C;
            if (r < I_C) { tr_item((const float*)args.in[10], 1024, 256, 256, (bf16_t*)(ws + WS_W1V), nullptr, scr, r, lane, MapId{0}); continue; } r -= I_C;
            tr_item((const float*)args.in[10] + 1024 * 256, 1024, 256, 256, (bf16_t*)(ws + WS_W1V), nullptr, scr, r, lane, MapId{256});
        }
        bf16_t* XB = (bf16_t*)(ws + WS_XB); float* rs1 = (float*)(ws + WS_RS1);
        float* cosT = (float*)(ws + WS_COS); float* sinT = (float*)(ws + WS_SIN);
        const float invf = 1.0f / powf(10000.0f, (float)(2 * (lane & 31)) / 64.0f);
        for (int m = gw; m < T; m += NGW) {
            const f32x4* xr = (const f32x4*)(x + (size_t)m * D) + lane;
            f32x4 v[4]; float s = 0.f;
#pragma unroll
            for (int jx = 0; jx < 4; ++jx) { v[jx] = xr[64 * jx]; s += (v[jx][0] * v[jx][0] + v[jx][1] * v[jx][1]) + (v[jx][2] * v[jx][2] + v[jx][3] * v[jx][3]); }
            s = wave_sum(s);
            if (lane == 0) rs1[m] = rsqrtf(s * (1.f / D) + EPS);
            u32x2* o8 = (u32x2*)(XB + (size_t)m * D) + lane;
#pragma unroll
            for (int jx = 0; jx < 4; ++jx) { u32x2 w; w.x = cvtpk(v[jx][0], v[jx][1]); w.y = cvtpk(v[jx][2], v[jx][3]); o8[64 * jx] = w; }
            const float ang = (float)positions[m] * invf;
            if (lane < 32) cosT[(size_t)m * 32 + lane] = cosf(ang); else sinT[(size_t)m * 32 + (lane - 32)] = sinf(ang);
        }
        if (bx < 32) {
            const int kv = bx >> 4, slab = bx & 15;
            const float* pe = (const float*)args.in[kv ? 7 : 6]; const float* W1 = (const float*)args.in[kv ? 10 : 8];
            const int n = tid & 255, half = tid >> 8; float acc = 0.f;
            for (int k = slab * 128 + half * 64; k < slab * 128 + half * 64 + 64; ++k) acc += pe[k] * W1[(size_t)k * 256 + n];
            __syncthreads();
            LAS float* red = (LAS float*)L;
            if (half) red[n] = acc;
            __syncthreads();
            if (!half) ((float*)(ws + WS_BIASP))[(kv * 16 + slab) * 256 + n] = acc + red[n];
            __syncthreads();
        }
    }
    if (args.use_cg) grid.sync(); else xcd_barrier(xbar);
    {
        pg8::Gemm g{(const bf16_t*)(ws + WS_XB), (const bf16_t*)(ws + WS_WIN), T, INP, D}; pg8::StaticOrder SO; SO.init(T, INP, G, bx);
        EpiProj E{(const float*)(ws + WS_RS1), (const float*)(ws + WS_COS), (const float*)(ws + WS_SIN), ws};
        pg8::gemm_phase<EpiProj, true>(L, g, SO, E, wave_s);
    }
    xcd_barrier(xbar);
    {
        PHASE_IDS();
        { pg8::Gemm g{(const bf16_t*)(ws + WS_KC), (const bf16_t*)(ws + WS_W1K), 4096, 512, 1024}; pg8::StaticOrder SO; SO.init(4096, 512, G, bx);
          EpiF32 E{(float*)(ws + WS_GK), 512}; pg8::gemm_phase<EpiF32, true>(L, g, SO, E, wave_s); }
        { pg8::Gemm g{(const bf16_t*)(ws + WS_VC), (const bf16_t*)(ws + WS_W1V), 4096, 512, 1024}; pg8::StaticOrder SO; SO.init(4096, 512, G, (bx + G - 32) % G);
          EpiF32 E{(float*)(ws + WS_GV), 512}; pg8::gemm_phase<EpiF32, true>(L, g, SO, E, wave_s); }
        __syncthreads();
        const float* lf = (const float*)args.in[4];
        float sa = 0.f, sb = 0.f;
        for (int d = 0; d < 64; ++d) { sa += lf[d] * lf[64 + d]; sb += lf[128 + d] * lf[192 + d]; }
        const float lam = __uint_as_float((unsigned)__builtin_amdgcn_readfirstlane((int)__float_as_uint(expf(sa) - expf(sb) + LAM_INIT)));
        if (wave_s == 0 && lane_id() == 0) misc[1] = 0;
        for (;;) {
            if (wave_s == 0 && lane_id() == 0) misc[0] = queue_fetch(ctl + 512, xbar.x & 7u, misc + 1);
            __syncthreads();
            const int idx = misc[0];
            __syncthreads();
            if (idx < 0) break;
            const int li = idx & 127, qb = 31 - (li >> 2), bh = (idx >> 7) * 4 + (li & 3);
            diff_unit(L, bh >> 2, bh & 3, qb, ws, lam, (const float*)args.in[5], wave_s);
        }
    }
    xcd_barrier(xbar);
    {
        PHASE_IDS();
        LAS float* hid = (LAS float*)L;
        LAS float* bias = hid + 4096;
        for (int un = bx; un < 512; un += G) {
            const int kv = un >> 8, p = (un >> 4) & 15, rb = un & 15;
            const float* Gm = (const float*)(ws + (kv ? WS_GV : WS_GK));
            const float* w2 = (const float*)args.in[kv ? 11 : 9];
            if (tid < 256) { float a = 0.f; const float* bp = (const float*)(ws + WS_BIASP) + kv * 16 * 256 + tid;
#pragma unroll
                for (int s = 0; s < 16; ++s) a += bp[s * 256]; bias[tid] = a; }
            __syncthreads();
#pragma unroll
            for (int i = 0; i < 8; ++i) { const int e = tid + 512 * i, r = e >> 8, k = e & 255, c = 16 * rb + r; const size_t R = (size_t)p * 256 + c;
                float v = Gm[R * 512 + k] + bias[k]; if (c < 255) v += Gm[(R + 1) * 512 + 256 + k];
                hid[r * 256 + k] = v / (1.f + __expf(-v)); }
            __syncthreads();
            const int d = tid & 63, r0 = tid >> 6; float a0 = 0.f, a1 = 0.f;
#pragma unroll 8
            for (int k = 0; k < 256; ++k) { const float w = w2[k * 64 + d]; a0 += hid[r0 * 256 + k] * w; a1 += hid[(r0 + 8) * 256 + k] * w; }
            bf16_t* O = (bf16_t*)(ws + (kv ? WS_VCMP : WS_KCMP)) + ((size_t)p * 256 + 16 * rb) * 64;
            O[r0 * 64 + d] = (bf16_t)(cvtpk(a0, 0.f) & 0xffffu); O[(r0 + 8) * 64 + d] = (bf16_t)(cvtpk(a1, 0.f) & 0xffffu);
            __syncthreads();
        }
    }
    xcd_barrier(xbar);
    {
        PHASE_IDS();
        if (wave_s == 0 && lane_id() == 0) misc[1] = 0;
        for (;;) {
            if (wave_s == 0 && lane_id() == 0) misc[0] = queue_fetch(ctl + 1024, xbar.x & 7u, misc + 1);
            __syncthreads();
            const int idx = misc[0];
            __syncthreads();
            if (idx < 0) break;
            const int li = idx & 127, qblk = 63 - (li >> 1), pgx = (idx >> 7) * 2 + (li & 1);
            nsa_unit(L, pgx >> 1, pgx & 1, qblk, ws, wave_s);
        }
    }
    xcd_barrier(xbar);
    {
        { pg8::Gemm g{(const bf16_t*)(ws + WS_YA), (const bf16_t*)(ws + WS_WA), T, D, 512}; pg8::StaticOrder SO; SO.init(T, D, G, bx);
          EpiBranch<false> E{(bf16_t*)(ws + WS_XB), (const bf16_t*)(ws + WS_MG)}; pg8::gemm_phase<EpiBranch<false>, true>(L, g, SO, E, wave_s); }
        __syncthreads();
        { pg8::Gemm g{(const bf16_t*)(ws + WS_YB), (const bf16_t*)(ws + WS_WB), T, D, 512}; pg8::StaticOrder SO; SO.init(T, D, G, bx);
          EpiBranch<true> E{(bf16_t*)(ws + WS_XB), (const bf16_t*)(ws + WS_MG)}; pg8::gemm_phase<EpiBranch<true>, true>(L, g, SO, E, wave_s); }
    }
    xcd_barrier(xbar);
    {
        pg8::Gemm g{(const bf16_t*)(ws + WS_XB), (const bf16_t*)(ws + WS_WO), T, D, D}; pg8::StaticOrder SO; SO.init(T, D, G, bx);
        EpiResid<false> E{(const void*)x, (bf16_t*)(ws + WS_YA), (float*)(ws + WS_SSQ2)};
        pg8::gemm_phase<EpiResid<false>, true>(L, g, SO, E, wave_s);
    }
    xcd_barrier(xbar);
    {
        pg8::Gemm g{(const bf16_t*)(ws + WS_YA), (const bf16_t*)(ws + WS_WGU), T, FF2, D}; pg8::StaticOrder SO; SO.init(T, FF2, G, bx);
        EpiGU E{(const float*)(ws + WS_SSQ2), (bf16_t*)(ws + WS_ACT)};
        pg8::gemm_phase<EpiGU, true>(L, g, SO, E, wave_s);
    }
    xcd_barrier(xbar);
    {
        pg8::Gemm g{(const bf16_t*)(ws + WS_ACT), (const bf16_t*)(ws + WS_WD), T, D, FF}; pg8::StaticOrder SO; SO.init(T, D, G, bx);
        EpiResid<true> E{(const void*)(ws + WS_YA), (bf16_t*)(ws + WS_XB), (float*)(ws + WS_SSQ3)};
        pg8::gemm_phase<EpiResid<true>, true>(L, g, SO, E, wave_s);
    }
    xcd_barrier(xbar);
    {
        PHASE_IDS();
        const float* gf = (const float*)args.in[19]; const float* SSQ3 = (const float*)(ws + WS_SSQ3);
        const int gw = bx * 8 + wave, NGW = G * 8;
        f32x4 gv[4];
#pragma unroll
        for (int jx = 0; jx < 4; ++jx) gv[jx] = ((const f32x4*)gf)[lane + 64 * jx];
        for (int m = gw; m < T; m += NGW) {
            float s = (lane < 16) ? SSQ3[(size_t)m * 16 + lane] : 0.f;
            s = wave_sum(s);
            const float rs = rsqrtf(s * (1.f / D) + EPS);
            const u32x2* hr = (const u32x2*)((const bf16_t*)(ws + WS_XB) + (size_t)m * D) + lane;
            f32x4* xr = (f32x4*)(out + (size_t)m * D) + lane;
#pragma unroll
            for (int jx = 0; jx < 4; ++jx) { const u32x2 w = hr[64 * jx]; f32x4 v = {bflo(w.x), bfhi(w.x), bflo(w.y), bfhi(w.y)}; v = v * rs * gv[jx]; xr[64 * jx] = v; }
        }
    }
}

extern "C" void kernel_launch(void* const* d_in, const int* in_sizes, int n_in, void* d_out, int out_size, void* d_ws, size_t ws_size, hipStream_t stream) {
    static int grid = 0;
    if (grid == 0) {
        if (n_in != 20 || out_size != T * D || ws_size < WS_END) { fprintf(stderr, "kernel_launch: unexpected shapes (n_in %d out %d ws %zu)\n", n_in, out_size, ws_size); grid = -1; return; }
        int dev = 0, cus = 0, per_cu = 0;
        hipGetDevice(&dev);
        hipDeviceGetAttribute(&cus, hipDeviceAttributeMultiprocessorCount, dev);
        hipFuncSetAttribute((const void*)hybrid_fwd, hipFuncAttributeMaxDynamicSharedMemorySize, LDS_BYTES);
        hipOccupancyMaxActiveBlocksPerMultiprocessor(&per_cu, (const void*)hybrid_fwd, 512, LDS_BYTES);
        if (per_cu < 1) { fprintf(stderr, "kernel_launch: occupancy query says %d blocks per CU\n", per_cu); per_cu = 1; }
        (void)hipGetLastError();
        grid = cus * per_cu;
    }
    if (grid < 0) return;
    hipMemsetAsync((char*)d_ws + WS_CTL, 0, 32768, stream);
    Args a{};
    for (int i = 0; i < 20; ++i) a.in[i] = d_in[i];
    a.out = (float*)d_out; a.ws = (unsigned char*)d_ws;
    void* params[] = {&a};
    hipError_t e = hipLaunchCooperativeKernel((const void*)hybrid_fwd, dim3(grid), dim3(512), params, LDS_BYTES, stream);
    if (e != hipSuccess) fprintf(stderr, "cooperative launch failed: %s (grid %d)\n", hipGetErrorString(e), grid);
}
```

```cpp
#include <hip/hip_runtime.h>
#include <hip/hip_cooperative_groups.h>
#include <cstdint>
#include <cstdio>
#include <type_traits>
namespace cg = cooperative_groups;

#define LAS __attribute__((address_space(3)))
typedef unsigned short bf16_t;
typedef short bf16x8 __attribute__((ext_vector_type(8)));
typedef short s16x4 __attribute__((ext_vector_type(4)));
typedef float f32x4 __attribute__((ext_vector_type(4)));
typedef float f32x2 __attribute__((ext_vector_type(2)));
typedef float f32x16 __attribute__((ext_vector_type(16)));
typedef unsigned u32x4 __attribute__((ext_vector_type(4)));
typedef unsigned u32x2 __attribute__((ext_vector_type(2)));
typedef __bf16 bf16x2_t __attribute__((ext_vector_type(2)));

constexpr int NB = 8, S = 4096, T = NB * S, D = 1024, FF = 2816, FF2 = 2 * FF, INP = 5120;
constexpr float EPS = 1e-6f;
constexpr float C2 = 0.125f * 1.4426950408889634f;
constexpr float LAM_INIT = 0.2f;

constexpr size_t MiB = 1u << 20;
constexpr size_t WS_CTL = 0;
constexpr size_t WS_WIN = 1 * MiB, WS_WGU = 11 * MiB, WS_WD = 22 * MiB, WS_WO = 28 * MiB, WS_WA = 30 * MiB, WS_WB = 31 * MiB, WS_W1K = 32 * MiB, WS_W1V = 33 * MiB;
constexpr size_t WS_COS = 34 * MiB, WS_SIN = 38 * MiB;
constexpr size_t WS_RS1 = 42 * MiB, WS_SSQ2 = 43 * MiB, WS_SSQ3 = 45 * MiB, WS_NG = 47 * MiB, WS_BIASP = 50 * MiB;
constexpr size_t WS_GK = 52 * MiB, WS_GV = 60 * MiB, WS_KCMP = 68 * MiB, WS_VCMP = 69 * MiB;
constexpr size_t WS_XB = 70 * MiB;
constexpr size_t WS_DQ = 134 * MiB, WS_DK = 166 * MiB, WS_DV = 198 * MiB, WS_NQ = 230 * MiB;
constexpr size_t WS_KC = 262 * MiB, WS_VC = 270 * MiB, WS_KS = 278 * MiB, WS_VS = 286 * MiB, WS_KW = 294 * MiB, WS_VW = 302 * MiB;
constexpr size_t WS_ACT = 134 * MiB;
constexpr size_t WS_MG = 310 * MiB;
constexpr size_t WS_YA = 438 * MiB, WS_YB = 470 * MiB;
constexpr size_t WS_END = 502 * MiB;
constexpr int LDS_BYTES = 155648;

__device__ __forceinline__ unsigned cvtpk(float lo, float hi) { f32x2 v = {lo, hi}; bf16x2_t b = __builtin_convertvector(v, bf16x2_t); return __builtin_bit_cast(unsigned, b); }
__device__ __forceinline__ float bf2f(unsigned short h) { return __uint_as_float(((unsigned)h) << 16); }
__device__ __forceinline__ float bflo(unsigned w) { return __uint_as_float(w << 16); }
__device__ __forceinline__ float bfhi(unsigned w) { return __uint_as_float(w & 0xffff0000u); }
__device__ __forceinline__ float sigmoidf_(float x) { return __builtin_amdgcn_rcpf(1.f + __builtin_amdgcn_exp2f(x * -1.4426950408889634f)); }
__device__ __forceinline__ int lane_id() { unsigned z = 0u; asm volatile("" : "+v"(z)); return (int)__builtin_amdgcn_mbcnt_hi(~0u, __builtin_amdgcn_mbcnt_lo(~0u, z)); }
__device__ __forceinline__ float xor32_sum(float v) { auto rr = __builtin_amdgcn_permlane32_swap(__float_as_uint(v), __float_as_uint(v), false, false); return __uint_as_float(rr[0]) + __uint_as_float(rr[1]); }
__device__ __forceinline__ float xor32_max(float v) { auto rr = __builtin_amdgcn_permlane32_swap(__float_as_uint(v), __float_as_uint(v), false, false); return __builtin_fmaxf(__uint_as_float(rr[0]), __uint_as_float(rr[1])); }
__device__ __forceinline__ float wave_sum(float v) {
#pragma unroll
    for (int o = 1; o < 64; o <<= 1) v += __shfl_xor(v, o);
    return v;
}

namespace pg8 {
constexpr int BM = 256, BK = 64, HALF = 128, HTB = HALF * BK * 2, STAGE_BYTES = 8 * HTB, NXCD = 8, WGM = 8;
__host__ __device__ __forceinline__ int lds_byte(int r, int c) { const int st = (r >> 4) * 2 + (c >> 5), rr = r & 15, cc = c & 31, ob = rr * 64 + cc * 2; return st * 1024 + (ob ^ (((ob >> 9) & 1) << 5)); }
__host__ __device__ __forceinline__ void stage_rc(int b, int& R, int& C) { const int st = b / 1024, sb = b % 1024, swz = sb ^ (((sb >> 9) & 1) << 5); R = (st >> 1) * 16 + swz / 64; C = (st & 1) * 32 + (swz % 64) / 2; }
__host__ __device__ __forceinline__ int perm32(int rho) { const int n = rho >> 4, i = rho & 15; return 8 * (i >> 2) + 4 * n + (i & 3); }
struct Unit { int pm, pn; };
struct Gemm { const bf16_t* A; const bf16_t* Bt; int M, N, K; };
struct StaticOrder {
    int nM, nN, nwg, G, c;
    __host__ __device__ void init(int M, int N, int G_, int c_) { nM = M / BM; nN = N / BM; nwg = nM * nN; G = G_; c = c_; }
    __host__ __device__ bool next(int i, Unit& u) const {
        const long L = (long)i * G + c; if (L >= nwg) return false;
        int wgid = (int)L; { const int q = nwg / NXCD, r = nwg % NXCD, xcd = wgid % NXCD, off = wgid / NXCD; wgid = (xcd < r ? xcd * (q + 1) : r * (q + 1) + (xcd - r) * q) + off; }
        const int nig = WGM * nN, gid = wgid / nig, fm = gid * WGM, gsz = (nM - fm) < WGM ? (nM - fm) : WGM;
        u.pm = fm + ((wgid % nig) % gsz); u.pn = (wgid % nig) / gsz; return true;
    }
};
template <class Epi, bool ALIGN_EPI>
__device__ __forceinline__ void gemm_phase(LAS unsigned char* lds, const Gemm g, const StaticOrder& S, const Epi& E, int wv) {
    int tid_ = wv * 64 + lane_id(); asm volatile("" : "+v"(tid_));
    const int tid = tid_, wid = __builtin_amdgcn_readfirstlane(tid >> 6), lane = tid & 63, wr = wid >> 2, wc = wid & 3, fr = lane & 15, fq = lane >> 4;
    const int K = g.K, nt = K / BK;
    unsigned voffA[2], voffB[2];
#pragma unroll
    for (int i = 0; i < 2; ++i) { int R, C; stage_rc(tid * 16 + i * 8192, R, C); const int Rb = (R & ~31) + perm32(R & 31);
        voffA[i] = (unsigned)(R * K + C) * 2u; voffB[i] = (unsigned)(Rb * K + C) * 2u; }
    const size_t kstep = (size_t)(BK * 2);
    const size_t hstep = (size_t)HALF * K * 2;
    const size_t tstep = 2 * hstep;
    const unsigned ldsw = (unsigned)wid * 1024u;
    const int aoff = lds_byte(wr * 64 + fr, fq * 8), boff = lds_byte(wc * 32 + fr, fq * 8);
#define PG8_SA(b, h) (((b) * 2 + (h)) * HTB)
#define PG8_SB(b, h) ((4 + (b) * 2 + (h)) * HTB)
#define PG8_STAGE(bufoff, gbase, voff) do { _Pragma("unroll") for (int _i = 0; _i < 2; ++_i) \
        __builtin_amdgcn_global_load_lds((const unsigned*)((const char*)(gbase) + (voff)[_i]), (LAS unsigned*)(lds + (bufoff) + ldsw + _i * 8192), 16, 0, 0); } while (0)
#define PG8_LDA(dst, b, h) do { _Pragma("unroll") for (int m = 0; m < 4; ++m) _Pragma("unroll") for (int k = 0; k < 2; ++k) dst[m][k] = *(const LAS bf16x8*)(lds + PG8_SA(b, h) + aoff + m * 2048 + k * 1024); } while (0)
#define PG8_LDB(dst, b, h) do { _Pragma("unroll") for (int n = 0; n < 2; ++n) _Pragma("unroll") for (int k = 0; k < 2; ++k) dst[n][k] = *(const LAS bf16x8*)(lds + PG8_SB(b, h) + boff + n * 2048 + k * 1024); } while (0)
#define PG8_MMA(ai, bj, At, Bt) do { __builtin_amdgcn_s_setprio(1); _Pragma("unroll") for (int m = 0; m < 4; ++m) _Pragma("unroll") for (int n = 0; n < 2; ++n) _Pragma("unroll") for (int k = 0; k < 2; ++k) \
        acc[ai][bj][m][n] = __builtin_amdgcn_mfma_f32_16x16x32_bf16(Bt[n][k], At[m][k], acc[ai][bj][m][n], 0, 0, 0); __builtin_amdgcn_s_setprio(0); } while (0)
#define PG8_WAIT_V(n) asm volatile("s_waitcnt vmcnt(" #n ")" ::: "memory")
#define PG8_WAIT_L(n) asm volatile("s_waitcnt lgkmcnt(" #n ")" ::: "memory")
#define PG8_BAR __builtin_amdgcn_s_barrier()
#define PG8_SCHED __builtin_amdgcn_sched_barrier(0)
    Unit cur, nxt; int ui = 0;
    if (!S.next(0, cur)) return;
    f32x4 acc[2][2][4][2];
#pragma unroll
    for (int a = 0; a < 2; ++a)
#pragma unroll
        for (int b = 0; b < 2; ++b)
#pragma unroll
            for (int m = 0; m < 4; ++m)
#pragma unroll
                for (int n = 0; n < 2; ++n) acc[a][b][m][n] = (f32x4){0.f, 0.f, 0.f, 0.f};
    bf16x8 At[4][2], B0[2][2], B1[2][2];
    const char* cA = (const char*)g.A + (size_t)cur.pm * tstep; const char* cB = (const char*)g.Bt + (size_t)cur.pn * tstep;
    PG8_STAGE(PG8_SB(0, 0), cB, voffB); PG8_STAGE(PG8_SB(0, 1), cB + hstep, voffB); PG8_STAGE(PG8_SA(0, 0), cA, voffA); PG8_STAGE(PG8_SA(0, 1), cA + hstep, voffA);
    if (wr == 1) PG8_BAR;
    PG8_WAIT_V(2); PG8_BAR;
    PG8_STAGE(PG8_SB(1, 0), cB + kstep, voffB); PG8_STAGE(PG8_SA(1, 0), cA + kstep, voffA); PG8_STAGE(PG8_SB(1, 1), cB + hstep + kstep, voffB);
    PG8_WAIT_V(6); PG8_BAR;
    for (;;) {
        const bool has_next = S.next(ui + 1, nxt);
        const char* nA = has_next ? (const char*)g.A + (size_t)nxt.pm * tstep : cA; const char* nB = has_next ? (const char*)g.Bt + (size_t)nxt.pn * tstep : cB;
        for (int t = 0; t < nt; t += 2) {
            const bool last = (t == nt - 2);
            const char* a1 = cA + (size_t)(t + 1) * kstep;
            const char* a2 = last ? nA : cA + (size_t)(t + 2) * kstep; const char* b2 = last ? nB : cB + (size_t)(t + 2) * kstep;
            const char* a3 = a2 + kstep; const char* b3 = b2 + kstep;
            PG8_LDB(B0, 0, 0); PG8_LDB(B1, 0, 1); PG8_SCHED; PG8_LDA(At, 0, 0); PG8_STAGE(PG8_SA(1, 1), a1 + hstep, voffA);
            PG8_WAIT_V(8); PG8_WAIT_L(0); PG8_BAR; PG8_MMA(0, 0, At, B0); PG8_MMA(0, 1, At, B1); PG8_BAR; PG8_SCHED;
            PG8_LDA(At, 0, 1); PG8_STAGE(PG8_SB(0, 0), b2, voffB); PG8_STAGE(PG8_SB(0, 1), b2 + hstep, voffB); PG8_STAGE(PG8_SA(0, 0), a2, voffA);
            PG8_WAIT_V(8); PG8_WAIT_L(0); PG8_BAR; PG8_MMA(1, 0, At, B0); PG8_MMA(1, 1, At, B1); PG8_BAR; PG8_SCHED;
            PG8_LDB(B0, 1, 0); PG8_LDB(B1, 1, 1); PG8_SCHED; PG8_LDA(At, 1, 0); PG8_STAGE(PG8_SA(0, 1), a2 + hstep, voffA);
            PG8_WAIT_V(8); PG8_WAIT_L(0); PG8_BAR; PG8_MMA(0, 0, At, B0); PG8_MMA(0, 1, At, B1); PG8_BAR; PG8_SCHED;
            PG8_LDA(At, 1, 1); PG8_STAGE(PG8_SB(1, 0), b3, voffB); PG8_STAGE(PG8_SB(1, 1), b3 + hstep, voffB); PG8_STAGE(PG8_SA(1, 0), a3, voffA);
            PG8_WAIT_V(8); PG8_WAIT_L(0); PG8_BAR; PG8_MMA(1, 0, At, B0); PG8_MMA(1, 1, At, B1); PG8_BAR; PG8_SCHED;
        }
        if constexpr (ALIGN_EPI) { if (wr == 0) PG8_BAR; }
        E(acc, cur, wr, wc, fr, fq);
        if (!has_next) break;
#pragma unroll
        for (int a = 0; a < 2; ++a)
#pragma unroll
            for (int b = 0; b < 2; ++b)
#pragma unroll
                for (int m = 0; m < 4; ++m)
#pragma unroll
                    for (int n = 0; n < 2; ++n) acc[a][b][m][n] = (f32x4){0.f, 0.f, 0.f, 0.f};
        cur = nxt; cA = nA; cB = nB; ++ui;
        if constexpr (ALIGN_EPI) { if (wr == 1) PG8_BAR; }
    }
    PG8_WAIT_V(0);
    if constexpr (!ALIGN_EPI) { if (wr == 0) PG8_BAR; }
    PG8_BAR;
#undef PG8_SA
#undef PG8_SB
#undef PG8_STAGE
#undef PG8_LDA
#undef PG8_LDB
#undef PG8_MMA
#undef PG8_WAIT_V
#undef PG8_WAIT_L
#undef PG8_BAR
#undef PG8_SCHED
}
}

typedef f32x4 AccT[2][2][4][2];

struct EpiProj {
    const float* rs1; const float* cosT; const float* sinT;
    unsigned char* ws;
    __device__ __forceinline__ void operator()(const AccT& acc, const pg8::Unit& u, int wr, int wc, int fr, int fq) const {
        const int row0 = u.pm * 256 + wr * 64 + fr;
        const int pn = u.pn;
        if (pn < 4 || (pn >= 6 && pn <= 9)) {
            bf16_t* base; int hd; float scale = 1.f; size_t hoff, bstride = (size_t)8 * S * 64; bool plain = false;
            if (pn < 2)       { const int h64 = (pn & 1) * 4 + wc; base = (bf16_t*)(ws + WS_DQ); hd = 128; scale = C2; hoff = (size_t)(h64 >> 1) * S * 128 + (h64 & 1) * 64; }
            else if (pn < 4)  { const int h64 = (pn & 1) * 4 + wc; base = (bf16_t*)(ws + WS_DK); hd = 64; hoff = (size_t)h64 * S * 64; }
            else if (pn < 8)  { const int h64 = (pn - 6) * 4 + wc; base = (bf16_t*)(ws + WS_NQ); hd = 64; scale = C2; hoff = (size_t)h64 * S * 64; }
            else if (pn == 8) { base = (bf16_t*)(ws + (wc < 2 ? WS_KC : WS_KS)); hd = 64; hoff = (size_t)(wc & 1) * S * 64; bstride = (size_t)2 * S * 64; }
            else              { base = (bf16_t*)(ws + (wc < 2 ? WS_KW : WS_VC)); hd = 64; hoff = (size_t)(wc & 1) * S * 64; bstride = (size_t)2 * S * 64; plain = wc >= 2; }
            const int d0 = 8 * fq;
            if (!plain) {
#pragma unroll
                for (int ai = 0; ai < 2; ++ai)
#pragma unroll
                    for (int m = 0; m < 4; ++m) { const int r = row0 + ai * 128 + m * 16; const float rs = rs1[r] * scale;
                        const int b = r >> 12, s = r & 4095;
                        bf16_t* p = base + (size_t)b * bstride + hoff + (size_t)s * hd + d0;
                        const f32x4 c0 = *(const f32x4*)(cosT + (size_t)r * 32 + d0), c1 = *(const f32x4*)(cosT + (size_t)r * 32 + d0 + 4), s0 = *(const f32x4*)(sinT + (size_t)r * 32 + d0), s1 = *(const f32x4*)(sinT + (size_t)r * 32 + d0 + 4);
                        const f32x4 xa = acc[ai][0][m][0] * rs, xb = acc[ai][0][m][1] * rs, ya = acc[ai][1][m][0] * rs, yb = acc[ai][1][m][1] * rs;
                        const f32x4 oa = xa * c0 - ya * s0, ob = xb * c1 - yb * s1, pa = ya * c0 + xa * s0, pb = yb * c1 + xb * s1;
                        u32x4 w1, w2; w1.x = cvtpk(oa[0], oa[1]); w1.y = cvtpk(oa[2], oa[3]); w1.z = cvtpk(ob[0], ob[1]); w1.w = cvtpk(ob[2], ob[3]);
                        w2.x = cvtpk(pa[0], pa[1]); w2.y = cvtpk(pa[2], pa[3]); w2.z = cvtpk(pb[0], pb[1]); w2.w = cvtpk(pb[2], pb[3]);
                        *(u32x4*)p = w1; *(u32x4*)(p + 32) = w2; }
            } else {
#pragma unroll
                for (int ai = 0; ai < 2; ++ai)
#pragma unroll
                    for (int m = 0; m < 4; ++m) { const int r = row0 + ai * 128 + m * 16; const float rs = rs1[r];
                        const int b = r >> 12, s = r & 4095;
#pragma unroll
                        for (int bj = 0; bj < 2; ++bj) { const f32x4 v0 = acc[ai][bj][m][0] * rs, v1 = acc[ai][bj][m][1] * rs;
                            u32x4 w; w.x = cvtpk(v0[0], v0[1]); w.y = cvtpk(v0[2], v0[3]); w.z = cvtpk(v1[0], v1[1]); w.w = cvtpk(v1[2], v1[3]);
                            *(u32x4*)(base + ((size_t)(b * 2 + bj) * S + s) * 64 + 32 * (wc & 1) + d0) = w; } }
            }
            return;
        }
#pragma unroll
        for (int bj = 0; bj < 2; ++bj) {
            const int sec = u.pn * 2 + bj;
            if (sec >= 39) continue;
            if (sec == 38) {
                if (wc == 0 && fq < 3) {
                    float* NG = (float*)(ws + WS_NG);
#pragma unroll
                    for (int ai = 0; ai < 2; ++ai)
#pragma unroll
                        for (int m = 0; m < 4; ++m) { const int r = row0 + ai * 128 + m * 16; const float rs = rs1[r];
                            f32x4 v0 = acc[ai][bj][m][0] * rs, v1 = acc[ai][bj][m][1] * rs;
                            f32x4 o0, o1;
#pragma unroll
                            for (int i = 0; i < 4; ++i) { o0[i] = sigmoidf_(v0[i]); o1[i] = sigmoidf_(v1[i]); }
                            *(f32x4*)(NG + (size_t)r * 24 + fq * 8) = o0; *(f32x4*)(NG + (size_t)r * 24 + fq * 8 + 4) = o1; }
                }
                continue;
            }
            if (sec >= 22) {
                bf16_t* MG = (bf16_t*)(ws + WS_MG);
                const int col = (sec - 22) * 128 + wc * 32 + fq * 8;
#pragma unroll
                for (int ai = 0; ai < 2; ++ai)
#pragma unroll
                    for (int m = 0; m < 4; ++m) { const int r = row0 + ai * 128 + m * 16; const float rs = rs1[r];
                        f32x4 v0 = acc[ai][bj][m][0] * rs, v1 = acc[ai][bj][m][1] * rs;
                        u32x4 w; w.x = cvtpk(sigmoidf_(v0[0]), sigmoidf_(v0[1])); w.y = cvtpk(sigmoidf_(v0[2]), sigmoidf_(v0[3]));
                        w.z = cvtpk(sigmoidf_(v1[0]), sigmoidf_(v1[1])); w.w = cvtpk(sigmoidf_(v1[2]), sigmoidf_(v1[3]));
                        *(u32x4*)(MG + (size_t)r * 2048 + col) = w; }
                continue;
            }
            bf16_t* base; int H, head, HD, coff; bool rope; float scale = 1.f;
            if (sec < 4)       { base = (bf16_t*)(ws + WS_DQ); H = 4; head = sec;      HD = 128; coff = (wc >> 1) * 64; rope = true; scale = C2; }
            else if (sec < 8)  { base = (bf16_t*)(ws + WS_DK); H = 8; head = (sec - 4) * 2 + (wc >> 1); HD = 64; coff = 0; rope = true; }
            else if (sec < 12) { base = (bf16_t*)(ws + WS_DV); H = 4; head = sec - 8;  HD = 128; coff = (wc >> 1) * 64; rope = false; }
            else if (sec < 16) { base = (bf16_t*)(ws + WS_NQ); H = 8; head = (sec - 12) * 2 + (wc >> 1); HD = 64; coff = 0; rope = true; scale = C2; }
            else { base = (bf16_t*)(ws + (sec == 20 ? WS_VS : WS_VW)); H = 2; head = wc >> 1; HD = 64; coff = 0; rope = false; }
            const int j = 4 * (wc & 1) + fq;
#pragma unroll
            for (int ai = 0; ai < 2; ++ai)
#pragma unroll
                for (int m = 0; m < 4; ++m) { const int r = row0 + ai * 128 + m * 16; const float rs = rs1[r] * scale;
                    const int b = r >> 12, s = r & 4095;
                    bf16_t* p = base + ((size_t)(b * H + head) * S + s) * HD + coff;
                    f32x4 v0 = acc[ai][bj][m][0] * rs, v1 = acc[ai][bj][m][1] * rs;
                    if (rope) {
                        const f32x4 c = *(const f32x4*)(cosT + (size_t)r * 32 + 4 * j), sn = *(const f32x4*)(sinT + (size_t)r * 32 + 4 * j);
                        const f32x4 o1 = v0 * c - v1 * sn, o2 = v1 * c + v0 * sn;
                        u32x2 w1, w2; w1.x = cvtpk(o1[0], o1[1]); w1.y = cvtpk(o1[2], o1[3]); w2.x = cvtpk(o2[0], o2[1]); w2.y = cvtpk(o2[2], o2[3]);
                        *(u32x2*)(p + 4 * j) = w1; *(u32x2*)(p + 32 + 4 * j) = w2;
                    } else {
                        u32x4 w; w.x = cvtpk(v0[0], v0[1]); w.y = cvtpk(v0[2], v0[3]); w.z = cvtpk(v1[0], v1[1]); w.w = cvtpk(v1[2], v1[3]);
                        *(u32x4*)(p + 8 * j) = w;
                    }
                }
        }
    }
};
struct EpiF32 {
    float* O; int ldc;
    __device__ __forceinline__ void operator()(const AccT& acc, const pg8::Unit& u, int wr, int wc, int fr, int fq) const {
        const int row0 = u.pm * 256 + wr * 64 + fr, col0 = u.pn * 256 + wc * 32 + fq * 8;
#pragma unroll
        for (int ai = 0; ai < 2; ++ai)
#pragma unroll
            for (int m = 0; m < 4; ++m)
#pragma unroll
                for (int bj = 0; bj < 2; ++bj) { float* p = O + (size_t)(row0 + ai * 128 + m * 16) * ldc + col0 + bj * 128;
                    *(f32x4*)p = acc[ai][bj][m][0]; *(f32x4*)(p + 4) = acc[ai][bj][m][1]; }
    }
};
template <bool SECOND> struct EpiBranch {
    bf16_t* MERGED; const bf16_t* MG;
    __device__ __forceinline__ void operator()(const AccT& acc, const pg8::Unit& u, int wr, int wc, int fr, int fq) const {
        const int row0 = u.pm * 256 + wr * 64 + fr, col0 = u.pn * 256 + wc * 32 + fq * 8;
#pragma unroll
        for (int ai = 0; ai < 2; ++ai)
#pragma unroll
            for (int m = 0; m < 4; ++m)
#pragma unroll
                for (int bj = 0; bj < 2; ++bj) { const int r = row0 + ai * 128 + m * 16, c = col0 + bj * 128;
                    const u32x4 g = *(const u32x4*)(MG + (size_t)r * 2048 + (SECOND ? 1024 : 0) + c);
                    const f32x4 a0 = acc[ai][bj][m][0], a1 = acc[ai][bj][m][1];
                    float o[8] = {bflo(g.x) * a0[0], bfhi(g.x) * a0[1], bflo(g.y) * a0[2], bfhi(g.y) * a0[3], bflo(g.z) * a1[0], bfhi(g.z) * a1[1], bflo(g.w) * a1[2], bfhi(g.w) * a1[3]};
                    bf16_t* p = MERGED + (size_t)r * 1024 + c;
                    if (SECOND) { const u32x4 pv = *(const u32x4*)p;
                        o[0] += bflo(pv.x); o[1] += bfhi(pv.x); o[2] += bflo(pv.y); o[3] += bfhi(pv.y); o[4] += bflo(pv.z); o[5] += bfhi(pv.z); o[6] += bflo(pv.w); o[7] += bfhi(pv.w); }
                    u32x4 w; w.x = cvtpk(o[0], o[1]); w.y = cvtpk(o[2], o[3]); w.z = cvtpk(o[4], o[5]); w.w = cvtpk(o[6], o[7]);
                    *(u32x4*)p = w; }
    }
};
template <bool BASE_BF> struct EpiResid {
    const void* base; bf16_t* HB; float* SSQ;
    __device__ __forceinline__ void operator()(const AccT& acc, const pg8::Unit& u, int wr, int wc, int fr, int fq) const {
        const int row0 = u.pm * 256 + wr * 64 + fr, col0 = u.pn * 256 + wc * 32 + fq * 8;
#pragma unroll
        for (int ai = 0; ai < 2; ++ai)
#pragma unroll
            for (int m = 0; m < 4; ++m) { const int r = row0 + ai * 128 + m * 16; float ss = 0.f;
#pragma unroll
                for (int bj = 0; bj < 2; ++bj) { const size_t off = (size_t)r * 1024 + col0 + bj * 128;
                    f32x4 b0, b1;
                    if (BASE_BF) { const u32x4 g = *(const u32x4*)((const bf16_t*)base + off); b0 = (f32x4){bflo(g.x), bfhi(g.x), bflo(g.y), bfhi(g.y)}; b1 = (f32x4){bflo(g.z), bfhi(g.z), bflo(g.w), bfhi(g.w)}; }
                    else { b0 = *(const f32x4*)((const float*)base + off); b1 = *(const f32x4*)((const float*)base + off + 4); }
                    const f32x4 h0 = b0 + acc[ai][bj][m][0], h1 = b1 + acc[ai][bj][m][1];
                    ss += (h0[0] * h0[0] + h0[1] * h0[1]) + (h0[2] * h0[2] + h0[3] * h0[3]) + (h1[0] * h1[0] + h1[1] * h1[1]) + (h1[2] * h1[2] + h1[3] * h1[3]);
                    u32x4 w; w.x = cvtpk(h0[0], h0[1]); w.y = cvtpk(h0[2], h0[3]); w.z = cvtpk(h1[0], h1[1]); w.w = cvtpk(h1[2], h1[3]); *(u32x4*)(HB + off) = w; }
                ss += __shfl_xor(ss, 16); ss += __shfl_xor(ss, 32);
                if (fq == 0) SSQ[(size_t)r * 16 + u.pn * 4 + wc] = ss; }
    }
};
struct EpiGU {
    const float* SSQ2; bf16_t* ACT;
    __device__ __forceinline__ void operator()(const AccT& acc, const pg8::Unit& u, int wr, int wc, int fr, int fq) const {
        const int row0 = u.pm * 256 + wr * 64 + fr, col0 = u.pn * 128 + wc * 32 + fq * 8;
#pragma unroll
        for (int ai = 0; ai < 2; ++ai)
#pragma unroll
            for (int m = 0; m < 4; ++m) { const int r = row0 + ai * 128 + m * 16;
                const f32x4* sp = (const f32x4*)(SSQ2 + (size_t)r * 16); const f32x4 s0 = sp[0], s1 = sp[1], s2 = sp[2], s3 = sp[3];
                const float tot = ((s0[0] + s0[1]) + (s0[2] + s0[3])) + ((s1[0] + s1[1]) + (s1[2] + s1[3])) + ((s2[0] + s2[1]) + (s2[2] + s2[3])) + ((s3[0] + s3[1]) + (s3[2] + s3[3]));
                const float rs = rsqrtf(tot * (1.f / 1024.f) + EPS);
                float o[8];
#pragma unroll
                for (int n = 0; n < 2; ++n) { const f32x4 gv = acc[ai][0][m][n] * rs, uv = acc[ai][1][m][n] * rs;
#pragma unroll
                    for (int i = 0; i < 4; ++i) o[4 * n + i] = gv[i] * sigmoidf_(gv[i]) * uv[i]; }
                u32x4 w; w.x = cvtpk(o[0], o[1]); w.y = cvtpk(o[2], o[3]); w.z = cvtpk(o[4], o[5]); w.w = cvtpk(o[6], o[7]);
                *(u32x4*)(ACT + (size_t)r * FF + col0) = w; }
    }
};

typedef std::integral_constant<bool, true> TrueC; typedef std::integral_constant<bool, false> FalseC;
__device__ __forceinline__ int crow(int r, int hi) { return (r & 3) + 8 * (r >> 2) + 4 * hi; }
__device__ __forceinline__ constexpr int ccol(int r) { return (r & 3) + 8 * (r >> 2); }
__device__ __forceinline__ void glds16(const void* g, LAS unsigned char* l) {
    unsigned keep; const unsigned dst = (unsigned)__builtin_amdgcn_readfirstlane((int)(unsigned)(uintptr_t)l);
    asm volatile("s_mov_b32 %0, m0\n\ts_mov_b32 m0, %2\n\ts_nop 0\n\tglobal_load_lds_dwordx4 %1, off\n\ts_mov_b32 m0, %0" : "=&s"(keep) : "v"(g), "s"(dst) : "memory");
}
#define VM_DRAIN_SYNC() do { asm volatile("s_waitcnt vmcnt(0)" ::: "memory"); __syncthreads(); } while (0)
#define WAIT_BAR(N) asm volatile("s_waitcnt vmcnt(" #N ") lgkmcnt(0)\n\ts_barrier" ::: "memory")
__device__ __forceinline__ void wait_bar_n(int n) { if (n == 4) WAIT_BAR(4); else if (n == 2) WAIT_BAR(2); else if (n == 1) WAIT_BAR(1); else WAIT_BAR(0); }
__device__ __forceinline__ int ksrc_off(int wid, int lane) { const int ip = (lane - 8 * (wid & 1)) & 63, rho = ip >> 3, c = (ip & 7) ^ rho; return (8 * wid + rho) * 64 + c * 8; }
__device__ __forceinline__ void kread_offs(int (&koff)[4], int r32, int hi) {
    const int pc = r32 >> 3, rho = r32 & 7;
#pragma unroll
    for (int d0 = 0; d0 < 4; ++d0) koff[d0] = pc * 1024 + (((rho * 8 + ((2 * d0 + hi) ^ rho) + 8 * (pc & 1)) & 63) << 4);
}
__device__ __forceinline__ void qkt(f32x16& p0, f32x16& p1, const LAS unsigned char* Kslot, const int (&koff)[4], const bf16x8* qr) {
    bf16x8 kf[8];
#pragma unroll
    for (int d0 = 0; d0 < 4; ++d0) { kf[2 * d0] = *(const LAS bf16x8*)(Kslot + koff[d0]); kf[2 * d0 + 1] = *(const LAS bf16x8*)(Kslot + koff[d0] + 4096); }
    const f32x16 zz = f32x16{};
    p0 = __builtin_amdgcn_mfma_f32_32x32x16_bf16(kf[0], qr[0], zz, 0, 0, 0); p1 = __builtin_amdgcn_mfma_f32_32x32x16_bf16(kf[1], qr[0], zz, 0, 0, 0);
#pragma unroll
    for (int d0 = 1; d0 < 4; ++d0) { p0 = __builtin_amdgcn_mfma_f32_32x32x16_bf16(kf[2 * d0], qr[d0], p0, 0, 0, 0); p1 = __builtin_amdgcn_mfma_f32_32x32x16_bf16(kf[2 * d0 + 1], qr[d0], p1, 0, 0, 0); }
}
__device__ __forceinline__ s16x4 vtr(const LAS unsigned char* p) { return __builtin_bit_cast(s16x4, __builtin_amdgcn_ds_read_tr16_b64_v4i16((LAS s16x4*)p)); }
template <int NDB> struct Flash {
    f32x16 o[NDB]; float mhat, l; bool first;
    __device__ __forceinline__ void reset() {
#pragma unroll
        for (int d = 0; d < NDB; ++d) o[d] = f32x16{};
        mhat = 0.f; l = 0.f; first = true; }
    static __device__ __forceinline__ float rowmax_abs(const f32x16& p0, const f32x16& p1) {
        float a = __builtin_fmaxf(__builtin_fmaxf(p0[0], p0[1]), p1[0]), c = __builtin_fmaxf(__builtin_fmaxf(p0[2], p0[3]), p1[1]);
        a = __builtin_fmaxf(__builtin_fmaxf(a, p1[2]), p1[3]);
#pragma unroll
        for (int r = 4; r < 16; r += 4) { a = __builtin_fmaxf(__builtin_fmaxf(a, p0[r]), p0[r + 1]); c = __builtin_fmaxf(__builtin_fmaxf(c, p0[r + 2]), p0[r + 3]);
            a = __builtin_fmaxf(__builtin_fmaxf(a, p1[r]), p1[r + 1]); c = __builtin_fmaxf(__builtin_fmaxf(c, p1[r + 2]), p1[r + 3]); }
        return xor32_max(__builtin_fmaxf(a, c));
    }
    __device__ __forceinline__ void decide(float rmabs, bool rowvalid, LAS float* wsf, int r32, int hi) {
        const float rm = rowvalid ? rmabs - mhat : -INFINITY;
        bool need; float dl;
        if (first) { need = true; dl = (rm > -1e30f) ? rm : 0.f; }
        else { need = __any(rm > 8.0f); dl = fmaxf(rm, 0.f); }
        if (need) {
            mhat += dl;
            if (!first) {
                const float f = __builtin_amdgcn_exp2f(-dl); l *= f;
                if (hi == 0) wsf[r32] = f;
                asm volatile("s_waitcnt lgkmcnt(0)" ::: "memory");
                const f32x4 t0 = *(const LAS f32x4*)(wsf + 4 * hi), t1 = *(const LAS f32x4*)(wsf + 8 + 4 * hi), t2 = *(const LAS f32x4*)(wsf + 16 + 4 * hi), t3 = *(const LAS f32x4*)(wsf + 24 + 4 * hi);
                const f32x16 fv = {t0[0], t0[1], t0[2], t0[3], t1[0], t1[1], t1[2], t1[3], t2[0], t2[1], t2[2], t2[3], t3[0], t3[1], t3[2], t3[3]};
#pragma unroll
                for (int d = 0; d < NDB; ++d) o[d] = o[d] * fv;
                asm volatile("s_waitcnt lgkmcnt(0)" ::: "memory");
            }
        }
        first = false;
    }
    __device__ __forceinline__ void exphalf(f32x16& p, float mm, u32x4& w0, u32x4& w1) {
        p = p - mm;
        float sa = 0.f, sb = 0.f;
#pragma unroll
        for (int r = 0; r < 16; r += 2) { p[r] = __builtin_amdgcn_exp2f(p[r]); p[r + 1] = __builtin_amdgcn_exp2f(p[r + 1]); sa += p[r]; sb += p[r + 1]; }
        l += sa + sb;
        w0 = (u32x4){cvtpk(p[0], p[1]), cvtpk(p[2], p[3]), cvtpk(p[4], p[5]), cvtpk(p[6], p[7])};
        w1 = (u32x4){cvtpk(p[8], p[9]), cvtpk(p[10], p[11]), cvtpk(p[12], p[13]), cvtpk(p[14], p[15])};
    }
    __device__ __forceinline__ void pv_half(const u32x4& w0, const u32x4& w1, const LAS unsigned char* Vslot, int lane, int hi, int kb) {
        const LAS unsigned char* vp = Vslot + ((lane >> 4) & 1) * 32 + (lane & 3) * 8 + (4 * hi + ((lane & 15) >> 2)) * 64;
#pragma unroll
        for (int d = 0; d < NDB; ++d) {
            const s16x4 l0 = vtr(vp + (d * 4 + kb) * 1024), h0 = vtr(vp + (d * 4 + kb) * 1024 + 512), l1 = vtr(vp + (d * 4 + kb + 1) * 1024), h1 = vtr(vp + (d * 4 + kb + 1) * 1024 + 512);
            o[d] = __builtin_amdgcn_mfma_f32_32x32x16_bf16(__builtin_bit_cast(bf16x8, w0), (bf16x8){l0[0], l0[1], l0[2], l0[3], h0[0], h0[1], h0[2], h0[3]}, o[d], 0, 0, 0);
            o[d] = __builtin_amdgcn_mfma_f32_32x32x16_bf16(__builtin_bit_cast(bf16x8, w1), (bf16x8){l1[0], l1[1], l1[2], l1[3], h1[0], h1[1], h1[2], h1[3]}, o[d], 0, 0, 0);
        }
    }
    __device__ __forceinline__ void tile(f32x16& p0, f32x16& p1, const LAS unsigned char* Vslot, LAS float* wsf, int lane, int r32, int hi) {
        decide(rowmax_abs(p0, p1), true, wsf, r32, hi);
        u32x4 w0, w1, w2, w3;
        exphalf(p0, mhat, w0, w1); pv_half(w0, w1, Vslot, lane, hi, 0);
        exphalf(p1, mhat, w2, w3); pv_half(w2, w3, Vslot, lane, hi, 2);
    }
    __device__ __forceinline__ float ltot() const { return xor32_sum(l); }
};
__device__ __forceinline__ void row_bcast(float v, float (&fr_)[16], LAS float* wsf, int r32, int hi) {
    asm volatile("s_waitcnt lgkmcnt(0)" ::: "memory");
    if (hi == 0) wsf[r32] = v;
    asm volatile("s_waitcnt lgkmcnt(0)" ::: "memory");
#pragma unroll
    for (int k = 0; k < 4; ++k) { const f32x4 t = *(const LAS f32x4*)(wsf + 8 * k + 4 * hi); fr_[4 * k] = t[0]; fr_[4 * k + 1] = t[1]; fr_[4 * k + 2] = t[2]; fr_[4 * k + 3] = t[3]; }
    asm volatile("s_waitcnt lgkmcnt(0)" ::: "memory");
}

constexpr int DF_STAGE = 0;
constexpr int DF_WSF = 98304;
__device__ __forceinline__ void diff_unit(LAS unsigned char* L, int b, int h, int qb, const unsigned char* ws, float lam, const float* subg, int wv) {
    int tid_ = wv * 64 + lane_id(); asm volatile("" : "+v"(tid_));
    const int tid = tid_, lane = tid & 63, r32 = lane & 31, hi = lane >> 5, wid = __builtin_amdgcn_readfirstlane(tid >> 6);
    const int comp = wid >> 2, rgi = wid & 3;
    const size_t bh = (size_t)(b * 4 + h) * S;
    const bf16_t* Qp = (const bf16_t*)(ws + WS_DQ) + (bh + qb * 128 + rgi * 32 + r32) * 128 + comp * 64;
    bf16x8 qr[4];
#pragma unroll
    for (int d0 = 0; d0 < 4; ++d0) qr[d0] = *(const bf16x8*)(Qp + d0 * 16 + hi * 8);
    const bf16_t* Kg = (const bf16_t*)(ws + WS_DK) + bh * 128 + ksrc_off(wid, lane);
    int koff[4]; kread_offs(koff, r32, hi);
    const bf16_t* Vg = (const bf16_t*)(ws + WS_DV) + bh * 128 + (size_t)(16 * (wid & 3) + (lane >> 2)) * 128 + (wid >> 2) * 32 + (lane & 3) * 8;
    LAS float* wsf = (LAS float*)(L + DF_WSF) + wid * 32;
    const int NT = 2 * qb + 2;
    Flash<4> F; F.reset();
    auto dmaK = [&](int t, int s) { const bf16_t* src = Kg + (size_t)t * 4096; LAS unsigned char* d = L + s * 16384 + wid * 1024; glds16(src, d); glds16(src + (size_t)S * 64, d + 8192); };
    auto dmaV = [&](int t, int s) { const bf16_t* src = Vg + (size_t)t * 8192; LAS unsigned char* d = L + 49152 + s * 16384 + wid * 1024; glds16(src, d); glds16(src + 64, d + 8192); };
    dmaK(0, 0); dmaV(0, 0); dmaK(1, 1); dmaV(1, 1); if (NT > 2) dmaK(2, 2);
    WAIT_BAR(0);
    f32x16 a0, a1, b0, b1; float ra, rb;
    const int xq = 32 * rgi + r32 - 4 * hi;
    auto cmask = [&](f32x16& c0, f32x16& c1, int t) { const int x = xq - 64 * (t - (NT - 2));
#pragma unroll
        for (int r = 0; r < 16; ++r) { if (ccol(r) > x) c0[r] = -INFINITY; if (ccol(r) + 32 > x) c1[r] = -INFINITY; } };
    qkt(a0, a1, L + comp * 8192, koff, qr);
    if (NT == 2) cmask(a0, a1, 0);
    ra = Flash<4>::rowmax_abs(a0, a1);
    WAIT_BAR(0);
    int s0 = 0, s1 = 1, s2 = 2;
    auto iter = [&](int t, f32x16& c0, f32x16& c1, float& rc, f32x16& n0, f32x16& n1, float& rn, auto next) {
        int nis = 0;
        if (t + 3 < NT) { dmaK(t + 3, s0); nis += 2; }
        if (t + 2 < NT) { dmaV(t + 2, s2); nis += 2; }
        F.decide(rc, true, wsf, r32, hi);
        const LAS unsigned char* Vs = L + 49152 + s0 * 16384;
        u32x4 w0, w1, w2, w3;
        if constexpr (decltype(next)::value) qkt(n0, n1, L + s1 * 16384 + comp * 8192, koff, qr);
        F.exphalf(c0, F.mhat, w0, w1);
        F.pv_half(w0, w1, Vs, lane, hi, 0);
        F.exphalf(c1, F.mhat, w2, w3);
        F.pv_half(w2, w3, Vs, lane, hi, 2);
        if constexpr (decltype(next)::value) { rn = Flash<4>::rowmax_abs(n0, n1); if (t + 1 >= NT - 2) { cmask(n0, n1, t + 1); rn = Flash<4>::rowmax_abs(n0, n1); } }
        wait_bar_n(nis);
        const int tmp = s0; s0 = s1; s1 = s2; s2 = tmp;
    };
    int t = 0;
    for (; t < NT - 2; t += 2) { iter(t, a0, a1, ra, b0, b1, rb, TrueC{}); iter(t + 1, b0, b1, rb, a0, a1, ra, TrueC{}); }
    iter(NT - 2, a0, a1, ra, b0, b1, rb, TrueC{});
    iter(NT - 1, b0, b1, rb, a0, a1, ra, FalseC{});
    const float lt = F.ltot();
    float fr_[16];
    row_bcast((comp ? lam : 1.f) / lt, fr_, wsf, r32, hi);
    LAS float* stg = (LAS float*)(L + DF_STAGE) + rgi * 32 * 132;
    if (comp == 1) {
#pragma unroll
        for (int d = 0; d < 4; ++d)
#pragma unroll
            for (int r = 0; r < 16; ++r) stg[crow(r, hi) * 132 + d * 32 + r32] = F.o[d][r] * fr_[r];
    }
    __syncthreads();
    if (comp == 0) {
#pragma unroll
        for (int d = 0; d < 4; ++d)
#pragma unroll
            for (int r = 0; r < 16; ++r) { const int ix = crow(r, hi) * 132 + d * 32 + r32; stg[ix] = F.o[d][r] * fr_[r] - stg[ix]; }
        asm volatile("s_waitcnt lgkmcnt(0)" ::: "memory");
        const LAS float* rowp = stg + r32 * 132 + 64 * hi;
        float ss = 0.f;
#pragma unroll
        for (int k = 0; k < 16; ++k) { const f32x4 v = *(const LAS f32x4*)(rowp + 4 * k); ss += (v[0] * v[0] + v[1] * v[1]) + (v[2] * v[2] + v[3] * v[3]); }
        ss = xor32_sum(ss);
        const float rstd = rsqrtf(ss * (1.f / 128.f) + EPS) * (1.f - LAM_INIT);
        bf16_t* Yp = (bf16_t*)(ws + WS_YA) + ((size_t)b * S + qb * 128 + rgi * 32 + r32) * 512 + h * 128 + 64 * hi;
#pragma unroll
        for (int k = 0; k < 8; ++k) { const f32x4 v0 = *(const LAS f32x4*)(rowp + 8 * k), v1 = *(const LAS f32x4*)(rowp + 8 * k + 4);
            const f32x4 g0 = *(const f32x4*)(subg + 64 * hi + 8 * k), g1 = *(const f32x4*)(subg + 64 * hi + 8 * k + 4);
            u32x4 w; w.x = cvtpk(v0[0] * rstd * g0[0], v0[1] * rstd * g0[1]); w.y = cvtpk(v0[2] * rstd * g0[2], v0[3] * rstd * g0[3]);
            w.z = cvtpk(v1[0] * rstd * g1[0], v1[1] * rstd * g1[1]); w.w = cvtpk(v1[2] * rstd * g1[2], v1[3] * rstd * g1[3]);
            *(u32x4*)(Yp + 8 * k) = w; }
    }
    __syncthreads();
}

constexpr int NS_CMP = 49152;
constexpr int NS_GL = 114688;
constexpr int NS_WSF = 147456;
template <int MODE>
__device__ __forceinline__ void nsa_kv_pass(LAS unsigned char* L, Flash<2>& F, const bf16x8* qr, const int (&koff)[4], const bf16_t* Kg0, const bf16_t* Vg0, int jlo, int jhi, int qblk, int ql, unsigned long long mymask,
                                            LAS float* wsf, int wid, int lane, int r32, int hi) {
    auto dmaK = [&](int j, int s) { glds16(Kg0 + (size_t)j * 4096, L + s * 8192 + wid * 1024); };
    auto dmaV = [&](int j, int s) { glds16(Vg0 + (size_t)j * 4096, L + 24576 + s * 8192 + wid * 1024); };
    dmaK(jlo, 0); dmaV(jlo, 0); if (jlo + 1 <= jhi) { dmaK(jlo + 1, 1); dmaV(jlo + 1, 1); } if (jlo + 2 <= jhi) dmaK(jlo + 2, 2);
    WAIT_BAR(0);
    f32x16 a0, a1, b0, b1; float ra, rb;
    const int xq = ql - 4 * hi;
    auto masked = [&](int j) { return MODE == 1 ? (j == qblk) : (j == qblk || j == qblk - 8); };
    auto amask = [&](f32x16& c0, f32x16& c1, int j) {
        if (MODE == 1) {
#pragma unroll
            for (int r = 0; r < 16; ++r) { if (ccol(r) > xq) c0[r] = -INFINITY; if (ccol(r) + 32 > xq) c1[r] = -INFINITY; }
        } else { const int base = 64 * (qblk - j) + xq;
#pragma unroll
            for (int r = 0; r < 16; ++r) { if ((unsigned)(base - ccol(r)) >= 512u) c0[r] = -INFINITY; if ((unsigned)(base - ccol(r) - 32) >= 512u) c1[r] = -INFINITY; } } };
    qkt(a0, a1, L, koff, qr);
    if (masked(jlo)) amask(a0, a1, jlo);
    ra = Flash<2>::rowmax_abs(a0, a1);
    WAIT_BAR(0);
    int s0 = 0, s1 = 1, s2 = 2;
    auto iter = [&](int j, f32x16& c0, f32x16& c1, float& rc, f32x16& n0, f32x16& n1, float& rn, auto next) {
        int nis = 0;
        if (j + 3 <= jhi) { dmaK(j + 3, s0); nis += 1; }
        if (j + 2 <= jhi) { dmaV(j + 2, s2); nis += 1; }
        const bool rowvalid = (MODE == 1) ? (bool)((mymask >> j) & 1ull) : true;
        F.decide(rc, rowvalid, wsf, r32, hi);
        const float mm = rowvalid ? F.mhat : INFINITY;
        const LAS unsigned char* Vs = L + 24576 + s0 * 8192;
        u32x4 w0, w1, w2, w3;
        if constexpr (decltype(next)::value) qkt(n0, n1, L + s1 * 8192, koff, qr);
        F.exphalf(c0, mm, w0, w1);
        F.pv_half(w0, w1, Vs, lane, hi, 0);
        F.exphalf(c1, mm, w2, w3);
        F.pv_half(w2, w3, Vs, lane, hi, 2);
        if constexpr (decltype(next)::value) { rn = Flash<2>::rowmax_abs(n0, n1); if (masked(j + 1)) { amask(n0, n1, j + 1); rn = Flash<2>::rowmax_abs(n0, n1); } }
        wait_bar_n(nis);
        const int tmp = s0; s0 = s1; s1 = s2; s2 = tmp;
    };
    int j = jlo;
    for (; j + 2 <= jhi; j += 2) { iter(j, a0, a1, ra, b0, b1, rb, TrueC{}); iter(j + 1, b0, b1, rb, a0, a1, ra, TrueC{}); }
    if (j < jhi) { iter(j, a0, a1, ra, b0, b1, rb, TrueC{}); iter(jhi, b0, b1, rb, a0, a1, ra, FalseC{}); }
    else iter(jhi, a0, a1, ra, b0, b1, rb, FalseC{});
}
__device__ __forceinline__ void nsa_unit(LAS unsigned char* L, int b, int g, int qblk, const unsigned char* ws, int wv) {
    int tid_ = wv * 64 + lane_id(); asm volatile("" : "+v"(tid_));
    const int tid = tid_, lane = tid & 63, r32 = lane & 31, hi = lane >> 5, wid = __builtin_amdgcn_readfirstlane(tid >> 6);
    const int ql = 8 * wid + (r32 & 7), hh = r32 >> 3, head = g * 4 + hh;
    const int qpos = 64 * qblk + ql;
    const size_t tok = (size_t)b * S + qpos;
    const bf16_t* Qp = (const bf16_t*)(ws + WS_NQ) + ((size_t)(b * 8 + head) * S + qpos) * 64;
    bf16x8 qr[4];
#pragma unroll
    for (int d0 = 0; d0 < 4; ++d0) qr[d0] = *(const bf16x8*)(Qp + d0 * 16 + hi * 8);
    const float* NGp = (const float*)(ws + WS_NG) + tok * 24 + head;
    const float g0 = NGp[0], g1 = NGp[8], g2 = NGp[16];
    LAS float* wsf = (LAS float*)(L + NS_WSF) + wid * 32;
    const size_t pg = (size_t)(b * 2 + g);
    LAS float* yst = (LAS float*)(L + NS_CMP) + wid * 2048;
    float fr_[16];
    unsigned long long mymask = 0ull;
    int koff[4]; kread_offs(koff, r32, hi);
    {
        const int ntc = ((4 * qblk + 2) >> 6) + 1;
        const bf16_t* Kc = (const bf16_t*)(ws + WS_KCMP) + pg * 256 * 64 + ksrc_off(wid, lane);
        const bf16_t* Vc = (const bf16_t*)(ws + WS_VCMP) + (pg * 256 + 16 * (wid & 3) + (lane >> 2)) * 64 + (wid >> 2) * 32 + (lane & 3) * 8;
        for (int ct = 0; ct < ntc; ++ct) { glds16(Kc + (size_t)ct * 4096, L + NS_CMP + ct * 8192 + wid * 1024); glds16(Vc + (size_t)ct * 4096, L + NS_CMP + 32768 + ct * 8192 + wid * 1024); }
        VM_DRAIN_SYNC();
        const int cm = (qpos >= 31) ? ((qpos - 31) >> 4) : -1;
        Flash<2> F; F.reset();
        for (int ct = 0; ct < ntc; ++ct) {
            f32x16 p0, p1;
            qkt(p0, p1, L + NS_CMP + ct * 8192, koff, qr);
            const int x = cm - 64 * ct - 4 * hi;
#pragma unroll
            for (int r = 0; r < 16; ++r) { if (ccol(r) > x) p0[r] = -INFINITY; if (ccol(r) + 32 > x) p1[r] = -INFINITY; }
            F.tile(p0, p1, L + NS_CMP + 32768 + ct * 8192, wsf, lane, r32, hi);
        }
        const float lt = F.ltot();
        const float il = lt > 0.f ? 1.f / lt : 0.f;
        LAS float* Gs = (LAS float*)(L + NS_GL) + wid * 1024;
        LAS float* Ls = Gs + 512;
        for (int ct = 0; ct < ntc; ++ct) {
            f32x16 p0, p1;
            qkt(p0, p1, L + NS_CMP + ct * 8192, koff, qr);
            const int x = cm - 64 * ct - 4 * hi;
#pragma unroll
            for (int r = 0; r < 16; ++r) {
                float a = (ccol(r) > x) ? 0.f : __builtin_amdgcn_exp2f(p0[r] - F.mhat) * il, bq = (ccol(r) + 32 > x) ? 0.f : __builtin_amdgcn_exp2f(p1[r] - F.mhat) * il;
                a += __shfl_xor(a, 8); a += __shfl_xor(a, 16); bq += __shfl_xor(bq, 8); bq += __shfl_xor(bq, 16);
                p0[r] = a; p1[r] = bq; }
            if (r32 < 8) {
#pragma unroll
                for (int k = 0; k < 4; ++k) { const int jj = 16 * ct + 2 * k + hi;
                    Gs[r32 * 64 + jj] = (p0[4 * k] + p0[4 * k + 1]) + (p0[4 * k + 2] + p0[4 * k + 3]); Ls[r32 * 64 + jj] = p0[4 * k + 3];
                    Gs[r32 * 64 + jj + 8] = (p1[4 * k] + p1[4 * k + 1]) + (p1[4 * k + 2] + p1[4 * k + 3]); Ls[r32 * 64 + jj + 8] = p1[4 * k + 3]; }
            }
        }
        asm volatile("s_waitcnt lgkmcnt(0)" ::: "memory");
        const int j = lane, jmax = 16 * ntc;
        for (int qi = 0; qi < 8; ++qi) {
            float v = (j < jmax) ? Gs[qi * 64 + j] : 0.f;
            if (j >= 1 && j - 1 < jmax) v += Ls[qi * 64 + j - 1];
            if (j == 0 || j == qblk || j == qblk - 1) v = 1e9f;
            if (j > qblk) v = -1e30f;
            unsigned key = __float_as_uint(v); key = (key & 0x80000000u) ? ~key : (key | 0x80000000u);
            unsigned long long C = ~0ull; int kk = 16;
            for (int bit = 31; bit >= 0; --bit) {
                const unsigned long long bs = __ballot((key >> bit) & 1u) & C;
                const int c1 = __popcll(bs);
                if (c1 >= kk) C = bs; else { kk -= c1; C &= ~bs; }
            }
            const unsigned Tk = (unsigned)__builtin_amdgcn_readlane((int)key, (int)__builtin_ctzll(C));
            unsigned long long selm = __ballot(key > Tk);
            for (int i = 0; i < kk; ++i) { const unsigned long long low = C & (0ull - C); selm |= low; C ^= low; }
            const unsigned long long m = selm & ((qblk >= 63) ? ~0ull : ((1ull << (qblk + 1)) - 1ull));
            if ((r32 & 7) == qi) mymask = m;
        }
        asm volatile("s_waitcnt lgkmcnt(0)" ::: "memory");
        __syncthreads();
        row_bcast(g0 * il, fr_, wsf, r32, hi);
#pragma unroll
        for (int d = 0; d < 2; ++d)
#pragma unroll
            for (int r = 0; r < 16; ++r) yst[crow(r, hi) * 64 + d * 32 + r32] = F.o[d][r] * fr_[r];
    }
    const size_t ksrc = pg * S * 64 + ksrc_off(wid, lane);
    const size_t voff = (pg * S + 16 * (wid & 3) + (lane >> 2)) * 64 + (wid >> 2) * 32 + (lane & 3) * 8;
    {
        Flash<2> F; F.reset();
        nsa_kv_pass<1>(L, F, qr, koff, (const bf16_t*)(ws + WS_KS) + ksrc, (const bf16_t*)(ws + WS_VS) + voff, 0, qblk, qblk, ql, mymask, wsf, wid, lane, r32, hi);
        const float lt = F.ltot();
        row_bcast(g1 / lt, fr_, wsf, r32, hi);
#pragma unroll
        for (int d = 0; d < 2; ++d)
#pragma unroll
            for (int r = 0; r < 16; ++r) yst[crow(r, hi) * 64 + d * 32 + r32] += F.o[d][r] * fr_[r];
    }
    {
        Flash<2> F; F.reset();
        const int jlo = qblk >= 8 ? qblk - 8 : 0;
        nsa_kv_pass<2>(L, F, qr, koff, (const bf16_t*)(ws + WS_KW) + ksrc, (const bf16_t*)(ws + WS_VW) + voff, jlo, qblk, qblk, ql, 0ull, wsf, wid, lane, r32, hi);
        const float lt = F.ltot();
        row_bcast(g2 / lt, fr_, wsf, r32, hi);
        LAS bf16_t* stg = (LAS bf16_t*)(L + NS_GL) + wid * 2048;
#pragma unroll
        for (int r = 0; r < 16; ++r) { const int orow = crow(r, hi);
#pragma unroll
            for (int d = 0; d < 2; ++d) { const float yv = yst[orow * 64 + d * 32 + r32] + F.o[d][r] * fr_[r]; stg[orow * 64 + d * 32 + r32] = (bf16_t)(cvtpk(yv, 0.f) & 0xffffu); } }
        asm volatile("s_waitcnt lgkmcnt(0)" ::: "memory");
        bf16_t* Yb = (bf16_t*)(ws + WS_YB);
#pragma unroll
        for (int i = 0; i < 4; ++i) { const int row = i * 8 + (lane >> 3), ch = lane & 7; const u32x4 v = *(const LAS u32x4*)(stg + row * 64 + ch * 8);
            *(u32x4*)(Yb + ((size_t)b * S + 64 * qblk + 8 * wid + (row & 7)) * 512 + (g * 4 + (row >> 3)) * 64 + ch * 8) = v; }
    }
    __syncthreads();
}

#define XB_TMO      128
#define XB_XCNT(j)  (256  + 64 * (j))
#define XB_XSUB(j)  (1280 + 64 * (j))
#define XB_XGEN(j)  (2304 + 64 * (j))
#define XB_TOP      3328
#define XB_TOPGEN   3392
#define XCD_BAR_WORDS 3456
#define XB_SPIN_CAP (1u << 18)

__device__ __forceinline__ unsigned xb_ld(unsigned* p)              { return __hip_atomic_load(p, __ATOMIC_RELAXED, __HIP_MEMORY_SCOPE_AGENT); }
__device__ __forceinline__ unsigned xb_add(unsigned* p, unsigned v) { return __hip_atomic_fetch_add(p, v, __ATOMIC_RELAXED, __HIP_MEMORY_SCOPE_AGENT); }
__device__ __forceinline__ unsigned xb_xcc_id() { return (unsigned)__builtin_amdgcn_s_getreg((3 << 11) | 20) & 0xFu; }
#define XB_SPIN(cond, bar) do { unsigned _sp = 0; while (cond) { __builtin_amdgcn_s_sleep(1); \
    if ((++_sp & 255u) == 0u) { if (xb_ld(&(bar)[XB_TMO])) break; if (_sp > XB_SPIN_CAP) { atomicAdd(&(bar)[XB_TMO], 1u); break; } } } } while (0)

struct XcdBarrier {
    unsigned* bar; unsigned x;
    volatile LAS unsigned* st;
    bool lead;
};

__device__ __forceinline__ XcdBarrier xcd_barrier_post(unsigned* bar, volatile LAS unsigned* st, bool lead) {
    XcdBarrier b; b.bar = bar; b.x = xb_xcc_id(); b.st = st; b.lead = lead;
    if (b.lead && lane_id() == 0) (void)xb_add(&bar[XB_XCNT(b.x)], 1u);
    return b;
}
__device__ __forceinline__ void xcd_barrier_complete(unsigned* bar, unsigned x, unsigned& nloc, unsigned& nx) {
    const unsigned G = gridDim.x * gridDim.y * gridDim.z;
    unsigned sum, cnt, mine, sp = 0u;
    for (;;) {
        sum = 0u; cnt = 0u; mine = 0u;
#pragma unroll
        for (unsigned j = 0; j < 16; ++j) { const unsigned c = xb_ld(&bar[XB_XCNT(j)]); sum += c; cnt += (c > 0u) ? 1u : 0u; mine = (j == x) ? c : mine; }
        if (sum == G) break;
        __builtin_amdgcn_s_sleep(1);
        if ((++sp & 255u) == 0u) { if (xb_ld(&bar[XB_TMO])) break; if (sp > XB_SPIN_CAP) { atomicAdd(&bar[XB_TMO], 1u); break; } }
    }
    nloc = mine > 0u ? mine : 1u; nx = cnt > 0u ? cnt : 1u;
}

__device__ __forceinline__ void xcd_barrier(const XcdBarrier& b) {
    asm volatile("s_waitcnt vmcnt(0)" ::: "memory");
    __syncthreads();
    if (b.lead && lane_id() == 0) {
        unsigned* bar = b.bar;
        __builtin_amdgcn_s_waitcnt(0);
        unsigned nloc = b.st[0], nx = b.st[1];
        if (nloc == 0u) { xcd_barrier_complete(bar, b.x, nloc, nx); b.st[0] = nloc; b.st[1] = nx; }
        const unsigned old = xb_add(&bar[XB_XSUB(b.x)], 1u);
        const unsigned gen = old / nloc;
        if (old + 1u == (gen + 1u) * nloc) {
            __builtin_amdgcn_fence(__ATOMIC_RELEASE, "agent");
            asm volatile("s_waitcnt vmcnt(0)" ::: "memory");
            const unsigned og = xb_add(&bar[XB_TOP], 1u);
            const unsigned tg = og / nx;
            if (og + 1u == (tg + 1u) * nx) xb_add(&bar[XB_TOPGEN], 1u);
            else XB_SPIN(xb_ld(&bar[XB_TOPGEN]) == tg, bar);
            __builtin_amdgcn_fence(__ATOMIC_ACQUIRE, "agent");
            xb_add(&bar[XB_XGEN(b.x)], 1u);
            asm volatile("s_waitcnt vmcnt(0)" ::: "memory");
        } else {
            XB_SPIN(xb_ld(&bar[XB_XGEN(b.x)]) == gen, bar);
            __builtin_amdgcn_fence(__ATOMIC_ACQUIRE, "agent");
            asm volatile("s_waitcnt vmcnt(0)" ::: "memory");
        }
    }
    __syncthreads();
}


template <class MapF>
__device__ __forceinline__ void tr_item(const float* W, int K, int N, int ldw, bf16_t* WT, const float* kscale, LAS float* scr, int item, int lane, const MapF& map) {
    const int nblk = (N + 31) / 32, kb = item / nblk, nb = item % nblk, k0 = 64 * kb, n0 = 32 * nb;
    const int nn = n0 + (lane & 31);
#pragma unroll 8
    for (int i = 0; i < 32; ++i) { const int kk = 2 * i + (lane >> 5); float v = (nn < N) ? W[(size_t)(k0 + kk) * ldw + nn] : 0.f; if (kscale) v *= kscale[k0 + kk]; scr[kk * 33 + (lane & 31)] = v; }
    asm volatile("s_waitcnt lgkmcnt(0)" ::: "memory");
    const int c = lane & 7;
#pragma unroll
    for (int jx = 0; jx < 4; ++jx) { const int n = (lane >> 3) + 8 * jx; const LAS float* s = scr + (8 * c) * 33 + n;
        u32x4 o; o.x = cvtpk(s[0 * 33], s[1 * 33]); o.y = cvtpk(s[2 * 33], s[3 * 33]); o.z = cvtpk(s[4 * 33], s[5 * 33]); o.w = cvtpk(s[6 * 33], s[7 * 33]);
        if (n0 + n < N) *(u32x4*)(WT + (size_t)map(n0 + n) * K + k0 + 8 * c) = o; }
    asm volatile("s_waitcnt lgkmcnt(0)" ::: "memory");
}
__device__ __forceinline__ int rope_pos(int d) { return d < 32 ? 8 * (d >> 2) + (d & 3) : 8 * ((d - 32) >> 2) + 4 + (d & 3); }
struct MapIn {
    __device__ __forceinline__ int operator()(int n) const {
        if (n >= 2840) return 2816 + (n - 2840);
        if (n >= 2816) return 4864 + (n - 2816);
        if (n < 1024 || (n >= 1536 && n < 2048)) {
            const int tile = (n < 1024) ? (n >> 8) : 6 + ((n - 1536) >> 8), hq = (n >> 6) & 3, d = n & 63;
            return tile * 256 + (d >= 32 ? 128 : 0) + hq * 32 + (d & 31); }
        if (n < 1536) return n;
        const int sidx = (n - 2048) >> 7, g = (n >> 6) & 1, d = n & 63;
        if (sidx == 0 || sidx == 2) return 8 * 256 + (d >= 32 ? 128 : 0) + ((sidx >> 1) * 2 + g) * 32 + (d & 31);
        if (sidx == 4) return 9 * 256 + (d >= 32 ? 128 : 0) + g * 32 + (d & 31);
        if (sidx == 1) return 9 * 256 + (g ? 192 : 64) + d;
        return 10 * 256 + (sidx == 5 ? 128 : 0) + g * 64 + d;
    }
};
struct MapId { int off; __device__ __forceinline__ int operator()(int n) const { return off + n; } };
struct MapGU { int up; __device__ __forceinline__ int operator()(int f) const { return 256 * (f >> 7) + 128 * up + (f & 127); } };

__device__ __forceinline__ int queue_fetch(unsigned* qbase, unsigned x, LAS int* kstate) {
    int k = *kstate;
    while (k < 8) { const unsigned q = (x + (unsigned)k) & 7u; const unsigned li = atomicAdd(qbase + 64 * q, 1u); if (li < 128u) { *kstate = k; return (int)(q * 128u + li); } ++k; }
    *kstate = k; return -1;
}
struct Args { const void* in[20]; float* out; unsigned char* ws; int use_cg; int pad; };

__global__ void __launch_bounds__(512, 2) hybrid_fwd(Args args) {
    extern __shared__ __attribute__((aligned(16))) unsigned char lds_raw[];
    LAS unsigned char* L = (LAS unsigned char*)lds_raw;
    cg::grid_group grid = cg::this_grid();
    const int wave_s = __builtin_amdgcn_readfirstlane((int)(threadIdx.x >> 6));
#define PHASE_IDS() int tid_ = wave_s * 64 + lane_id(); asm volatile("" : "+v"(tid_)); const int tid = tid_, lane = tid & 63, wave = __builtin_amdgcn_readfirstlane(tid >> 6); (void)lane; (void)wave
    const int G = gridDim.x, bx = blockIdx.x;
    unsigned char* ws = args.ws;
    const float* x = (const float*)args.in[0];
    const int* positions = (const int*)args.in[1];
    float* out = args.out;
    unsigned* ctl = (unsigned*)(ws + WS_CTL);
    LAS int* misc = (LAS int*)(L + LDS_BYTES - 64);
    { const int t0 = wave_s * 64 + lane_id(); if (t0 < 16) misc[t0] = 0; }
    __syncthreads();
    const XcdBarrier xbar = xcd_barrier_post(ctl + 4096, (volatile LAS unsigned*)(misc + 8), wave_s == 0);

    {
        PHASE_IDS();
        LAS float* scr = (LAS float*)(L + wave * 16384);
        const int gw = bx * 8 + wave, NGW = G * 8;
        const float* g1 = (const float*)args.in[2]; const float* g2 = (const float*)args.in[15];
        constexpr int I_IN = 16 * 153, I_G = 16 * 88, I_D = 44 * 32, I_O = 16 * 32, I_A = 8 * 32, I_C = 16 * 8;
        constexpr int NIT = I_IN + 2 * I_G + I_D + I_O + 2 * I_A + 4 * I_C;
        for (int it = gw; it < NIT; it += NGW) {
            int r = it;
            if (r < I_IN) { tr_item((const float*)args.in[3], 1024, 4888, 4888, (bf16_t*)(ws + WS_WIN), g1, scr, r, lane, MapIn{}); continue; } r -= I_IN;
            if (r < I_G) { tr_item((const float*)args.in[16], 1024, FF, FF, (bf16_t*)(ws + WS_WGU), g2, scr, r, lane, MapGU{0}); continue; } r -= I_G;
            if (r < I_G) { tr_item((const float*)args.in[17], 1024, FF, FF, (bf16_t*)(ws + WS_WGU), g2, scr, r, lane, MapGU{1}); continue; } r -= I_G;
            if (r < I_D) { tr_item((const float*)args.in[18], FF, 1024, 1024, (bf16_t*)(ws + WS_WD), nullptr, scr, r, lane, MapId{0}); continue; } r -= I_D;
            if (r < I_O) { tr_item((const float*)args.in[14], 1024, 1024, 1024, (bf16_t*)(ws + WS_WO), nullptr, scr, r, lane, MapId{0}); continue; } r -= I_O;
            if (r < I_A) { tr_item((const float*)args.in[12], 512, 1024, 1024, (bf16_t*)(ws + WS_WA), nullptr, scr, r, lane, MapId{0}); continue; } r -= I_A;
            if (r < I_A) { tr_item((const float*)args.in[13], 512, 1024, 1024, (bf16_t*)(ws + WS_WB), nullptr, scr, r, lane, MapId{0}); continue; } r -= I_A;
            if (r < I_C) { tr_item((const float*)args.in[8], 1024, 256, 256, (bf16_t*)(ws + WS_W1K), nullptr, scr, r, lane, MapId{0}); continue; } r -= I_C;
            if (r < I_C) { tr_item((const float*)args.in[8] + 1024 * 256, 1024, 256, 256, (bf16_t*)(ws + WS_W1K), nullptr, scr, r, lane, MapId{256}); continue; } r -= I_C;
            if (r < I_C) { tr_item((const float*)args.in[10], 1024, 256, 256, (bf16_t*)(ws + WS_W1V), nullptr, scr, r, lane, MapId{0}); continue; } r -= I_C;
            tr_item((const float*)args.in[10] + 1024 * 256, 1024, 256, 256, (bf16_t*)(ws + WS_W1V), nullptr, scr, r, lane, MapId{256});
        }
        bf16_t* XB = (bf16_t*)(ws + WS_XB); float* rs1 = (float*)(ws + WS_RS1);
        float* cosT = (float*)(ws + WS_COS); float* sinT = (float*)(ws + WS_SIN);
        const float invf = 1.0f / powf(10000.0f, (float)(2 * (lane & 31)) / 64.0f);
        for (int m = gw; m < T; m += NGW) {
            const f32x4* xr = (const f32x4*)(x + (size_t)m * D) + lane;
            f32x4 v[4]; float s = 0.f;
#pragma unroll
            for (int jx = 0; jx < 4; ++jx) { v[jx] = xr[64 * jx]; s += (v[jx][0] * v[jx][0] + v[jx][1] * v[jx][1]) + (v[jx][2] * v[jx][2] + v[jx][3] * v[jx][3]); }
            s = wave_sum(s);
            if (lane == 0) rs1[m] = rsqrtf(s * (1.f / D) + EPS);
            u32x2* o8 = (u32x2*)(XB + (size_t)m * D) + lane;
#pragma unroll
            for (int jx = 0; jx < 4; ++jx) { u32x2 w; w.x = cvtpk(v[jx][0], v[jx][1]); w.y = cvtpk(v[jx][2], v[jx][3]); o8[64 * jx] = w; }
            const float ang = (float)positions[m] * invf;
            if (lane < 32) cosT[(size_t)m * 32 + lane] = cosf(ang); else sinT[(size_t)m * 32 + (lane - 32)] = sinf(ang);
        }
        if (bx < 32) {
            const int kv = bx >> 4, slab = bx & 15;
            const float* pe = (const float*)args.in[kv ? 7 : 6]; const float* W1 = (const float*)args.in[kv ? 10 : 8];
            const int n = tid & 255, half = tid >> 8; float acc = 0.f;
            for (int k = slab * 128 + half * 64; k < slab * 128 + half * 64 + 64; ++k) acc += pe[k] * W1[(size_t)k * 256 + n];
            __syncthreads();
            LAS float* red = (LAS float*)L;
            if (half) red[n] = acc;
            __syncthreads();
            if (!half) ((float*)(ws + WS_BIASP))[(kv * 16 + slab) * 256 + n] = acc + red[n];
            __syncthreads();
        }
    }
    if (args.use_cg) grid.sync(); else xcd_barrier(xbar);
    {
        pg8::Gemm g{(const bf16_t*)(ws + WS_XB), (const bf16_t*)(ws + WS_WIN), T, INP, D}; pg8::StaticOrder SO; SO.init(T, INP, G, bx);
        EpiProj E{(const float*)(ws + WS_RS1), (const float*)(ws + WS_COS), (const float*)(ws + WS_SIN), ws};
        pg8::gemm_phase<EpiProj, true>(L, g, SO, E, wave_s);
    }
    xcd_barrier(xbar);
    {
        PHASE_IDS();
        { pg8::Gemm g{(const bf16_t*)(ws + WS_KC), (const bf16_t*)(ws + WS_W1K), 4096, 512, 1024}; pg8::StaticOrder SO; SO.init(4096, 512, G, bx);
          EpiF32 E{(float*)(ws + WS_GK), 512}; pg8::gemm_phase<EpiF32, true>(L, g, SO, E, wave_s); }
        { pg8::Gemm g{(const bf16_t*)(ws + WS_VC), (const bf16_t*)(ws + WS_W1V), 4096, 512, 1024}; pg8::StaticOrder SO; SO.init(4096, 512, G, (bx + G - 32) % G);
          EpiF32 E{(float*)(ws + WS_GV), 512}; pg8::gemm_phase<EpiF32, true>(L, g, SO, E, wave_s); }
        __syncthreads();
        const float* lf = (const float*)args.in[4];
        float sa = 0.f, sb = 0.f;
        for (int d = 0; d < 64; ++d) { sa += lf[d] * lf[64 + d]; sb += lf[128 + d] * lf[192 + d]; }
        const float lam = __uint_as_float((unsigned)__builtin_amdgcn_readfirstlane((int)__float_as_uint(expf(sa) - expf(sb) + LAM_INIT)));
        if (wave_s == 0 && lane_id() == 0) misc[1] = 0;
        for (;;) {
            if (wave_s == 0 && lane_id() == 0) misc[0] = queue_fetch(ctl + 512, xbar.x & 7u, misc + 1);
            __syncthreads();
            const int idx = misc[0];
            __syncthreads();
            if (idx < 0) break;
            const int li = idx & 127, qb = 31 - (li >> 2), bh = (idx >> 7) * 4 + (li & 3);
            diff_unit(L, bh >> 2, bh & 3, qb, ws, lam, (const float*)args.in[5], wave_s);
        }
    }
    xcd_barrier(xbar);
    {
        PHASE_IDS();
        LAS float* hid = (LAS float*)L;
        LAS float* bias = hid + 4096;
        for (int un = bx; un < 512; un += G) {
            const int kv = un >> 8, p = (un >> 4) & 15, rb = un & 15;
            const float* Gm = (const float*)(ws + (kv ? WS_GV : WS_GK));
            const float* w2 = (const float*)args.in[kv ? 11 : 9];
            if (tid < 256) { float a = 0.f; const float* bp = (const float*)(ws + WS_BIASP) + kv * 16 * 256 + tid;
#pragma unroll
                for (int s = 0; s < 16; ++s) a += bp[s * 256]; bias[tid] = a; }
            __syncthreads();
#pragma unroll
            for (int i = 0; i < 8; ++i) { const int e = tid + 512 * i, r = e >> 8, k = e & 255, c = 16 * rb + r; const size_t R = (size_t)p * 256 + c;
                float v = Gm[R * 512 + k] + bias[k]; if (c < 255) v += Gm[(R + 1) * 512 + 256 + k];
                hid[r * 256 + k] = v / (1.f + __expf(-v)); }
            __syncthreads();
            const int d = tid & 63, r0 = tid >> 6; float a0 = 0.f, a1 = 0.f;
#pragma unroll 8
            for (int k = 0; k < 256; ++k) { const float w = w2[k * 64 + d]; a0 += hid[r0 * 256 + k] * w; a1 += hid[(r0 + 8) * 256 + k] * w; }
            bf16_t* O = (bf16_t*)(ws + (kv ? WS_VCMP : WS_KCMP)) + ((size_t)p * 256 + 16 * rb) * 64;
            O[r0 * 64 + d] = (bf16_t)(cvtpk(a0, 0.f) & 0xffffu); O[(r0 + 8) * 64 + d] = (bf16_t)(cvtpk(a1, 0.f) & 0xffffu);
            __syncthreads();
        }
    }
    xcd_barrier(xbar);
    {
        PHASE_IDS();
        if (wave_s == 0 && lane_id() == 0) misc[1] = 0;
        for (;;) {
            if (wave_s == 0 && lane_id() == 0) misc[0] = queue_fetch(ctl + 1024, xbar.x & 7u, misc + 1);
            __syncthreads();
            const int idx = misc[0];
            __syncthreads();
            if (idx < 0) break;
            const int li = idx & 127, qblk = 63 - (li >> 1), pgx = (idx >> 7) * 2 + (li & 1);
            nsa_unit(L, pgx >> 1, pgx & 1, qblk, ws, wave_s);
        }
    }
    xcd_barrier(xbar);
    {
        { pg8::Gemm g{(const bf16_t*)(ws + WS_YA), (const bf16_t*)(ws + WS_WA), T, D, 512}; pg8::StaticOrder SO; SO.init(T, D, G, bx);
          EpiBranch<false> E{(bf16_t*)(ws + WS_XB), (const bf16_t*)(ws + WS_MG)}; pg8::gemm_phase<EpiBranch<false>, true>(L, g, SO, E, wave_s); }
        __syncthreads();
        { pg8::Gemm g{(const bf16_t*)(ws + WS_YB), (const bf16_t*)(ws + WS_WB), T, D, 512}; pg8::StaticOrder SO; SO.init(T, D, G, bx);
          EpiBranch<true> E{(bf16_t*)(ws + WS_XB), (const bf16_t*)(ws + WS_MG)}; pg8::gemm_phase<EpiBranch<true>, true>(L, g, SO, E, wave_s); }
    }
    xcd_barrier(xbar);
    {
        pg8::Gemm g{(const bf16_t*)(ws + WS_XB), (const bf16_t*)(ws + WS_WO), T, D, D}; pg8::StaticOrder SO; SO.init(T, D, G, bx);
        EpiResid<false> E{(const void*)x, (bf16_t*)(ws + WS_YA), (float*)(ws + WS_SSQ2)};
        pg8::gemm_phase<EpiResid<false>, true>(L, g, SO, E, wave_s);
    }
    xcd_barrier(xbar);
    {
        pg8::Gemm g{(const bf16_t*)(ws + WS_YA), (const bf16_t*)(ws + WS_WGU), T, FF2, D}; pg8::StaticOrder SO; SO.init(T, FF2, G, bx);
        EpiGU E{(const float*)(ws + WS_SSQ2), (bf16_t*)(ws + WS_ACT)};
        pg8::gemm_phase<EpiGU, true>(L, g, SO, E, wave_s);
    }
    xcd_barrier(xbar);
    {
        pg8::Gemm g{(const bf16_t*)(ws + WS_ACT), (const bf16_t*)(ws + WS_WD), T, D, FF}; pg8::StaticOrder SO; SO.init(T, D, G, bx);
        EpiResid<true> E{(const void*)(ws + WS_YA), (bf16_t*)(ws + WS_XB), (float*)(ws + WS_SSQ3)};
        pg8::gemm_phase<EpiResid<true>, true>(L, g, SO, E, wave_s);
    }
    xcd_barrier(xbar);
    {
        PHASE_IDS();
        const float* gf = (const float*)args.in[19]; const float* SSQ3 = (const float*)(ws + WS_SSQ3);
        const int gw = bx * 8 + wave, NGW = G * 8;
        f32x4 gv[4];
#pragma unroll
        for (int jx = 0; jx < 4; ++jx) gv[jx] = ((const f32x4*)gf)[lane + 64 * jx];
        for (int m = gw; m < T; m += NGW) {
            float s = (lane < 16) ? SSQ3[(size_t)m * 16 + lane] : 0.f;
            s = wave_sum(s);
            const float rs = rsqrtf(s * (1.f / D) + EPS);
            const u32x2* hr = (const u32x2*)((const bf16_t*)(ws + WS_XB) + (size_t)m * D) + lane;
            f32x4* xr = (f32x4*)(out + (size_t)m * D) + lane;
#pragma unroll
            for (int jx = 0; jx < 4; ++jx) { const u32x2 w = hr[64 * jx]; f32x4 v = {bflo(w.x), bfhi(w.x), bflo(w.y), bfhi(w.y)}; v = v * rs * gv[jx]; xr[64 * jx] = v; }
        }
    }
}

extern "C" void kernel_launch(void* const* d_in, const int* in_sizes, int n_in, void* d_out, int out_size, void* d_ws, size_t ws_size, hipStream_t stream) {
    static int grid = 0;
    if (grid == 0) {
        if (n_in != 20 || out_size != T * D || ws_size < WS_END) { fprintf(stderr, "kernel_launch: unexpected shapes (n_in %d out %d ws %zu)\n", n_in, out_size, ws_size); grid = -1; return; }
        int dev = 0, cus = 0, per_cu = 0;
        hipGetDevice(&dev);
        hipDeviceGetAttribute(&cus, hipDeviceAttributeMultiprocessorCount, dev);
        hipFuncSetAttribute((const void*)hybrid_fwd, hipFuncAttributeMaxDynamicSharedMemorySize, LDS_BYTES);
        hipOccupancyMaxActiveBlocksPerMultiprocessor(&per_cu, (const void*)hybrid_fwd, 512, LDS_BYTES);
        if (per_cu < 1) { fprintf(stderr, "kernel_launch: occupancy query says %d blocks per CU\n", per_cu); per_cu = 1; }
        (void)hipGetLastError();
        grid = cus * per_cu;
    }
    if (grid < 0) return;
    hipMemsetAsync((char*)d_ws + WS_CTL, 0, 32768, stream);
    Args a{};
    for (int i = 0; i < 20; ++i) a.in[i] = d_in[i];
    a.out = (float*)d_out; a.ws = (unsigned char*)d_ws;
    void* params[] = {&a};
    hipError_t e = hipLaunchCooperativeKernel((const void*)hybrid_fwd, dim3(grid), dim3(512), params, LDS_BYTES, stream);
    if (e != hipSuccess) fprintf(stderr, "cooperative launch failed: %s (grid %d)\n", hipGetErrorString(e), grid);
}
```

```cpp
#include <hip/hip_runtime.h>
#include <hip/hip_cooperative_groups.h>
#include <cstdint>
#include <cstdio>
#include <type_traits>
namespace cg = cooperative_groups;

#define LAS __attribute__((address_space(3)))
typedef unsigned short bf16_t;
typedef short bf16x8 __attribute__((ext_vector_type(8)));
typedef short s16x4 __attribute__((ext_vector_type(4)));
typedef float f32x4 __attribute__((ext_vector_type(4)));
typedef float f32x2 __attribute__((ext_vector_type(2)));
typedef float f32x16 __attribute__((ext_vector_type(16)));
typedef unsigned u32x4 __attribute__((ext_vector_type(4)));
typedef unsigned u32x2 __attribute__((ext_vector_type(2)));
typedef __bf16 bf16x2_t __attribute__((ext_vector_type(2)));

constexpr int NB = 8, S = 4096, T = NB * S, D = 1024, FF = 2816, FF2 = 2 * FF, INP = 5120;
constexpr float EPS = 1e-6f;
constexpr float C2 = 0.125f * 1.4426950408889634f;
constexpr float LAM_INIT = 0.2f;

constexpr size_t MiB = 1u << 20;
constexpr size_t WS_CTL = 0;
constexpr size_t WS_WIN = 1 * MiB, WS_WGU = 11 * MiB, WS_WD = 22 * MiB, WS_WO = 28 * MiB, WS_WA = 30 * MiB, WS_WB = 31 * MiB, WS_W1K = 32 * MiB, WS_W1V = 33 * MiB;
constexpr size_t WS_COS = 34 * MiB, WS_SIN = 38 * MiB;
constexpr size_t WS_RS1 = 42 * MiB, WS_SSQ2 = 43 * MiB, WS_SSQ3 = 45 * MiB, WS_NG = 47 * MiB, WS_BIASP = 50 * MiB;
constexpr size_t WS_GK = 52 * MiB, WS_GV = 60 * MiB, WS_KCMP = 68 * MiB, WS_VCMP = 69 * MiB;
constexpr size_t WS_XB = 70 * MiB;
constexpr size_t WS_DQ = 134 * MiB, WS_DK = 166 * MiB, WS_DV = 198 * MiB, WS_NQ = 230 * MiB;
constexpr size_t WS_KC = 262 * MiB, WS_VC = 270 * MiB, WS_KS = 278 * MiB, WS_VS = 286 * MiB, WS_KW = 294 * MiB, WS_VW = 302 * MiB;
constexpr size_t WS_ACT = 134 * MiB;
constexpr size_t WS_MG = 310 * MiB;
constexpr size_t WS_YA = 438 * MiB, WS_YB = 470 * MiB;
constexpr size_t WS_END = 502 * MiB;
constexpr int LDS_BYTES = 155648;

__device__ __forceinline__ unsigned cvtpk(float lo, float hi) { f32x2 v = {lo, hi}; bf16x2_t b = __builtin_convertvector(v, bf16x2_t); return __builtin_bit_cast(unsigned, b); }
__device__ __forceinline__ float bf2f(unsigned short h) { return __uint_as_float(((unsigned)h) << 16); }
__device__ __forceinline__ float bflo(unsigned w) { return __uint_as_float(w << 16); }
__device__ __forceinline__ float bfhi(unsigned w) { return __uint_as_float(w & 0xffff0000u); }
__device__ __forceinline__ float sigmoidf_(float x) { return __builtin_amdgcn_rcpf(1.f + __builtin_amdgcn_exp2f(x * -1.4426950408889634f)); }
__device__ __forceinline__ int lane_id() { unsigned z = 0u; asm volatile("" : "+v"(z)); return (int)__builtin_amdgcn_mbcnt_hi(~0u, __builtin_amdgcn_mbcnt_lo(~0u, z)); }
__device__ __forceinline__ float xor32_sum(float v) { auto rr = __builtin_amdgcn_permlane32_swap(__float_as_uint(v), __float_as_uint(v), false, false); return __uint_as_float(rr[0]) + __uint_as_float(rr[1]); }
__device__ __forceinline__ float xor32_max(float v) { auto rr = __builtin_amdgcn_permlane32_swap(__float_as_uint(v), __float_as_uint(v), false, false); return __builtin_fmaxf(__uint_as_float(rr[0]), __uint_as_float(rr[1])); }
__device__ __forceinline__ float heads4_sum(float v) {
    v += __uint_as_float((unsigned)__builtin_amdgcn_update_dpp(0, (int)__float_as_uint(v), 0x128, 0xf, 0xf, false));
    auto rr = __builtin_amdgcn_permlane16_swap(__float_as_uint(v), __float_as_uint(v), false, false);
    return __uint_as_float(rr[0]) + __uint_as_float(rr[1]);
}
__device__ __forceinline__ float wave_sum(float v) {
#pragma unroll
    for (int o = 1; o < 64; o <<= 1) v += __shfl_xor(v, o);
    return v;
}

namespace pg8 {
constexpr int BM = 256, BK = 64, HALF = 128, HTB = HALF * BK * 2, STAGE_BYTES = 8 * HTB, NXCD = 8, WGM = 8;
__host__ __device__ __forceinline__ int lds_byte(int r, int c) { const int st = (r >> 4) * 2 + (c >> 5), rr = r & 15, cc = c & 31, ob = rr * 64 + cc * 2; return st * 1024 + (ob ^ (((ob >> 9) & 1) << 5)); }
__host__ __device__ __forceinline__ void stage_rc(int b, int& R, int& C) { const int st = b / 1024, sb = b % 1024, swz = sb ^ (((sb >> 9) & 1) << 5); R = (st >> 1) * 16 + swz / 64; C = (st & 1) * 32 + (swz % 64) / 2; }
__host__ __device__ __forceinline__ int perm32(int rho) { const int n = rho >> 4, i = rho & 15; return 8 * (i >> 2) + 4 * n + (i & 3); }
struct Unit { int pm, pn; };
struct Gemm { const bf16_t* A; const bf16_t* Bt; int M, N, K; };
struct StaticOrder {
    int nM, nN, nwg, G, c;
    __host__ __device__ void init(int M, int N, int G_, int c_) { nM = M / BM; nN = N / BM; nwg = nM * nN; G = G_; c = c_; }
    __host__ __device__ bool next(int i, Unit& u) const {
        const long L = (long)i * G + c; if (L >= nwg) return false;
        int wgid = (int)L; { const int q = nwg / NXCD, r = nwg % NXCD, xcd = wgid % NXCD, off = wgid / NXCD; wgid = (xcd < r ? xcd * (q + 1) : r * (q + 1) + (xcd - r) * q) + off; }
        const int nig = WGM * nN, gid = wgid / nig, fm = gid * WGM, gsz = (nM - fm) < WGM ? (nM - fm) : WGM;
        u.pm = fm + ((wgid % nig) % gsz); u.pn = (wgid % nig) / gsz; return true;
    }
};
template <class Epi, bool ALIGN_EPI>
__device__ __forceinline__ void gemm_phase(LAS unsigned char* lds, const Gemm g, const StaticOrder& S, const Epi& E, int wv) {
    int tid_ = wv * 64 + lane_id(); asm volatile("" : "+v"(tid_));
    const int tid = tid_, wid = __builtin_amdgcn_readfirstlane(tid >> 6), lane = tid & 63, wr = wid >> 2, wc = wid & 3, fr = lane & 15, fq = lane >> 4;
    const int K = g.K, nt = K / BK;
    unsigned voffA[2], voffB[2];
#pragma unroll
    for (int i = 0; i < 2; ++i) { int R, C; stage_rc(tid * 16 + i * 8192, R, C); const int Rb = (R & ~31) + perm32(R & 31);
        voffA[i] = (unsigned)(R * K + C) * 2u; voffB[i] = (unsigned)(Rb * K + C) * 2u; }
    const size_t kstep = (size_t)(BK * 2);
    const size_t hstep = (size_t)HALF * K * 2;
    const size_t tstep = 2 * hstep;
    const unsigned ldsw = (unsigned)wid * 1024u;
    const int aoff = lds_byte(wr * 64 + fr, fq * 8), boff = lds_byte(wc * 32 + fr, fq * 8);
#define PG8_SA(b, h) (((b) * 2 + (h)) * HTB)
#define PG8_SB(b, h) ((4 + (b) * 2 + (h)) * HTB)
#define PG8_STAGE(bufoff, gbase, voff) do { _Pragma("unroll") for (int _i = 0; _i < 2; ++_i) \
        __builtin_amdgcn_global_load_lds((const unsigned*)((const char*)(gbase) + (voff)[_i]), (LAS unsigned*)(lds + (bufoff) + ldsw + _i * 8192), 16, 0, 0); } while (0)
#define PG8_LDA(dst, b, h) do { _Pragma("unroll") for (int m = 0; m < 4; ++m) _Pragma("unroll") for (int k = 0; k < 2; ++k) dst[m][k] = *(const LAS bf16x8*)(lds + PG8_SA(b, h) + aoff + m * 2048 + k * 1024); } while (0)
#define PG8_LDB(dst, b, h) do { _Pragma("unroll") for (int n = 0; n < 2; ++n) _Pragma("unroll") for (int k = 0; k < 2; ++k) dst[n][k] = *(const LAS bf16x8*)(lds + PG8_SB(b, h) + boff + n * 2048 + k * 1024); } while (0)
#define PG8_MMA(ai, bj, At, Bt) do { __builtin_amdgcn_s_setprio(1); _Pragma("unroll") for (int m = 0; m < 4; ++m) _Pragma("unroll") for (int n = 0; n < 2; ++n) _Pragma("unroll") for (int k = 0; k < 2; ++k) \
        acc[ai][bj][m][n] = __builtin_amdgcn_mfma_f32_16x16x32_bf16(Bt[n][k], At[m][k], acc[ai][bj][m][n], 0, 0, 0); __builtin_amdgcn_s_setprio(0); } while (0)
#define PG8_WAIT_V(n) asm volatile("s_waitcnt vmcnt(" #n ")" ::: "memory")
#define PG8_WAIT_L(n) asm volatile("s_waitcnt lgkmcnt(" #n ")" ::: "memory")
#define PG8_BAR __builtin_amdgcn_s_barrier()
#define PG8_SCHED __builtin_amdgcn_sched_barrier(0)
    Unit cur, nxt; int ui = 0;
    if (!S.next(0, cur)) return;
    f32x4 acc[2][2][4][2];
#pragma unroll
    for (int a = 0; a < 2; ++a)
#pragma unroll
        for (int b = 0; b < 2; ++b)
#pragma unroll
            for (int m = 0; m < 4; ++m)
#pragma unroll
                for (int n = 0; n < 2; ++n) acc[a][b][m][n] = (f32x4){0.f, 0.f, 0.f, 0.f};
    bf16x8 At[4][2], B0[2][2], B1[2][2];
    const char* cA = (const char*)g.A + (size_t)cur.pm * tstep; const char* cB = (const char*)g.Bt + (size_t)cur.pn * tstep;
    PG8_STAGE(PG8_SB(0, 0), cB, voffB); PG8_STAGE(PG8_SB(0, 1), cB + hstep, voffB); PG8_STAGE(PG8_SA(0, 0), cA, voffA); PG8_STAGE(PG8_SA(0, 1), cA + hstep, voffA);
    if (wr == 1) PG8_BAR;
    PG8_WAIT_V(2); PG8_BAR;
    PG8_STAGE(PG8_SB(1, 0), cB + kstep, voffB); PG8_STAGE(PG8_SA(1, 0), cA + kstep, voffA); PG8_STAGE(PG8_SB(1, 1), cB + hstep + kstep, voffB);
    PG8_WAIT_V(6); PG8_BAR;
    for (;;) {
        const bool has_next = S.next(ui + 1, nxt);
        const char* nA = has_next ? (const char*)g.A + (size_t)nxt.pm * tstep : cA; const char* nB = has_next ? (const char*)g.Bt + (size_t)nxt.pn * tstep : cB;
        for (int t = 0; t < nt; t += 2) {
            const bool last = (t == nt - 2);
            const char* a1 = cA + (size_t)(t + 1) * kstep;
            const char* a2 = last ? nA : cA + (size_t)(t + 2) * kstep; const char* b2 = last ? nB : cB + (size_t)(t + 2) * kstep;
            const char* a3 = a2 + kstep; const char* b3 = b2 + kstep;
            PG8_LDB(B0, 0, 0); PG8_LDB(B1, 0, 1); PG8_SCHED; PG8_LDA(At, 0, 0); PG8_STAGE(PG8_SA(1, 1), a1 + hstep, voffA);
            PG8_WAIT_V(8); PG8_WAIT_L(0); PG8_BAR; PG8_MMA(0, 0, At, B0); PG8_MMA(0, 1, At, B1); PG8_BAR; PG8_SCHED;
            PG8_LDA(At, 0, 1); PG8_STAGE(PG8_SB(0, 0), b2, voffB); PG8_STAGE(PG8_SB(0, 1), b2 + hstep, voffB); PG8_STAGE(PG8_SA(0, 0), a2, voffA);
            PG8_WAIT_V(8); PG8_WAIT_L(0); PG8_BAR; PG8_MMA(1, 0, At, B0); PG8_MMA(1, 1, At, B1); PG8_BAR; PG8_SCHED;
            PG8_LDB(B0, 1, 0); PG8_LDB(B1, 1, 1); PG8_SCHED; PG8_LDA(At, 1, 0); PG8_STAGE(PG8_SA(0, 1), a2 + hstep, voffA);
            PG8_WAIT_V(8); PG8_WAIT_L(0); PG8_BAR; PG8_MMA(0, 0, At, B0); PG8_MMA(0, 1, At, B1); PG8_BAR; PG8_SCHED;
            PG8_LDA(At, 1, 1); PG8_STAGE(PG8_SB(1, 0), b3, voffB); PG8_STAGE(PG8_SB(1, 1), b3 + hstep, voffB); PG8_STAGE(PG8_SA(1, 0), a3, voffA);
            PG8_WAIT_V(8); PG8_WAIT_L(0); PG8_BAR; PG8_MMA(1, 0, At, B0); PG8_MMA(1, 1, At, B1); PG8_BAR; PG8_SCHED;
        }
        if constexpr (ALIGN_EPI) { if (wr == 0) PG8_BAR; }
        E(acc, cur, wr, wc, fr, fq);
        if (!has_next) break;
#pragma unroll
        for (int a = 0; a < 2; ++a)
#pragma unroll
            for (int b = 0; b < 2; ++b)
#pragma unroll
                for (int m = 0; m < 4; ++m)
#pragma unroll
                    for (int n = 0; n < 2; ++n) acc[a][b][m][n] = (f32x4){0.f, 0.f, 0.f, 0.f};
        cur = nxt; cA = nA; cB = nB; ++ui;
        if constexpr (ALIGN_EPI) { if (wr == 1) PG8_BAR; }
    }
    PG8_WAIT_V(0);
    if constexpr (!ALIGN_EPI) { if (wr == 0) PG8_BAR; }
    PG8_BAR;
#undef PG8_SA
#undef PG8_SB
#undef PG8_STAGE
#undef PG8_LDA
#undef PG8_LDB
#undef PG8_MMA
#undef PG8_WAIT_V
#undef PG8_WAIT_L
#undef PG8_BAR
#undef PG8_SCHED
}
}

typedef f32x4 AccT[2][2][4][2];

struct EpiProj {
    const float* rs1; const float* cosT; const float* sinT;
    unsigned char* ws;
    __device__ __forceinline__ void operator()(const AccT& acc, const pg8::Unit& u, int wr, int wc, int fr, int fq) const {
        const int row0 = u.pm * 256 + wr * 64 + fr;
        const int pn = u.pn;
        if (pn < 4 || (pn >= 6 && pn <= 9)) {
            bf16_t* base; int hd; float scale = 1.f; size_t hoff, bstride = (size_t)8 * S * 64; bool plain = false;
            if (pn < 2)       { const int h64 = (pn & 1) * 4 + wc; base = (bf16_t*)(ws + WS_DQ); hd = 128; scale = C2; hoff = (size_t)(h64 >> 1) * S * 128 + (h64 & 1) * 64; }
            else if (pn < 4)  { const int h64 = (pn & 1) * 4 + wc; base = (bf16_t*)(ws + WS_DK); hd = 64; hoff = (size_t)h64 * S * 64; }
            else if (pn < 8)  { const int h64 = (pn - 6) * 4 + wc; base = (bf16_t*)(ws + WS_NQ); hd = 64; scale = C2; hoff = (size_t)h64 * S * 64; }
            else if (pn == 8) { base = (bf16_t*)(ws + (wc < 2 ? WS_KC : WS_KS)); hd = 64; hoff = (size_t)(wc & 1) * S * 64; bstride = (size_t)2 * S * 64; }
            else              { base = (bf16_t*)(ws + (wc < 2 ? WS_KW : WS_VC)); hd = 64; hoff = (size_t)(wc & 1) * S * 64; bstride = (size_t)2 * S * 64; plain = wc >= 2; }
            const int d0 = 8 * fq;
            if (!plain) {
#pragma unroll
                for (int ai = 0; ai < 2; ++ai)
#pragma unroll
                    for (int m = 0; m < 4; ++m) { const int r = row0 + ai * 128 + m * 16; const float rs = rs1[r] * scale;
                        const int b = r >> 12, s = r & 4095;
                        bf16_t* p = base + (size_t)b * bstride + hoff + (size_t)s * hd + d0;
                        const f32x4 c0 = *(const f32x4*)(cosT + (size_t)r * 32 + d0), c1 = *(const f32x4*)(cosT + (size_t)r * 32 + d0 + 4), s0 = *(const f32x4*)(sinT + (size_t)r * 32 + d0), s1 = *(const f32x4*)(sinT + (size_t)r * 32 + d0 + 4);
                        const f32x4 xa = acc[ai][0][m][0] * rs, xb = acc[ai][0][m][1] * rs, ya = acc[ai][1][m][0] * rs, yb = acc[ai][1][m][1] * rs;
                        const f32x4 oa = xa * c0 - ya * s0, ob = xb * c1 - yb * s1, pa = ya * c0 + xa * s0, pb = yb * c1 + xb * s1;
                        u32x4 w1, w2; w1.x = cvtpk(oa[0], oa[1]); w1.y = cvtpk(oa[2], oa[3]); w1.z = cvtpk(ob[0], ob[1]); w1.w = cvtpk(ob[2], ob[3]);
                        w2.x = cvtpk(pa[0], pa[1]); w2.y = cvtpk(pa[2], pa[3]); w2.z = cvtpk(pb[0], pb[1]); w2.w = cvtpk(pb[2], pb[3]);
                        *(u32x4*)p = w1; *(u32x4*)(p + 32) = w2; }
            } else {
#pragma unroll
                for (int ai = 0; ai < 2; ++ai)
#pragma unroll
                    for (int m = 0; m < 4; ++m) { const int r = row0 + ai * 128 + m * 16; const float rs = rs1[r];
                        const int b = r >> 12, s = r & 4095;
#pragma unroll
                        for (int bj = 0; bj < 2; ++bj) { const f32x4 v0 = acc[ai][bj][m][0] * rs, v1 = acc[ai][bj][m][1] * rs;
                            u32x4 w; w.x = cvtpk(v0[0], v0[1]); w.y = cvtpk(v0[2], v0[3]); w.z = cvtpk(v1[0], v1[1]); w.w = cvtpk(v1[2], v1[3]);
                            *(u32x4*)(base + ((size_t)(b * 2 + bj) * S + s) * 64 + 32 * (wc & 1) + d0) = w; } }
            }
            return;
        }
#pragma unroll
        for (int bj = 0; bj < 2; ++bj) {
            const int sec = u.pn * 2 + bj;
            if (sec >= 39) continue;
            if (sec == 38) {
                if (wc == 0 && fq < 3) {
                    float* NG = (float*)(ws + WS_NG);
#pragma unroll
                    for (int ai = 0; ai < 2; ++ai)
#pragma unroll
                        for (int m = 0; m < 4; ++m) { const int r = row0 + ai * 128 + m * 16; const float rs = rs1[r];
                            f32x4 v0 = acc[ai][bj][m][0] * rs, v1 = acc[ai][bj][m][1] * rs;
                            f32x4 o0, o1;
#pragma unroll
                            for (int i = 0; i < 4; ++i) { o0[i] = sigmoidf_(v0[i]); o1[i] = sigmoidf_(v1[i]); }
                            *(f32x4*)(NG + (size_t)r * 24 + fq * 8) = o0; *(f32x4*)(NG + (size_t)r * 24 + fq * 8 + 4) = o1; }
                }
                continue;
            }
            if (sec >= 22) {
                bf16_t* MG = (bf16_t*)(ws + WS_MG);
                const int col = (sec - 22) * 128 + wc * 32 + fq * 8;
#pragma unroll
                for (int ai = 0; ai < 2; ++ai)
#pragma unroll
                    for (int m = 0; m < 4; ++m) { const int r = row0 + ai * 128 + m * 16; const float rs = rs1[r];
                        f32x4 v0 = acc[ai][bj][m][0] * rs, v1 = acc[ai][bj][m][1] * rs;
                        u32x4 w; w.x = cvtpk(sigmoidf_(v0[0]), sigmoidf_(v0[1])); w.y = cvtpk(sigmoidf_(v0[2]), sigmoidf_(v0[3]));
                        w.z = cvtpk(sigmoidf_(v1[0]), sigmoidf_(v1[1])); w.w = cvtpk(sigmoidf_(v1[2]), sigmoidf_(v1[3]));
                        *(u32x4*)(MG + (size_t)r * 2048 + col) = w; }
                continue;
            }
            bf16_t* base; int H, head, HD, coff; bool rope; float scale = 1.f;
            if (sec < 4)       { base = (bf16_t*)(ws + WS_DQ); H = 4; head = sec;      HD = 128; coff = (wc >> 1) * 64; rope = true; scale = C2; }
            else if (sec < 8)  { base = (bf16_t*)(ws + WS_DK); H = 8; head = (sec - 4) * 2 + (wc >> 1); HD = 64; coff = 0; rope = true; }
            else if (sec < 12) { base = (bf16_t*)(ws + WS_DV); H = 4; head = sec - 8;  HD = 128; coff = (wc >> 1) * 64; rope = false; }
            else if (sec < 16) { base = (bf16_t*)(ws + WS_NQ); H = 8; head = (sec - 12) * 2 + (wc >> 1); HD = 64; coff = 0; rope = true; scale = C2; }
            else { base = (bf16_t*)(ws + (sec == 20 ? WS_VS : WS_VW)); H = 2; head = wc >> 1; HD = 64; coff = 0; rope = false; }
            const int j = 4 * (wc & 1) + fq;
#pragma unroll
            for (int ai = 0; ai < 2; ++ai)
#pragma unroll
                for (int m = 0; m < 4; ++m) { const int r = row0 + ai * 128 + m * 16; const float rs = rs1[r] * scale;
                    const int b = r >> 12, s = r & 4095;
                    bf16_t* p = base + ((size_t)(b * H + head) * S + s) * HD + coff;
                    f32x4 v0 = acc[ai][bj][m][0] * rs, v1 = acc[ai][bj][m][1] * rs;
                    if (rope) {
                        const f32x4 c = *(const f32x4*)(cosT + (size_t)r * 32 + 4 * j), sn = *(const f32x4*)(sinT + (size_t)r * 32 + 4 * j);
                        const f32x4 o1 = v0 * c - v1 * sn, o2 = v1 * c + v0 * sn;
                        u32x2 w1, w2; w1.x = cvtpk(o1[0], o1[1]); w1.y = cvtpk(o1[2], o1[3]); w2.x = cvtpk(o2[0], o2[1]); w2.y = cvtpk(o2[2], o2[3]);
                        *(u32x2*)(p + 4 * j) = w1; *(u32x2*)(p + 32 + 4 * j) = w2;
                    } else {
                        u32x4 w; w.x = cvtpk(v0[0], v0[1]); w.y = cvtpk(v0[2], v0[3]); w.z = cvtpk(v1[0], v1[1]); w.w = cvtpk(v1[2], v1[3]);
                        *(u32x4*)(p + 8 * j) = w;
                    }
                }
        }
    }
};
struct EpiF32 {
    float* O; int ldc;
    __device__ __forceinline__ void operator()(const AccT& acc, const pg8::Unit& u, int wr, int wc, int fr, int fq) const {
        const int row0 = u.pm * 256 + wr * 64 + fr, col0 = u.pn * 256 + wc * 32 + fq * 8;
#pragma unroll
        for (int ai = 0; ai < 2; ++ai)
#pragma unroll
            for (int m = 0; m < 4; ++m)
#pragma unroll
                for (int bj = 0; bj < 2; ++bj) { float* p = O + (size_t)(row0 + ai * 128 + m * 16) * ldc + col0 + bj * 128;
                    *(f32x4*)p = acc[ai][bj][m][0]; *(f32x4*)(p + 4) = acc[ai][bj][m][1]; }
    }
};
template <bool SECOND> struct EpiBranch {
    bf16_t* MERGED; const bf16_t* MG;
    __device__ __forceinline__ void operator()(const AccT& acc, const pg8::Unit& u, int wr, int wc, int fr, int fq) const {
        const int row0 = u.pm * 256 + wr * 64 + fr, col0 = u.pn * 256 + wc * 32 + fq * 8;
#pragma unroll
        for (int ai = 0; ai < 2; ++ai)
#pragma unroll
            for (int m = 0; m < 4; ++m)
#pragma unroll
                for (int bj = 0; bj < 2; ++bj) { const int r = row0 + ai * 128 + m * 16, c = col0 + bj * 128;
                    const u32x4 g = *(const u32x4*)(MG + (size_t)r * 2048 + (SECOND ? 1024 : 0) + c);
                    const f32x4 a0 = acc[ai][bj][m][0], a1 = acc[ai][bj][m][1];
                    float o[8] = {bflo(g.x) * a0[0], bfhi(g.x) * a0[1], bflo(g.y) * a0[2], bfhi(g.y) * a0[3], bflo(g.z) * a1[0], bfhi(g.z) * a1[1], bflo(g.w) * a1[2], bfhi(g.w) * a1[3]};
                    bf16_t* p = MERGED + (size_t)r * 1024 + c;
                    if (SECOND) { const u32x4 pv = *(const u32x4*)p;
                        o[0] += bflo(pv.x); o[1] += bfhi(pv.x); o[2] += bflo(pv.y); o[3] += bfhi(pv.y); o[4] += bflo(pv.z); o[5] += bfhi(pv.z); o[6] += bflo(pv.w); o[7] += bfhi(pv.w); }
                    u32x4 w; w.x = cvtpk(o[0], o[1]); w.y = cvtpk(o[2], o[3]); w.z = cvtpk(o[4], o[5]); w.w = cvtpk(o[6], o[7]);
                    *(u32x4*)p = w; }
    }
};
template <bool BASE_BF> struct EpiResid {
    const void* base; bf16_t* HB; float* SSQ;
    __device__ __forceinline__ void operator()(const AccT& acc, const pg8::Unit& u, int wr, int wc, int fr, int fq) const {
        const int row0 = u.pm * 256 + wr * 64 + fr, col0 = u.pn * 256 + wc * 32 + fq * 8;
#pragma unroll
        for (int ai = 0; ai < 2; ++ai)
#pragma unroll
            for (int m = 0; m < 4; ++m) { const int r = row0 + ai * 128 + m * 16; float ss = 0.f;
#pragma unroll
                for (int bj = 0; bj < 2; ++bj) { const size_t off = (size_t)r * 1024 + col0 + bj * 128;
                    f32x4 b0, b1;
                    if (BASE_BF) { const u32x4 g = *(const u32x4*)((const bf16_t*)base + off); b0 = (f32x4){bflo(g.x), bfhi(g.x), bflo(g.y), bfhi(g.y)}; b1 = (f32x4){bflo(g.z), bfhi(g.z), bflo(g.w), bfhi(g.w)}; }
                    else { b0 = *(const f32x4*)((const float*)base + off); b1 = *(const f32x4*)((const float*)base + off + 4); }
                    const f32x4 h0 = b0 + acc[ai][bj][m][0], h1 = b1 + acc[ai][bj][m][1];
                    ss += (h0[0] * h0[0] + h0[1] * h0[1]) + (h0[2] * h0[2] + h0[3] * h0[3]) + (h1[0] * h1[0] + h1[1] * h1[1]) + (h1[2] * h1[2] + h1[3] * h1[3]);
                    u32x4 w; w.x = cvtpk(h0[0], h0[1]); w.y = cvtpk(h0[2], h0[3]); w.z = cvtpk(h1[0], h1[1]); w.w = cvtpk(h1[2], h1[3]); *(u32x4*)(HB + off) = w; }
                ss += __shfl_xor(ss, 16); ss += __shfl_xor(ss, 32);
                if (fq == 0) SSQ[(size_t)r * 16 + u.pn * 4 + wc] = ss; }
    }
};
struct EpiGU {
    const float* SSQ2; bf16_t* ACT;
    __device__ __forceinline__ void operator()(const AccT& acc, const pg8::Unit& u, int wr, int wc, int fr, int fq) const {
        const int row0 = u.pm * 256 + wr * 64 + fr, col0 = u.pn * 128 + wc * 32 + fq * 8;
#pragma unroll
        for (int ai = 0; ai < 2; ++ai)
#pragma unroll
            for (int m = 0; m < 4; ++m) { const int r = row0 + ai * 128 + m * 16;
                const f32x4* sp = (const f32x4*)(SSQ2 + (size_t)r * 16); const f32x4 s0 = sp[0], s1 = sp[1], s2 = sp[2], s3 = sp[3];
                const float tot = ((s0[0] + s0[1]) + (s0[2] + s0[3])) + ((s1[0] + s1[1]) + (s1[2] + s1[3])) + ((s2[0] + s2[1]) + (s2[2] + s2[3])) + ((s3[0] + s3[1]) + (s3[2] + s3[3]));
                const float rs = rsqrtf(tot * (1.f / 1024.f) + EPS);
                float o[8];
#pragma unroll
                for (int n = 0; n < 2; ++n) { const f32x4 gv = acc[ai][0][m][n] * rs, uv = acc[ai][1][m][n] * rs;
#pragma unroll
                    for (int i = 0; i < 4; ++i) o[4 * n + i] = gv[i] * sigmoidf_(gv[i]) * uv[i]; }
                u32x4 w; w.x = cvtpk(o[0], o[1]); w.y = cvtpk(o[2], o[3]); w.z = cvtpk(o[4], o[5]); w.w = cvtpk(o[6], o[7]);
                *(u32x4*)(ACT + (size_t)r * FF + col0) = w; }
    }
};

typedef std::integral_constant<bool, true> TrueC; typedef std::integral_constant<bool, false> FalseC;
__device__ __forceinline__ int crow(int r, int hi) { return (r & 3) + 8 * (r >> 2) + 4 * hi; }
__device__ __forceinline__ constexpr int ccol(int r) { return (r & 3) + 8 * (r >> 2); }
__device__ __forceinline__ void glds16(const void* g, LAS unsigned char* l) {
    unsigned keep; const unsigned dst = (unsigned)__builtin_amdgcn_readfirstlane((int)(unsigned)(uintptr_t)l);
    asm volatile("s_mov_b32 %0, m0\n\ts_mov_b32 m0, %2\n\ts_nop 0\n\tglobal_load_lds_dwordx4 %1, off\n\ts_mov_b32 m0, %0" : "=&s"(keep) : "v"(g), "s"(dst) : "memory");
}
#define VM_DRAIN_SYNC() do { asm volatile("s_waitcnt vmcnt(0)" ::: "memory"); __syncthreads(); } while (0)
#define WAIT_BAR(N) asm volatile("s_waitcnt vmcnt(" #N ") lgkmcnt(0)\n\ts_barrier" ::: "memory")
__device__ __forceinline__ void wait_bar_n(int n) { if (n == 4) WAIT_BAR(4); else if (n == 2) WAIT_BAR(2); else if (n == 1) WAIT_BAR(1); else WAIT_BAR(0); }
__device__ __forceinline__ int ksrc_off(int wid, int lane) { const int ip = (lane - 8 * (wid & 1)) & 63, rho = ip >> 3, c = (ip & 7) ^ rho; return (8 * wid + rho) * 64 + c * 8; }
__device__ __forceinline__ void kread_offs(int (&koff)[4], int r32, int hi) {
    const int pc = r32 >> 3, rho = r32 & 7;
#pragma unroll
    for (int d0 = 0; d0 < 4; ++d0) koff[d0] = pc * 1024 + (((rho * 8 + ((2 * d0 + hi) ^ rho) + 8 * (pc & 1)) & 63) << 4);
}
__device__ __forceinline__ void qkt(f32x16& p0, f32x16& p1, const LAS unsigned char* Kslot, const int (&koff)[4], const bf16x8* qr) {
    bf16x8 kf[8];
#pragma unroll
    for (int d0 = 0; d0 < 4; ++d0) { kf[2 * d0] = *(const LAS bf16x8*)(Kslot + koff[d0]); kf[2 * d0 + 1] = *(const LAS bf16x8*)(Kslot + koff[d0] + 4096); }
    const f32x16 zz = f32x16{};
    p0 = __builtin_amdgcn_mfma_f32_32x32x16_bf16(kf[0], qr[0], zz, 0, 0, 0); p1 = __builtin_amdgcn_mfma_f32_32x32x16_bf16(kf[1], qr[0], zz, 0, 0, 0);
#pragma unroll
    for (int d0 = 1; d0 < 4; ++d0) { p0 = __builtin_amdgcn_mfma_f32_32x32x16_bf16(kf[2 * d0], qr[d0], p0, 0, 0, 0); p1 = __builtin_amdgcn_mfma_f32_32x32x16_bf16(kf[2 * d0 + 1], qr[d0], p1, 0, 0, 0); }
}
__device__ __forceinline__ s16x4 vtr(const LAS unsigned char* p) { return __builtin_bit_cast(s16x4, __builtin_amdgcn_ds_read_tr16_b64_v4i16((LAS s16x4*)p)); }
template <int NDB> struct Flash {
    f32x16 o[NDB]; float mhat, l; bool first;
    __device__ __forceinline__ void reset() {
#pragma unroll
        for (int d = 0; d < NDB; ++d) o[d] = f32x16{};
        mhat = 0.f; l = 0.f; first = true; }
    static __device__ __forceinline__ float rowmax_abs(const f32x16& p0, const f32x16& p1) {
        float a = __builtin_fmaxf(__builtin_fmaxf(p0[0], p0[1]), p1[0]), c = __builtin_fmaxf(__builtin_fmaxf(p0[2], p0[3]), p1[1]);
        a = __builtin_fmaxf(__builtin_fmaxf(a, p1[2]), p1[3]);
#pragma unroll
        for (int r = 4; r < 16; r += 4) { a = __builtin_fmaxf(__builtin_fmaxf(a, p0[r]), p0[r + 1]); c = __builtin_fmaxf(__builtin_fmaxf(c, p0[r + 2]), p0[r + 3]);
            a = __builtin_fmaxf(__builtin_fmaxf(a, p1[r]), p1[r + 1]); c = __builtin_fmaxf(__builtin_fmaxf(c, p1[r + 2]), p1[r + 3]); }
        return xor32_max(__builtin_fmaxf(a, c));
    }
    __device__ __forceinline__ void decide(float rmabs, bool rowvalid, LAS float* wsf, int r32, int hi) {
        const float rm = rowvalid ? rmabs - mhat : -INFINITY;
        bool need; float dl;
        if (first) { need = true; dl = (rm > -1e30f) ? rm : 0.f; }
        else { need = __any(rm > 8.0f); dl = fmaxf(rm, 0.f); }
        if (need) {
            mhat += dl;
            if (!first) {
                const float f = __builtin_amdgcn_exp2f(-dl); l *= f;
                if (hi == 0) wsf[r32] = f;
                asm volatile("s_waitcnt lgkmcnt(0)" ::: "memory");
                const f32x4 t0 = *(const LAS f32x4*)(wsf + 4 * hi), t1 = *(const LAS f32x4*)(wsf + 8 + 4 * hi), t2 = *(const LAS f32x4*)(wsf + 16 + 4 * hi), t3 = *(const LAS f32x4*)(wsf + 24 + 4 * hi);
                const f32x16 fv = {t0[0], t0[1], t0[2], t0[3], t1[0], t1[1], t1[2], t1[3], t2[0], t2[1], t2[2], t2[3], t3[0], t3[1], t3[2], t3[3]};
#pragma unroll
                for (int d = 0; d < NDB; ++d) o[d] = o[d] * fv;
                asm volatile("s_waitcnt lgkmcnt(0)" ::: "memory");
            }
        }
        first = false;
    }
    __device__ __forceinline__ void exphalf(f32x16& p, float mm, u32x4& w0, u32x4& w1) {
        p = p - mm;
        float sa = 0.f, sb = 0.f;
#pragma unroll
        for (int r = 0; r < 16; r += 2) { p[r] = __builtin_amdgcn_exp2f(p[r]); p[r + 1] = __builtin_amdgcn_exp2f(p[r + 1]); sa += p[r]; sb += p[r + 1]; }
        l += sa + sb;
        w0 = (u32x4){cvtpk(p[0], p[1]), cvtpk(p[2], p[3]), cvtpk(p[4], p[5]), cvtpk(p[6], p[7])};
        w1 = (u32x4){cvtpk(p[8], p[9]), cvtpk(p[10], p[11]), cvtpk(p[12], p[13]), cvtpk(p[14], p[15])};
    }
    __device__ __forceinline__ void pv_half(const u32x4& w0, const u32x4& w1, const LAS unsigned char* Vslot, int lane, int hi, int kb) {
        const LAS unsigned char* vp = Vslot + ((lane >> 4) & 1) * 32 + (lane & 3) * 8 + (4 * hi + ((lane & 15) >> 2)) * 64;
#pragma unroll
        for (int d = 0; d < NDB; ++d) {
            const s16x4 l0 = vtr(vp + (d * 4 + kb) * 1024), h0 = vtr(vp + (d * 4 + kb) * 1024 + 512), l1 = vtr(vp + (d * 4 + kb + 1) * 1024), h1 = vtr(vp + (d * 4 + kb + 1) * 1024 + 512);
            o[d] = __builtin_amdgcn_mfma_f32_32x32x16_bf16(__builtin_bit_cast(bf16x8, w0), (bf16x8){l0[0], l0[1], l0[2], l0[3], h0[0], h0[1], h0[2], h0[3]}, o[d], 0, 0, 0);
            o[d] = __builtin_amdgcn_mfma_f32_32x32x16_bf16(__builtin_bit_cast(bf16x8, w1), (bf16x8){l1[0], l1[1], l1[2], l1[3], h1[0], h1[1], h1[2], h1[3]}, o[d], 0, 0, 0);
        }
    }
    __device__ __forceinline__ void vload_half(bf16x8 (&vf)[2 * NDB], const LAS unsigned char* Vslot, int lane, int hi, int kb) const {
        const LAS unsigned char* vp = Vslot + ((lane >> 4) & 1) * 32 + (lane & 3) * 8 + (4 * hi + ((lane & 15) >> 2)) * 64;
#pragma unroll
        for (int d = 0; d < NDB; ++d)
#pragma unroll
            for (int k = 0; k < 2; ++k) { const s16x4 lo = vtr(vp + (d * 4 + kb + k) * 1024), hh = vtr(vp + (d * 4 + kb + k) * 1024 + 512);
                vf[2 * d + k] = (bf16x8){lo[0], lo[1], lo[2], lo[3], hh[0], hh[1], hh[2], hh[3]}; }
    }
    __device__ __forceinline__ void pv_mma(const u32x4& w0, const u32x4& w1, const bf16x8 (&vf)[2 * NDB]) {
#pragma unroll
        for (int d = 0; d < NDB; ++d) { o[d] = __builtin_amdgcn_mfma_f32_32x32x16_bf16(__builtin_bit_cast(bf16x8, w0), vf[2 * d], o[d], 0, 0, 0);
            o[d] = __builtin_amdgcn_mfma_f32_32x32x16_bf16(__builtin_bit_cast(bf16x8, w1), vf[2 * d + 1], o[d], 0, 0, 0); }
    }
    __device__ __forceinline__ void tile(f32x16& p0, f32x16& p1, const LAS unsigned char* Vslot, LAS float* wsf, int lane, int r32, int hi) {
        decide(rowmax_abs(p0, p1), true, wsf, r32, hi);
        u32x4 w0, w1, w2, w3;
        exphalf(p0, mhat, w0, w1); pv_half(w0, w1, Vslot, lane, hi, 0);
        exphalf(p1, mhat, w2, w3); pv_half(w2, w3, Vslot, lane, hi, 2);
    }
    __device__ __forceinline__ float ltot() const { return xor32_sum(l); }
};
__device__ __forceinline__ void row_bcast(float v, float (&fr_)[16], LAS float* wsf, int r32, int hi) {
    asm volatile("s_waitcnt lgkmcnt(0)" ::: "memory");
    if (hi == 0) wsf[r32] = v;
    asm volatile("s_waitcnt lgkmcnt(0)" ::: "memory");
#pragma unroll
    for (int k = 0; k < 4; ++k) { const f32x4 t = *(const LAS f32x4*)(wsf + 8 * k + 4 * hi); fr_[4 * k] = t[0]; fr_[4 * k + 1] = t[1]; fr_[4 * k + 2] = t[2]; fr_[4 * k + 3] = t[3]; }
    asm volatile("s_waitcnt lgkmcnt(0)" ::: "memory");
}

constexpr int DF_STAGE = 0;
constexpr int DF_WSF = 98304;
__device__ __forceinline__ void diff_unit(LAS unsigned char* L, int b, int h, int qb, const unsigned char* ws, float lam, const float* subg, int wv) {
    int tid_ = wv * 64 + lane_id(); asm volatile("" : "+v"(tid_));
    const int tid = tid_, lane = tid & 63, r32 = lane & 31, hi = lane >> 5, wid = __builtin_amdgcn_readfirstlane(tid >> 6);
    const int comp = wid >> 2, rgi = wid & 3;
    const size_t bh = (size_t)(b * 4 + h) * S;
    const bf16_t* Qp = (const bf16_t*)(ws + WS_DQ) + (bh + qb * 128 + rgi * 32 + r32) * 128 + comp * 64;
    bf16x8 qr[4];
#pragma unroll
    for (int d0 = 0; d0 < 4; ++d0) qr[d0] = *(const bf16x8*)(Qp + d0 * 16 + hi * 8);
    const bf16_t* Kg = (const bf16_t*)(ws + WS_DK) + bh * 128 + ksrc_off(wid, lane);
    int koff[4]; kread_offs(koff, r32, hi);
    const bf16_t* Vg = (const bf16_t*)(ws + WS_DV) + bh * 128 + (size_t)(16 * (wid & 3) + (lane >> 2)) * 128 + (wid >> 2) * 32 + (lane & 3) * 8;
    LAS float* wsf = (LAS float*)(L + DF_WSF) + wid * 32;
    const int NT = 2 * qb + 2;
    Flash<4> F; F.reset();
    auto dmaK = [&](int t, int s) { const bf16_t* src = Kg + (size_t)t * 4096; LAS unsigned char* d = L + s * 16384 + wid * 1024; glds16(src, d); glds16(src + (size_t)S * 64, d + 8192); };
    auto dmaV = [&](int t, int s) { const bf16_t* src = Vg + (size_t)t * 8192; LAS unsigned char* d = L + 49152 + s * 16384 + wid * 1024; glds16(src, d); glds16(src + 64, d + 8192); };
    dmaK(0, 0); dmaV(0, 0); dmaK(1, 1); dmaV(1, 1); if (NT > 2) dmaK(2, 2);
    WAIT_BAR(0);
    f32x16 a0, a1, b0, b1; float ra, rb;
    const int xq = 32 * rgi + r32 - 4 * hi;
    auto cmask = [&](f32x16& c0, f32x16& c1, int t) { const int x = xq - 64 * (t - (NT - 2));
#pragma unroll
        for (int r = 0; r < 16; ++r) { if (ccol(r) > x) c0[r] = -INFINITY; if (ccol(r) + 32 > x) c1[r] = -INFINITY; } };
    qkt(a0, a1, L + comp * 8192, koff, qr);
    if (NT == 2) cmask(a0, a1, 0);
    ra = Flash<4>::rowmax_abs(a0, a1);
    WAIT_BAR(0);
    int s0 = 0, s1 = 1, s2 = 2;
    auto iter = [&](int t, f32x16& c0, f32x16& c1, float& rc, f32x16& n0, f32x16& n1, float& rn, auto next) {
        int nis = 0;
        if (t + 3 < NT) { dmaK(t + 3, s0); nis += 2; }
        if (t + 2 < NT) { dmaV(t + 2, s2); nis += 2; }
        F.decide(rc, true, wsf, r32, hi);
        const LAS unsigned char* Vs = L + 49152 + s0 * 16384;
        u32x4 w0, w1, w2, w3;
        if constexpr (decltype(next)::value) qkt(n0, n1, L + s1 * 16384 + comp * 8192, koff, qr);
        F.exphalf(c0, F.mhat, w0, w1);
        F.pv_half(w0, w1, Vs, lane, hi, 0);
        F.exphalf(c1, F.mhat, w2, w3);
        F.pv_half(w2, w3, Vs, lane, hi, 2);
        if constexpr (decltype(next)::value) { rn = Flash<4>::rowmax_abs(n0, n1); if (t + 1 >= NT - 2) { cmask(n0, n1, t + 1); rn = Flash<4>::rowmax_abs(n0, n1); } }
        wait_bar_n(nis);
        const int tmp = s0; s0 = s1; s1 = s2; s2 = tmp;
    };
    int t = 0;
    for (; t < NT - 2; t += 2) { iter(t, a0, a1, ra, b0, b1, rb, TrueC{}); iter(t + 1, b0, b1, rb, a0, a1, ra, TrueC{}); }
    iter(NT - 2, a0, a1, ra, b0, b1, rb, TrueC{});
    iter(NT - 1, b0, b1, rb, a0, a1, ra, FalseC{});
    const float lt = F.ltot();
    float fr_[16];
    row_bcast((comp ? lam : 1.f) / lt, fr_, wsf, r32, hi);
    LAS float* stg = (LAS float*)(L + DF_STAGE) + rgi * 32 * 132;
    if (comp == 1) {
#pragma unroll
        for (int d = 0; d < 4; ++d)
#pragma unroll
            for (int r = 0; r < 16; ++r) stg[crow(r, hi) * 132 + d * 32 + r32] = F.o[d][r] * fr_[r];
    }
    __syncthreads();
    if (comp == 0) {
#pragma unroll
        for (int d = 0; d < 4; ++d)
#pragma unroll
            for (int r = 0; r < 16; ++r) { const int ix = crow(r, hi) * 132 + d * 32 + r32; stg[ix] = F.o[d][r] * fr_[r] - stg[ix]; }
        asm volatile("s_waitcnt lgkmcnt(0)" ::: "memory");
        const LAS float* rowp = stg + r32 * 132 + 64 * hi;
        float ss = 0.f;
#pragma unroll
        for (int k = 0; k < 16; ++k) { const f32x4 v = *(const LAS f32x4*)(rowp + 4 * k); ss += (v[0] * v[0] + v[1] * v[1]) + (v[2] * v[2] + v[3] * v[3]); }
        ss = xor32_sum(ss);
        const float rstd = rsqrtf(ss * (1.f / 128.f) + EPS) * (1.f - LAM_INIT);
        bf16_t* Yp = (bf16_t*)(ws + WS_YA) + ((size_t)b * S + qb * 128 + rgi * 32 + r32) * 512 + h * 128 + 64 * hi;
#pragma unroll
        for (int k = 0; k < 8; ++k) { const f32x4 v0 = *(const LAS f32x4*)(rowp + 8 * k), v1 = *(const LAS f32x4*)(rowp + 8 * k + 4);
            const f32x4 g0 = *(const f32x4*)(subg + 64 * hi + 8 * k), g1 = *(const f32x4*)(subg + 64 * hi + 8 * k + 4);
            u32x4 w; w.x = cvtpk(v0[0] * rstd * g0[0], v0[1] * rstd * g0[1]); w.y = cvtpk(v0[2] * rstd * g0[2], v0[3] * rstd * g0[3]);
            w.z = cvtpk(v1[0] * rstd * g1[0], v1[1] * rstd * g1[1]); w.w = cvtpk(v1[2] * rstd * g1[2], v1[3] * rstd * g1[3]);
            *(u32x4*)(Yp + 8 * k) = w; }
    }
    __syncthreads();
}

constexpr int NS_CMP = 49152;
constexpr int NS_GL = 114688;
constexpr int NS_WSF = 147456;
template <int MODE>
__device__ __forceinline__ void nsa_kv_pass(LAS unsigned char* L, Flash<2>& F, const bf16x8* qr, const int (&koff)[4], const bf16_t* Kg0, const bf16_t* Vg0, int jlo, int jhi, int qblk, int ql, unsigned long long mymask,
                                            LAS float* wsf, int wid, int lane, int r32, int hi) {
    auto dmaK = [&](int j, int s) { glds16(Kg0 + (size_t)j * 4096, L + s * 8192 + wid * 1024); };
    auto dmaV = [&](int j, int s) { glds16(Vg0 + (size_t)j * 4096, L + 24576 + s * 8192 + wid * 1024); };
    dmaK(jlo, 0); dmaV(jlo, 0); if (jlo + 1 <= jhi) { dmaK(jlo + 1, 1); dmaV(jlo + 1, 1); } if (jlo + 2 <= jhi) dmaK(jlo + 2, 2);
    WAIT_BAR(0);
    f32x16 a0, a1, b0, b1; float ra, rb;
    const int xq = ql - 4 * hi;
    auto masked = [&](int j) { return MODE == 1 ? (j == qblk) : (j == qblk || j == qblk - 8); };
    auto amask = [&](f32x16& c0, f32x16& c1, int j) {
        if (MODE == 1) {
#pragma unroll
            for (int r = 0; r < 16; ++r) { if (ccol(r) > xq) c0[r] = -INFINITY; if (ccol(r) + 32 > xq) c1[r] = -INFINITY; }
        } else { const int base = 64 * (qblk - j) + xq;
#pragma unroll
            for (int r = 0; r < 16; ++r) { if ((unsigned)(base - ccol(r)) >= 512u) c0[r] = -INFINITY; if ((unsigned)(base - ccol(r) - 32) >= 512u) c1[r] = -INFINITY; } } };
    qkt(a0, a1, L, koff, qr);
    if (masked(jlo)) amask(a0, a1, jlo);
    ra = Flash<2>::rowmax_abs(a0, a1);
    WAIT_BAR(0);
    int s0 = 0, s1 = 1, s2 = 2;
    auto iter = [&](int j, f32x16& c0, f32x16& c1, float& rc, f32x16& n0, f32x16& n1, float& rn, auto next) {
        int nis = 0;
        if (j + 3 <= jhi) { dmaK(j + 3, s0); nis += 1; }
        if (j + 2 <= jhi) { dmaV(j + 2, s2); nis += 1; }
        const bool rowvalid = (MODE == 1) ? (bool)((mymask >> j) & 1ull) : true;
        F.decide(rc, rowvalid, wsf, r32, hi);
        const float mm = rowvalid ? F.mhat : INFINITY;
        const LAS unsigned char* Vs = L + 24576 + s0 * 8192;
        u32x4 w0, w1, w2, w3; bf16x8 vfa[4], vfb[4];
        F.vload_half(vfa, Vs, lane, hi, 0);
        if constexpr (decltype(next)::value) qkt(n0, n1, L + s1 * 8192, koff, qr);
        F.exphalf(c0, mm, w0, w1);
        F.vload_half(vfb, Vs, lane, hi, 2);
        F.pv_mma(w0, w1, vfa);
        F.exphalf(c1, mm, w2, w3);
        F.pv_mma(w2, w3, vfb);
        if constexpr (decltype(next)::value) { rn = Flash<2>::rowmax_abs(n0, n1); if (masked(j + 1)) { amask(n0, n1, j + 1); rn = Flash<2>::rowmax_abs(n0, n1); } }
        wait_bar_n(nis);
        const int tmp = s0; s0 = s1; s1 = s2; s2 = tmp;
    };
    int j = jlo;
    for (; j + 2 <= jhi; j += 2) { iter(j, a0, a1, ra, b0, b1, rb, TrueC{}); iter(j + 1, b0, b1, rb, a0, a1, ra, TrueC{}); }
    if (j < jhi) { iter(j, a0, a1, ra, b0, b1, rb, TrueC{}); iter(jhi, b0, b1, rb, a0, a1, ra, FalseC{}); }
    else iter(jhi, a0, a1, ra, b0, b1, rb, FalseC{});
}
__device__ __forceinline__ void nsa_unit(LAS unsigned char* L, int b, int g, int qblk, const unsigned char* ws, int wv) {
    int tid_ = wv * 64 + lane_id(); asm volatile("" : "+v"(tid_));
    const int tid = tid_, lane = tid & 63, r32 = lane & 31, hi = lane >> 5, wid = __builtin_amdgcn_readfirstlane(tid >> 6);
    const int ql = 8 * wid + (r32 & 7), hh = r32 >> 3, head = g * 4 + hh;
    const int qpos = 64 * qblk + ql;
    const size_t tok = (size_t)b * S + qpos;
    const bf16_t* Qp = (const bf16_t*)(ws + WS_NQ) + ((size_t)(b * 8 + head) * S + qpos) * 64;
    bf16x8 qr[4];
#pragma unroll
    for (int d0 = 0; d0 < 4; ++d0) qr[d0] = *(const bf16x8*)(Qp + d0 * 16 + hi * 8);
    const float* NGp = (const float*)(ws + WS_NG) + tok * 24 + head;
    const float g0 = NGp[0], g1 = NGp[8], g2 = NGp[16];
    LAS float* wsf = (LAS float*)(L + NS_WSF) + wid * 32;
    const size_t pg = (size_t)(b * 2 + g);
    LAS float* yst = (LAS float*)(L + NS_CMP) + wid * 2048;
    float fr_[16];
    unsigned long long mymask = 0ull;
    int koff[4]; kread_offs(koff, r32, hi);
    {
        const int ntc = ((4 * qblk + 2) >> 6) + 1;
        const bf16_t* Kc = (const bf16_t*)(ws + WS_KCMP) + pg * 256 * 64 + ksrc_off(wid, lane);
        const bf16_t* Vc = (const bf16_t*)(ws + WS_VCMP) + (pg * 256 + 16 * (wid & 3) + (lane >> 2)) * 64 + (wid >> 2) * 32 + (lane & 3) * 8;
        for (int ct = 0; ct < ntc; ++ct) { glds16(Kc + (size_t)ct * 4096, L + NS_CMP + ct * 8192 + wid * 1024); glds16(Vc + (size_t)ct * 4096, L + NS_CMP + 32768 + ct * 8192 + wid * 1024); }
        VM_DRAIN_SYNC();
        const int cm = (qpos >= 31) ? ((qpos - 31) >> 4) : -1;
        Flash<2> F; F.reset();
        for (int ct = 0; ct < ntc; ++ct) {
            f32x16 p0, p1;
            qkt(p0, p1, L + NS_CMP + ct * 8192, koff, qr);
            const int x = cm - 64 * ct - 4 * hi;
#pragma unroll
            for (int r = 0; r < 16; ++r) { if (ccol(r) > x) p0[r] = -INFINITY; if (ccol(r) + 32 > x) p1[r] = -INFINITY; }
            F.tile(p0, p1, L + NS_CMP + 32768 + ct * 8192, wsf, lane, r32, hi);
        }
        const float lt = F.ltot();
        const float il = lt > 0.f ? 1.f / lt : 0.f;
        LAS float* Gs = (LAS float*)(L + NS_GL) + wid * 1024;
        LAS float* Ls = Gs + 512;
        for (int ct = 0; ct < ntc; ++ct) {
            f32x16 p0, p1;
            qkt(p0, p1, L + NS_CMP + ct * 8192, koff, qr);
            const int x = cm - 64 * ct - 4 * hi;
#pragma unroll
            for (int r = 0; r < 16; ++r) {
                float a = (ccol(r) > x) ? 0.f : __builtin_amdgcn_exp2f(p0[r] - F.mhat) * il, bq = (ccol(r) + 32 > x) ? 0.f : __builtin_amdgcn_exp2f(p1[r] - F.mhat) * il;
                a = heads4_sum(a); bq = heads4_sum(bq);
                p0[r] = a; p1[r] = bq; }
            if (r32 < 8) {
#pragma unroll
                for (int k = 0; k < 4; ++k) { const int jj = 16 * ct + 2 * k + hi;
                    Gs[r32 * 64 + jj] = (p0[4 * k] + p0[4 * k + 1]) + (p0[4 * k + 2] + p0[4 * k + 3]); Ls[r32 * 64 + jj] = p0[4 * k + 3];
                    Gs[r32 * 64 + jj + 8] = (p1[4 * k] + p1[4 * k + 1]) + (p1[4 * k + 2] + p1[4 * k + 3]); Ls[r32 * 64 + jj + 8] = p1[4 * k + 3]; }
            }
        }
        asm volatile("s_waitcnt lgkmcnt(0)" ::: "memory");
        const int j = lane, jmax = 16 * ntc;
        for (int qi = 0; qi < 8; ++qi) {
            float v = (j < jmax) ? Gs[qi * 64 + j] : 0.f;
            if (j >= 1 && j - 1 < jmax) v += Ls[qi * 64 + j - 1];
            if (j == 0 || j == qblk || j == qblk - 1) v = 1e9f;
            if (j > qblk) v = -1e30f;
            unsigned key = __float_as_uint(v); key = (key & 0x80000000u) ? ~key : (key | 0x80000000u);
            unsigned long long C = ~0ull, selm = 0ull; int kk = 16, nc = 64;
            if (qblk < 16) { selm = ~0ull; kk = 0; nc = 0; }
            for (int bit = 31; bit >= 0 && nc > kk; --bit) {
                const unsigned long long bs = __ballot((key >> bit) & 1u) & C;
                const int c1 = __popcll(bs);
                if (c1 >= kk) { C = bs; nc = c1; } else { selm |= bs; kk -= c1; C &= ~bs; nc -= c1; }
            }
            for (int i = 0; i < kk; ++i) { const unsigned long long low = C & (0ull - C); selm |= low; C ^= low; }
            const unsigned long long m = selm & ((qblk >= 63) ? ~0ull : ((1ull << (qblk + 1)) - 1ull));
            if ((r32 & 7) == qi) mymask = m;
        }
        asm volatile("s_waitcnt lgkmcnt(0)" ::: "memory");
        __syncthreads();
        row_bcast(g0 * il, fr_, wsf, r32, hi);
#pragma unroll
        for (int d = 0; d < 2; ++d)
#pragma unroll
            for (int r = 0; r < 16; ++r) yst[crow(r, hi) * 64 + d * 32 + r32] = F.o[d][r] * fr_[r];
    }
    const size_t ksrc = pg * S * 64 + ksrc_off(wid, lane);
    const size_t voff = (pg * S + 16 * (wid & 3) + (lane >> 2)) * 64 + (wid >> 2) * 32 + (lane & 3) * 8;
    {
        Flash<2> F; F.reset();
        nsa_kv_pass<1>(L, F, qr, koff, (const bf16_t*)(ws + WS_KS) + ksrc, (const bf16_t*)(ws + WS_VS) + voff, 0, qblk, qblk, ql, mymask, wsf, wid, lane, r32, hi);
        const float lt = F.ltot();
        row_bcast(g1 / lt, fr_, wsf, r32, hi);
#pragma unroll
        for (int d = 0; d < 2; ++d)
#pragma unroll
            for (int r = 0; r < 16; ++r) yst[crow(r, hi) * 64 + d * 32 + r32] += F.o[d][r] * fr_[r];
    }
    {
        Flash<2> F; F.reset();
        const int jlo = qblk >= 8 ? qblk - 8 : 0;
        nsa_kv_pass<2>(L, F, qr, koff, (const bf16_t*)(ws + WS_KW) + ksrc, (const bf16_t*)(ws + WS_VW) + voff, jlo, qblk, qblk, ql, 0ull, wsf, wid, lane, r32, hi);
        const float lt = F.ltot();
        row_bcast(g2 / lt, fr_, wsf, r32, hi);
        LAS bf16_t* stg = (LAS bf16_t*)(L + NS_GL) + wid * 2048;
#pragma unroll
        for (int r = 0; r < 16; ++r) { const int orow = crow(r, hi);
#pragma unroll
            for (int d = 0; d < 2; ++d) { const float yv = yst[orow * 64 + d * 32 + r32] + F.o[d][r] * fr_[r]; stg[orow * 64 + d * 32 + r32] = (bf16_t)(cvtpk(yv, 0.f) & 0xffffu); } }
        asm volatile("s_waitcnt lgkmcnt(0)" ::: "memory");
        bf16_t* Yb = (bf16_t*)(ws + WS_YB);
#pragma unroll
        for (int i = 0; i < 4; ++i) { const int row = i * 8 + (lane >> 3), ch = lane & 7; const u32x4 v = *(const LAS u32x4*)(stg + row * 64 + ch * 8);
            *(u32x4*)(Yb + ((size_t)b * S + 64 * qblk + 8 * wid + (row & 7)) * 512 + (g * 4 + (row >> 3)) * 64 + ch * 8) = v; }
    }
    __syncthreads();
}

#define XB_TMO      128
#define XB_XCNT(j)  (256  + 64 * (j))
#define XB_XSUB(j)  (1280 + 64 * (j))
#define XB_XGEN(j)  (2304 + 64 * (j))
#define XB_TOP      3328
#define XB_TOPGEN   3392
#define XCD_BAR_WORDS 3456
#define XB_SPIN_CAP (1u << 18)

__device__ __forceinline__ unsigned xb_ld(unsigned* p)              { return __hip_atomic_load(p, __ATOMIC_RELAXED, __HIP_MEMORY_SCOPE_AGENT); }
__device__ __forceinline__ unsigned xb_add(unsigned* p, unsigned v) { return __hip_atomic_fetch_add(p, v, __ATOMIC_RELAXED, __HIP_MEMORY_SCOPE_AGENT); }
__device__ __forceinline__ unsigned xb_xcc_id() { return (unsigned)__builtin_amdgcn_s_getreg((3 << 11) | 20) & 0xFu; }
#define XB_SPIN(cond, bar) do { unsigned _sp = 0; while (cond) { __builtin_amdgcn_s_sleep(1); \
    if ((++_sp & 255u) == 0u) { if (xb_ld(&(bar)[XB_TMO])) break; if (_sp > XB_SPIN_CAP) { atomicAdd(&(bar)[XB_TMO], 1u); break; } } } } while (0)

struct XcdBarrier {
    unsigned* bar; unsigned x;
    volatile LAS unsigned* st;
    bool lead;
};

__device__ __forceinline__ XcdBarrier xcd_barrier_post(unsigned* bar, volatile LAS unsigned* st, bool lead) {
    XcdBarrier b; b.bar = bar; b.x = xb_xcc_id(); b.st = st; b.lead = lead;
    if (b.lead && lane_id() == 0) (void)xb_add(&bar[XB_XCNT(b.x)], 1u);
    return b;
}
__device__ __forceinline__ void xcd_barrier_complete(unsigned* bar, unsigned x, unsigned& nloc, unsigned& nx) {
    const unsigned G = gridDim.x * gridDim.y * gridDim.z;
    unsigned sum, cnt, mine, sp = 0u;
    for (;;) {
        sum = 0u; cnt = 0u; mine = 0u;
#pragma unroll
        for (unsigned j = 0; j < 16; ++j) { const unsigned c = xb_ld(&bar[XB_XCNT(j)]); sum += c; cnt += (c > 0u) ? 1u : 0u; mine = (j == x) ? c : mine; }
        if (sum == G) break;
        __builtin_amdgcn_s_sleep(1);
        if ((++sp & 255u) == 0u) { if (xb_ld(&bar[XB_TMO])) break; if (sp > XB_SPIN_CAP) { atomicAdd(&bar[XB_TMO], 1u); break; } }
    }
    nloc = mine > 0u ? mine : 1u; nx = cnt > 0u ? cnt : 1u;
}

__device__ __forceinline__ void xcd_barrier(const XcdBarrier& b) {
    asm volatile("s_waitcnt vmcnt(0)" ::: "memory");
    __syncthreads();
    if (b.lead && lane_id() == 0) {
        unsigned* bar = b.bar;
        __builtin_amdgcn_s_waitcnt(0);
        unsigned nloc = b.st[0], nx = b.st[1];
        if (nloc == 0u) { xcd_barrier_complete(bar, b.x, nloc, nx); b.st[0] = nloc; b.st[1] = nx; }
        const unsigned old = xb_add(&bar[XB_XSUB(b.x)], 1u);
        const unsigned gen = old / nloc;
        if (old + 1u == (gen + 1u) * nloc) {
            __builtin_amdgcn_fence(__ATOMIC_RELEASE, "agent");
            asm volatile("s_waitcnt vmcnt(0)" ::: "memory");
            const unsigned og = xb_add(&bar[XB_TOP], 1u);
            const unsigned tg = og / nx;
            if (og + 1u == (tg + 1u) * nx) xb_add(&bar[XB_TOPGEN], 1u);
            else XB_SPIN(xb_ld(&bar[XB_TOPGEN]) == tg, bar);
            __builtin_amdgcn_fence(__ATOMIC_ACQUIRE, "agent");
            xb_add(&bar[XB_XGEN(b.x)], 1u);
            asm volatile("s_waitcnt vmcnt(0)" ::: "memory");
        } else {
            XB_SPIN(xb_ld(&bar[XB_XGEN(b.x)]) == gen, bar);
            __builtin_amdgcn_fence(__ATOMIC_ACQUIRE, "agent");
            asm volatile("s_waitcnt vmcnt(0)" ::: "memory");
        }
    }
    __syncthreads();
}


template <class MapF>
__device__ __forceinline__ void tr_item(const float* W, int K, int N, int ldw, bf16_t* WT, const float* kscale, LAS float* scr, int item, int lane, const MapF& map) {
    const int nblk = (N + 31) / 32, kb = item / nblk, nb = item % nblk, k0 = 64 * kb, n0 = 32 * nb;
    const int nn = n0 + (lane & 31);
#pragma unroll 8
    for (int i = 0; i < 32; ++i) { const int kk = 2 * i + (lane >> 5); float v = (nn < N) ? W[(size_t)(k0 + kk) * ldw + nn] : 0.f; if (kscale) v *= kscale[k0 + kk]; scr[kk * 33 + (lane & 31)] = v; }
    asm volatile("s_waitcnt lgkmcnt(0)" ::: "memory");
    const int c = lane & 7;
#pragma unroll
    for (int jx = 0; jx < 4; ++jx) { const int n = (lane >> 3) + 8 * jx; const LAS float* s = scr + (8 * c) * 33 + n;
        u32x4 o; o.x = cvtpk(s[0 * 33], s[1 * 33]); o.y = cvtpk(s[2 * 33], s[3 * 33]); o.z = cvtpk(s[4 * 33], s[5 * 33]); o.w = cvtpk(s[6 * 33], s[7 * 33]);
        if (n0 + n < N) *(u32x4*)(WT + (size_t)map(n0 + n) * K + k0 + 8 * c) = o; }
    asm volatile("s_waitcnt lgkmcnt(0)" ::: "memory");
}
__device__ __forceinline__ int rope_pos(int d) { return d < 32 ? 8 * (d >> 2) + (d & 3) : 8 * ((d - 32) >> 2) + 4 + (d & 3); }
struct MapIn {
    __device__ __forceinline__ int operator()(int n) const {
        if (n >= 2840) return 2816 + (n - 2840);
        if (n >= 2816) return 4864 + (n - 2816);
        if (n < 1024 || (n >= 1536 && n < 2048)) {
            const int tile = (n < 1024) ? (n >> 8) : 6 + ((n - 1536) >> 8), hq = (n >> 6) & 3, d = n & 63;
            return tile * 256 + (d >= 32 ? 128 : 0) + hq * 32 + (d & 31); }
        if (n < 1536) return n;
        const int sidx = (n - 2048) >> 7, g = (n >> 6) & 1, d = n & 63;
        if (sidx == 0 || sidx == 2) return 8 * 256 + (d >= 32 ? 128 : 0) + ((sidx >> 1) * 2 + g) * 32 + (d & 31);
        if (sidx == 4) return 9 * 256 + (d >= 32 ? 128 : 0) + g * 32 + (d & 31);
        if (sidx == 1) return 9 * 256 + (g ? 192 : 64) + d;
        return 10 * 256 + (sidx == 5 ? 128 : 0) + g * 64 + d;
    }
};
struct MapId { int off; __device__ __forceinline__ int operator()(int n) const { return off + n; } };
struct MapGU { int up; __device__ __forceinline__ int operator()(int f) const { return 256 * (f >> 7) + 128 * up + (f & 127); } };

__device__ __forceinline__ int queue_fetch(unsigned* qbase, unsigned x, LAS int* kstate) {
    int k = *kstate;
    while (k < 8) { const unsigned q = (x + (unsigned)k) & 7u; const unsigned li = atomicAdd(qbase + 64 * q, 1u); if (li < 128u) { *kstate = k; return (int)(q * 128u + li); } ++k; }
    *kstate = k; return -1;
}
struct Args { const void* in[20]; float* out; unsigned char* ws; int use_cg; int pad; };

__global__ void __launch_bounds__(512, 2) hybrid_fwd(Args args) {
    extern __shared__ __attribute__((aligned(16))) unsigned char lds_raw[];
    LAS unsigned char* L = (LAS unsigned char*)lds_raw;
    cg::grid_group grid = cg::this_grid();
    const int wave_s = __builtin_amdgcn_readfirstlane((int)(threadIdx.x >> 6));
#define PHASE_IDS() int tid_ = wave_s * 64 + lane_id(); asm volatile("" : "+v"(tid_)); const int tid = tid_, lane = tid & 63, wave = __builtin_amdgcn_readfirstlane(tid >> 6); (void)lane; (void)wave
    const int G = gridDim.x, bx = blockIdx.x;
    unsigned char* ws = args.ws;
    const float* x = (const float*)args.in[0];
    const int* positions = (const int*)args.in[1];
    float* out = args.out;
    unsigned* ctl = (unsigned*)(ws + WS_CTL);
    LAS int* misc = (LAS int*)(L + LDS_BYTES - 64);
    { const int t0 = wave_s * 64 + lane_id(); if (t0 < 16) misc[t0] = 0; }
    __syncthreads();
    const XcdBarrier xbar = xcd_barrier_post(ctl + 4096, (volatile LAS unsigned*)(misc + 8), wave_s == 0);

    {
        PHASE_IDS();
        LAS float* scr = (LAS float*)(L + wave * 16384);
        const int gw = bx * 8 + wave, NGW = G * 8;
        const float* g1 = (const float*)args.in[2]; const float* g2 = (const float*)args.in[15];
        constexpr int I_IN = 16 * 153, I_G = 16 * 88, I_D = 44 * 32, I_O = 16 * 32, I_A = 8 * 32, I_C = 16 * 8;
        constexpr int NIT = I_IN + 2 * I_G + I_D + I_O + 2 * I_A + 4 * I_C;
        for (int it = gw; it < NIT; it += NGW) {
            int r = it;
            if (r < I_IN) { tr_item((const float*)args.in[3], 1024, 4888, 4888, (bf16_t*)(ws + WS_WIN), g1, scr, r, lane, MapIn{}); continue; } r -= I_IN;
            if (r < I_G) { tr_item((const float*)args.in[16], 1024, FF, FF, (bf16_t*)(ws + WS_WGU), g2, scr, r, lane, MapGU{0}); continue; } r -= I_G;
            if (r < I_G) { tr_item((const float*)args.in[17], 1024, FF, FF, (bf16_t*)(ws + WS_WGU), g2, scr, r, lane, MapGU{1}); continue; } r -= I_G;
            if (r < I_D) { tr_item((const float*)args.in[18], FF, 1024, 1024, (bf16_t*)(ws + WS_WD), nullptr, scr, r, lane, MapId{0}); continue; } r -= I_D;
            if (r < I_O) { tr_item((const float*)args.in[14], 1024, 1024, 1024, (bf16_t*)(ws + WS_WO), nullptr, scr, r, lane, MapId{0}); continue; } r -= I_O;
            if (r < I_A) { tr_item((const float*)args.in[12], 512, 1024, 1024, (bf16_t*)(ws + WS_WA), nullptr, scr, r, lane, MapId{0}); continue; } r -= I_A;
            if (r < I_A) { tr_item((const float*)args.in[13], 512, 1024, 1024, (bf16_t*)(ws + WS_WB), nullptr, scr, r, lane, MapId{0}); continue; } r -= I_A;
            if (r < I_C) { tr_item((const float*)args.in[8], 1024, 256, 256, (bf16_t*)(ws + WS_W1K), nullptr, scr, r, lane, MapId{0}); continue; } r -= I_C;
            if (r < I_C) { tr_item((const float*)args.in[8] + 1024 * 256, 1024, 256, 256, (bf16_t*)(ws + WS_W1K), nullptr, scr, r, lane, MapId{256}); continue; } r -= I_C;
            if (r < I_C) { tr_item((const float*)args.in[10], 1024, 256, 256, (bf16_t*)(ws + WS_W1V), nullptr, scr, r, lane, MapId{0}); continue; } r -= I_C;
            tr_item((const float*)args.in[10] + 1024 * 256, 1024, 256, 256, (bf16_t*)(ws + WS_W1V), nullptr, scr, r, lane, MapId{256});
        }
        bf16_t* XB = (bf16_t*)(ws + WS_XB); float* rs1 = (float*)(ws + WS_RS1);
        float* cosT = (float*)(ws + WS_COS); float* sinT = (float*)(ws + WS_SIN);
        const float invf = 1.0f / powf(10000.0f, (float)(2 * (lane & 31)) / 64.0f);
        for (int m = gw; m < T; m += NGW) {
            const f32x4* xr = (const f32x4*)(x + (size_t)m * D) + lane;
            f32x4 v[4]; float s = 0.f;
#pragma unroll
            for (int jx = 0; jx < 4; ++jx) { v[jx] = xr[64 * jx]; s += (v[jx][0] * v[jx][0] + v[jx][1] * v[jx][1]) + (v[jx][2] * v[jx][2] + v[jx][3] * v[jx][3]); }
            s = wave_sum(s);
            if (lane == 0) rs1[m] = rsqrtf(s * (1.f / D) + EPS);
            u32x2* o8 = (u32x2*)(XB + (size_t)m * D) + lane;
#pragma unroll
            for (int jx = 0; jx < 4; ++jx) { u32x2 w; w.x = cvtpk(v[jx][0], v[jx][1]); w.y = cvtpk(v[jx][2], v[jx][3]); o8[64 * jx] = w; }
            const float ang = (float)positions[m] * invf;
            if (lane < 32) cosT[(size_t)m * 32 + lane] = cosf(ang); else sinT[(size_t)m * 32 + (lane - 32)] = sinf(ang);
        }
        if (bx < 32) {
            const int kv = bx >> 4, slab = bx & 15;
            const float* pe = (const float*)args.in[kv ? 7 : 6]; const float* W1 = (const float*)args.in[kv ? 10 : 8];
            const int n = tid & 255, half = tid >> 8; float acc = 0.f;
            for (int k = slab * 128 + half * 64; k < slab * 128 + half * 64 + 64; ++k) acc += pe[k] * W1[(size_t)k * 256 + n];
            __syncthreads();
            LAS float* red = (LAS float*)L;
            if (half) red[n] = acc;
            __syncthreads();
            if (!half) ((float*)(ws + WS_BIASP))[(kv * 16 + slab) * 256 + n] = acc + red[n];
            __syncthreads();
        }
    }
    if (args.use_cg) grid.sync(); else xcd_barrier(xbar);
    {
        pg8::Gemm g{(const bf16_t*)(ws + WS_XB), (const bf16_t*)(ws + WS_WIN), T, INP, D}; pg8::StaticOrder SO; SO.init(T, INP, G, bx);
        EpiProj E{(const float*)(ws + WS_RS1), (const float*)(ws + WS_COS), (const float*)(ws + WS_SIN), ws};
        pg8::gemm_phase<EpiProj, true>(L, g, SO, E, wave_s);
    }
    xcd_barrier(xbar);
    {
        PHASE_IDS();
        { pg8::Gemm g{(const bf16_t*)(ws + WS_KC), (const bf16_t*)(ws + WS_W1K), 4096, 512, 1024}; pg8::StaticOrder SO; SO.init(4096, 512, G, bx);
          EpiF32 E{(float*)(ws + WS_GK), 512}; pg8::gemm_phase<EpiF32, true>(L, g, SO, E, wave_s); }
        { pg8::Gemm g{(const bf16_t*)(ws + WS_VC), (const bf16_t*)(ws + WS_W1V), 4096, 512, 1024}; pg8::StaticOrder SO; SO.init(4096, 512, G, (bx + G - 32) % G);
          EpiF32 E{(float*)(ws + WS_GV), 512}; pg8::gemm_phase<EpiF32, true>(L, g, SO, E, wave_s); }
        __syncthreads();
        const float* lf = (const float*)args.in[4];
        float sa = 0.f, sb = 0.f;
        for (int d = 0; d < 64; ++d) { sa += lf[d] * lf[64 + d]; sb += lf[128 + d] * lf[192 + d]; }
        const float lam = __uint_as_float((unsigned)__builtin_amdgcn_readfirstlane((int)__float_as_uint(expf(sa) - expf(sb) + LAM_INIT)));
        if (wave_s == 0 && lane_id() == 0) misc[1] = 0;
        for (;;) {
            if (wave_s == 0 && lane_id() == 0) misc[0] = queue_fetch(ctl + 512, xbar.x & 7u, misc + 1);
            __syncthreads();
            const int idx = misc[0];
            __syncthreads();
            if (idx < 0) break;
            const int li = idx & 127, qb = 31 - (li >> 2), bh = (idx >> 7) * 4 + (li & 3);
            diff_unit(L, bh >> 2, bh & 3, qb, ws, lam, (const float*)args.in[5], wave_s);
        }
    }
    xcd_barrier(xbar);
    {
        PHASE_IDS();
        LAS float* hid = (LAS float*)L;
        LAS float* bias = hid + 4096;
        for (int un = bx; un < 512; un += G) {
            const int kv = un >> 8, p = (un >> 4) & 15, rb = un & 15;
            const float* Gm = (const float*)(ws + (kv ? WS_GV : WS_GK));
            const float* w2 = (const float*)args.in[kv ? 11 : 9];
            if (tid < 256) { float a = 0.f; const float* bp = (const float*)(ws + WS_BIASP) + kv * 16 * 256 + tid;
#pragma unroll
                for (int s = 0; s < 16; ++s) a += bp[s * 256]; bias[tid] = a; }
            __syncthreads();
#pragma unroll
            for (int i = 0; i < 8; ++i) { const int e = tid + 512 * i, r = e >> 8, k = e & 255, c = 16 * rb + r; const size_t R = (size_t)p * 256 + c;
                float v = Gm[R * 512 + k] + bias[k]; if (c < 255) v += Gm[(R + 1) * 512 + 256 + k];
                hid[r * 256 + k] = v / (1.f + __expf(-v)); }
            __syncthreads();
            const int d = tid & 63, r0 = tid >> 6; float a0 = 0.f, a1 = 0.f;
#pragma unroll 8
            for (int k = 0; k < 256; ++k) { const float w = w2[k * 64 + d]; a0 += hid[r0 * 256 + k] * w; a1 += hid[(r0 + 8) * 256 + k] * w; }
            bf16_t* O = (bf16_t*)(ws + (kv ? WS_VCMP : WS_KCMP)) + ((size_t)p * 256 + 16 * rb) * 64;
            O[r0 * 64 + d] = (bf16_t)(cvtpk(a0, 0.f) & 0xffffu); O[(r0 + 8) * 64 + d] = (bf16_t)(cvtpk(a1, 0.f) & 0xffffu);
            __syncthreads();
        }
    }
    xcd_barrier(xbar);
    {
        PHASE_IDS();
        if (wave_s == 0 && lane_id() == 0) misc[1] = 0;
        for (;;) {
            if (wave_s == 0 && lane_id() == 0) misc[0] = queue_fetch(ctl + 1024, xbar.x & 7u, misc + 1);
            __syncthreads();
            const int idx = misc[0];
            __syncthreads();
            if (idx < 0) break;
            const int li = idx & 127, qblk = 63 - (li >> 1), pgx = (idx >> 7) * 2 + (li & 1);
            nsa_unit(L, pgx >> 1, pgx & 1, qblk, ws, wave_s);
        }
    }
    xcd_barrier(xbar);
    {
        { pg8::Gemm g{(const bf16_t*)(ws + WS_YA), (const bf16_t*)(ws + WS_WA), T, D, 512}; pg8::StaticOrder SO; SO.init(T, D, G, bx);
          EpiBranch<false> E{(bf16_t*)(ws + WS_XB), (const bf16_t*)(ws + WS_MG)}; pg8::gemm_phase<EpiBranch<false>, true>(L, g, SO, E, wave_s); }
        __syncthreads();
        { pg8::Gemm g{(const bf16_t*)(ws + WS_YB), (const bf16_t*)(ws + WS_WB), T, D, 512}; pg8::StaticOrder SO; SO.init(T, D, G, bx);
          EpiBranch<true> E{(bf16_t*)(ws + WS_XB), (const bf16_t*)(ws + WS_MG)}; pg8::gemm_phase<EpiBranch<true>, true>(L, g, SO, E, wave_s); }
    }
    xcd_barrier(xbar);
    {
        pg8::Gemm g{(const bf16_t*)(ws + WS_XB), (const bf16_t*)(ws + WS_WO), T, D, D}; pg8::StaticOrder SO; SO.init(T, D, G, bx);
        EpiResid<false> E{(const void*)x, (bf16_t*)(ws + WS_YA), (float*)(ws + WS_SSQ2)};
        pg8::gemm_phase<EpiResid<false>, true>(L, g, SO, E, wave_s);
    }
    xcd_barrier(xbar);
    {
        pg8::Gemm g{(const bf16_t*)(ws + WS_YA), (const bf16_t*)(ws + WS_WGU), T, FF2, D}; pg8::StaticOrder SO; SO.init(T, FF2, G, bx);
        EpiGU E{(const float*)(ws + WS_SSQ2), (bf16_t*)(ws + WS_ACT)};
        pg8::gemm_phase<EpiGU, true>(L, g, SO, E, wave_s);
    }
    xcd_barrier(xbar);
    {
        pg8::Gemm g{(const bf16_t*)(ws + WS_ACT), (const bf16_t*)(ws + WS_WD), T, D, FF}; pg8::StaticOrder SO; SO.init(T, D, G, bx);
        EpiResid<true> E{(const void*)(ws + WS_YA), (bf16_t*)(ws + WS_XB), (float*)(ws + WS_SSQ3)};
        pg8::gemm_phase<EpiResid<true>, true>(L, g, SO, E, wave_s);
    }
    xcd_barrier(xbar);
    {
        PHASE_IDS();
        const float* gf = (const float*)args.in[19]; const float* SSQ3 = (const float*)(ws + WS_SSQ3);
        const int gw = bx * 8 + wave, NGW = G * 8;
        f32x4 gv[4];
#pragma unroll
        for (int jx = 0; jx < 4; ++jx) gv[jx] = ((const f32x4*)gf)[lane + 64 * jx];
        for (int m = gw; m < T; m += NGW) {
            float s = (lane < 16) ? SSQ3[(size_t)m * 16 + lane] : 0.f;
            s = wave_sum(s);
            const float rs = rsqrtf(s * (1.f / D) + EPS);
            const u32x2* hr = (const u32x2*)((const bf16_t*)(ws + WS_XB) + (size_t)m * D) + lane;
            f32x4* xr = (f32x4*)(out + (size_t)m * D) + lane;
#pragma unroll
            for (int jx = 0; jx < 4; ++jx) { const u32x2 w = hr[64 * jx]; f32x4 v = {bflo(w.x), bfhi(w.x), bflo(w.y), bfhi(w.y)}; v = v * rs * gv[jx]; xr[64 * jx] = v; }
        }
    }
}

extern "C" void kernel_launch(void* const* d_in, const int* in_sizes, int n_in, void* d_out, int out_size, void* d_ws, size_t ws_size, hipStream_t stream) {
    static int grid = 0;
    if (grid == 0) {
        if (n_in != 20 || out_size != T * D || ws_size < WS_END) { fprintf(stderr, "kernel_launch: unexpected shapes (n_in %d out %d ws %zu)\n", n_in, out_size, ws_size); grid = -1; return; }
        int dev = 0, cus = 0, per_cu = 0;
        hipGetDevice(&dev);
        hipDeviceGetAttribute(&cus, hipDeviceAttributeMultiprocessorCount, dev);
        hipFuncSetAttribute((const void*)hybrid_fwd, hipFuncAttributeMaxDynamicSharedMemorySize, LDS_BYTES);
        hipOccupancyMaxActiveBlocksPerMultiprocessor(&per_cu, (const void*)hybrid_fwd, 512, LDS_BYTES);
        if (per_cu < 1) { fprintf(stderr, "kernel_launch: occupancy query says %d blocks per CU\n", per_cu); per_cu = 1; }
        (void)hipGetLastError();
        grid = cus * per_cu;
    }
    if (grid < 0) return;
    hipMemsetAsync((char*)d_ws + WS_CTL, 0, 32768, stream);
    Args a{};
    for (int i = 0; i < 20; ++i) a.in[i] = d_in[i];
    a.out = (float*)d_out; a.ws = (unsigned char*)d_ws;
    void* params[] = {&a};
    hipError_t e = hipLaunchCooperativeKernel((const void*)hybrid_fwd, dim3(grid), dim3(512), params, LDS_BYTES, stream);
    if (e != hipSuccess) fprintf(stderr, "cooperative launch failed: %s (grid %d)\n", hipGetErrorString(e), grid);
}
```
